# Optimizing an MI355X kernel written in HIP

```python
import jax
import jax.numpy as jnp
from jax import lax
import numpy as np

D_MODEL = 1024
BATCH = 8
SEQ = 8192
DEPTH = 4

GRID_W = 64
CTX_LEN = 256
BLOCK = 128

RNN_WIDTH = D_MODEL
RNN_HEADS = RNN_WIDTH // 128
RNN_HEAD_DIM = RNN_WIDTH // RNN_HEADS
CONV_W = 4
CONV_LEFT = CONV_W // 2
LRU_C = 8.0
CMLP_WIDTH = D_MODEL // 2
CMLP_GROUPS = 4
CHUNK = 128
HEAD_DIM = 64
C_Q_HEADS = D_MODEL // (2 * HEAD_DIM)
C_KV_HEADS = C_Q_HEADS // 4
D_Q_HEADS = D_MODEL // (2 * HEAD_DIM)
D_KV_HEADS = D_Q_HEADS // 4
WINDOW = 128
ROPE_THETA = 10000.0
NEG_INF = -1e30
FFN_HIDDEN = -(-8 * D_MODEL // (3 * 256)) * 256

EVEN_SPLITS = (RNN_WIDTH, RNN_WIDTH, CMLP_WIDTH, CMLP_WIDTH)
EVEN_IN = sum(EVEN_SPLITS)
EVEN_MIX = RNN_WIDTH + CMLP_WIDTH
Q_SPLITS = (C_Q_HEADS * HEAD_DIM, D_Q_HEADS * HEAD_DIM)
KV_SPLITS = (C_KV_HEADS * HEAD_DIM, C_KV_HEADS * HEAD_DIM, D_KV_HEADS * HEAD_DIM, D_KV_HEADS * HEAD_DIM)
Q_COLS = sum(Q_SPLITS)
ODD_SPLITS = Q_SPLITS + KV_SPLITS
ODD_IN = sum(ODD_SPLITS)
ODD_MIX = Q_COLS

kernel_name = 'hybrid_rglru_gmlp_gqa_swa_prefix_trunk'


def _split(z, sizes):
    cuts = [int(s) for s in np.cumsum(sizes)[:-1]]
    return jnp.split(z, cuts, axis=-1)


def _heads(z, n):
    return z.reshape(z.shape[:-1] + (n, HEAD_DIM))


def _group(q, n_kv):
    return q.reshape(q.shape[:2] + (n_kv, q.shape[2] // n_kv, HEAD_DIM))


def _normalise(x, eps=1e-6):
    xf = x.astype(jnp.float32)
    xc = xf - jnp.mean(xf, axis=-1, keepdims=True)
    return (xc * lax.rsqrt(jnp.mean(xc * xc, axis=-1, keepdims=True) + eps)).astype(x.dtype)


def layer_norm(x, g, b):
    return _normalise(x) * g + b


def rms_norm(x, g, eps=1e-6):
    xf = x.astype(jnp.float32)
    return (xf * lax.rsqrt(jnp.mean(xf * xf, axis=-1, keepdims=True) + eps)).astype(x.dtype) * g


def modulate(x, shift, scale):
    return x * (1.0 + scale) + shift


def swiglu(h, w_in, w_out):
    gate, up = jnp.split(h @ w_in, 2, axis=-1)
    return (jax.nn.silu(gate) * up) @ w_out


def rope_tables(n_tokens, dtype):
    rows = n_tokens // GRID_W
    row = jnp.repeat(jnp.arange(rows, dtype=jnp.float32), GRID_W)
    col = jnp.tile(jnp.arange(GRID_W, dtype=jnp.float32), rows)
    nf = HEAD_DIM // 4
    inv_freq = ROPE_THETA ** (-jnp.arange(nf, dtype=jnp.float32) / nf)
    ang = jnp.stack([row[:, None] * inv_freq, col[:, None] * inv_freq], axis=1)
    return jnp.cos(ang).astype(dtype), jnp.sin(ang).astype(dtype)


def apply_rope_2d(x, cos, sin):
    nf = HEAD_DIM // 4
    xs = x.reshape(x.shape[:-1] + (2, 2, nf))
    x1, x2 = xs[..., 0, :], xs[..., 1, :]
    c = cos[None, :, None]
    s = sin[None, :, None]
    out = jnp.stack([x1 * c - x2 * s, x2 * c + x1 * s], axis=-2)
    return out.reshape(x.shape)


def centred_conv(x, w, b):
    T = x.shape[1]
    xp = jnp.pad(x, ((0, 0), (CONV_LEFT, CONV_W - 1 - CONV_LEFT), (0, 0)))
    out = xp[:, 0:T] * w[0]
    for k in range(1, CONV_W):
        out = out + xp[:, k:k + T] * w[k]
    return out + b


def rglru_coeffs(x, gate_w, gate_b, lam):
    B, T, _ = x.shape
    xh = x.reshape(B, T, RNN_HEADS, RNN_HEAD_DIM)
    gates = jnp.einsum('bthi,khij->kbthj', xh, gate_w.astype(jnp.float32)).reshape(2, B, T, RNN_WIDTH)
    gates = gates + gate_b.astype(jnp.float32)[:, None, None, :]
    r = jax.nn.sigmoid(gates[0])
    i = jax.nn.sigmoid(gates[1])
    log_a = -LRU_C * r * jax.nn.softplus(-lam.astype(jnp.float32))
    a = jnp.exp(log_a)
    b = jnp.sqrt(-jnp.expm1(2.0 * log_a)) * (i * x)
    return a, b


def linear_scan(a, b, reverse, h0=None):
    def combine(e1, e2):
        return e1[0] * e2[0], e2[0] * e1[1] + e2[1]
    acc_a, h = lax.associative_scan(combine, (a, b), reverse=reverse, axis=1)
    if h0 is None:
        return h
    return h + acc_a * h0[:, None, :]


def rg_lru_bidir(x_lat, x_ctx, gate_w, gate_b, lam, with_ctx_out):
    dtype = x_lat.dtype
    x_lat = x_lat.astype(jnp.float32)
    x_ctx = x_ctx.astype(jnp.float32)
    lat_out, ctx_out = [], []
    for d, reverse in enumerate((False, True)):
        a_c, b_c = rglru_coeffs(x_ctx, gate_w[d], gate_b[d], lam[d])
        h_c = linear_scan(a_c, b_c, reverse)
        h0 = h_c[:, 0] if reverse else h_c[:, -1]
        a_l, b_l = rglru_coeffs(x_lat, gate_w[d], gate_b[d], lam[d])
        lat_out.append(linear_scan(a_l, b_l, reverse, h0))
        ctx_out.append(h_c)
    y_lat = (lat_out[0] + lat_out[1]).astype(dtype)
    y_ctx = (ctx_out[0] + ctx_out[1]).astype(dtype) if with_ctx_out else None
    return y_lat, y_ctx


def chunk_gmlp(u, v, ws, bs):
    B, T, _ = v.shape
    vh = _normalise(v).reshape(B, T // CHUNK, CHUNK, CMLP_GROUPS, CMLP_WIDTH // CMLP_GROUPS)
    mixed = jnp.einsum('gpq,bnqgd->bnpgd', ws, vh) + bs.T[:, :, None]
    return u * mixed.reshape(B, T, CMLP_WIDTH)


def even_mixer(h_lat, h_ctx, w_in, w_out, conv_w, conv_b, gate_w, gate_b, lam, ws, bs, with_ctx_out):
    gate, xr, u, v = _split(h_lat @ w_in, EVEN_SPLITS)
    if with_ctx_out:
        gate_c, xr_c, u_c, v_c = _split(h_ctx @ w_in, EVEN_SPLITS)
    else:
        xr_c = h_ctx @ w_in[:, RNN_WIDTH:2 * RNN_WIDTH]
    xr = centred_conv(xr, conv_w, conv_b)
    xr_c = centred_conv(xr_c, conv_w, conv_b)
    rec, rec_c = rg_lru_bidir(xr, xr_c, gate_w, gate_b, lam, with_ctx_out)
    y_lat = jnp.concatenate([jax.nn.gelu(gate) * rec,
                             chunk_gmlp(jax.nn.gelu(u), jax.nn.gelu(v), ws, bs)], axis=-1) @ w_out
    if not with_ctx_out:
        return y_lat, None
    y_ctx = jnp.concatenate([jax.nn.gelu(gate_c) * rec_c,
                             chunk_gmlp(jax.nn.gelu(u_c), jax.nn.gelu(v_c), ws, bs)], axis=-1) @ w_out
    return y_lat, y_ctx


def attend(q, k, v, mask=None, sink=None):
    s = jnp.einsum('bqhgd,bkhd->bhgqk', q, k).astype(jnp.float32) * (HEAD_DIM ** -0.5)
    if mask is not None:
        s = jnp.where(mask, s, NEG_INF)
    if sink is not None:
        col = jnp.broadcast_to(sink.astype(jnp.float32)[None, :, :, None, None], s.shape[:-1] + (1,))
        p = jax.nn.softmax(jnp.concatenate([s, col], axis=-1), axis=-1)[..., :-1]
    else:
        p = jax.nn.softmax(s, axis=-1)
    return jnp.einsum('bhgqk,bkhd->bqhgd', p.astype(v.dtype), v)


def global_attn(q, k_lat, v_lat, k_ctx, v_ctx):
    B, T = q.shape[:2]
    k_all = jnp.concatenate([k_ctx, k_lat], axis=1)
    v_all = jnp.concatenate([v_ctx, v_lat], axis=1)
    qb = jnp.swapaxes(q.reshape((B, T // BLOCK, BLOCK) + q.shape[2:]), 0, 1)
    out = lax.map(lambda qi: attend(qi, k_all, v_all), qb)
    return jnp.swapaxes(out, 0, 1).reshape(B, T, -1)


def window_attn(q, k_lat, v_lat, k_ctx, v_ctx, sink):
    B, T = q.shape[:2]
    nb = T // BLOCK
    L = k_ctx.shape[1]
    pad = ((0, 0), (BLOCK, BLOCK), (0, 0), (0, 0))
    kp = jnp.pad(k_lat, pad)
    vp = jnp.pad(v_lat, pad)
    qb = jnp.swapaxes(q.reshape((B, nb, BLOCK) + q.shape[2:]), 0, 1)
    qoff = jnp.arange(BLOCK)[:, None]
    kidx = jnp.arange(3 * BLOCK)[None, :]
    ctx_mask = jnp.ones((BLOCK, L), dtype=bool)

    def one(args):
        qi, i = args
        start = i * BLOCK
        ki = lax.dynamic_slice_in_dim(kp, start, 3 * BLOCK, axis=1)
        vi = lax.dynamic_slice_in_dim(vp, start, 3 * BLOCK, axis=1)
        kpos = start - BLOCK + kidx
        band = (jnp.abs(kpos - (start + qoff)) <= WINDOW) & (kpos >= 0) & (kpos < T)
        mask = jnp.concatenate([ctx_mask, band], axis=-1)
        return attend(qi, jnp.concatenate([k_ctx, ki], axis=1), jnp.concatenate([v_ctx, vi], axis=1), mask, sink)

    out = lax.map(one, (qb, jnp.arange(nb)))
    return jnp.swapaxes(out, 0, 1).reshape(B, T, -1)


def odd_mixer(h_lat, h_ctx, w_in, w_out, qn_g, kn_g, sink, cos, sin, with_ctx_out):
    B, T, _ = h_lat.shape
    L = h_ctx.shape[1]
    cq, dq, ck, cv, dk, dv = _split(h_lat @ w_in, ODD_SPLITS)
    cq = apply_rope_2d(rms_norm(_heads(cq, C_Q_HEADS), qn_g), cos, sin)
    ck = apply_rope_2d(rms_norm(_heads(ck, C_KV_HEADS), kn_g), cos, sin)
    cv = _heads(cv, C_KV_HEADS)
    dq = apply_rope_2d(_heads(dq, D_Q_HEADS), cos, sin)
    dk = apply_rope_2d(_heads(dk, D_KV_HEADS), cos, sin)
    dv = _heads(dv, D_KV_HEADS)
    ck_c, cv_c, dk_c, dv_c = _split(h_ctx @ w_in[:, Q_COLS:], KV_SPLITS)
    ck_c = rms_norm(_heads(ck_c, C_KV_HEADS), kn_g)
    cv_c = _heads(cv_c, C_KV_HEADS)
    dk_c = _heads(dk_c, D_KV_HEADS)
    dv_c = _heads(dv_c, D_KV_HEADS)
    sink_g = sink.reshape(D_KV_HEADS, D_Q_HEADS // D_KV_HEADS)
    y_c = global_attn(_group(cq, C_KV_HEADS), ck, cv, ck_c, cv_c)
    y_d = window_attn(_group(dq, D_KV_HEADS), dk, dv, dk_c, dv_c, sink_g)
    y_lat = jnp.concatenate([y_c, y_d], axis=-1) @ w_out
    if not with_ctx_out:
        return y_lat, None
    cq_c, dq_c = _split(h_ctx @ w_in[:, :Q_COLS], Q_SPLITS)
    cq_c = rms_norm(_heads(cq_c, C_Q_HEADS), qn_g)
    yc_c = attend(_group(cq_c, C_KV_HEADS), ck_c, cv_c).reshape(B, L, -1)
    yd_c = attend(_group(_heads(dq_c, D_Q_HEADS), D_KV_HEADS), dk_c, dv_c, None, sink_g).reshape(B, L, -1)
    y_ctx = jnp.concatenate([yc_c, yd_c], axis=-1) @ w_out
    return y_lat, y_ctx


def setup_inputs(seed: int = 0) -> dict:
    key = jax.random.key(seed)
    ks = iter(jax.random.split(key, 40))

    def nrm(shape, scale):
        return jax.random.normal(next(ks), shape, jnp.float32) * scale

    n_even = (DEPTH + 1) // 2
    n_odd = DEPTH // 2
    beta = (8.0 * DEPTH) ** -0.25
    D = D_MODEL
    a_target = jax.random.uniform(next(ks), (n_even, 2, RNN_WIDTH), jnp.float32, 0.9, 0.999)
    a_base = a_target ** (1.0 / LRU_C)
    rg_lambda = jnp.log(a_base) - jnp.log1p(-a_base)
    return {
        'x': nrm((BATCH, SEQ, D), 1.0),
        'c': nrm((BATCH, D), 1.0),
        'ctx': nrm((BATCH, CTX_LEN, D), 1.0),
        'c_ctx': nrm((D,), 1.0),
        'ada_w': nrm((DEPTH, D, 6 * D), 0.5 * D ** -0.5),
        'ada_b': nrm((DEPTH, 6 * D), 0.02),
        'ln1_g': 1.0 + nrm((DEPTH, D), 0.02),
        'ln1_b': nrm((DEPTH, D), 0.02),
        'ln2_g': 1.0 + nrm((DEPTH, D), 0.02),
        'ln2_b': nrm((DEPTH, D), 0.02),
        'ffn_w_in': nrm((DEPTH, D, 2 * FFN_HIDDEN), D ** -0.5),
        'ffn_w_out': nrm((DEPTH, FFN_HIDDEN, D), beta * FFN_HIDDEN ** -0.5),
        'ev_w_in': nrm((n_even, D, EVEN_IN), D ** -0.5),
        'ev_w_out': nrm((n_even, EVEN_MIX, D), beta * EVEN_MIX ** -0.5),
        'rg_conv_w': nrm((n_even, CONV_W, RNN_WIDTH), CONV_W ** -0.5),
        'rg_conv_b': nrm((n_even, RNN_WIDTH), 0.02),
        'rg_gate_w': nrm((n_even, 2, 2, RNN_HEADS, RNN_HEAD_DIM, RNN_HEAD_DIM), RNN_HEAD_DIM ** -0.5),
        'rg_gate_b': nrm((n_even, 2, 2, RNN_WIDTH), 0.02),
        'rg_lambda': rg_lambda,
        'cm_w_s': nrm((n_even, CMLP_GROUPS, CHUNK, CHUNK), CHUNK ** -0.5),
        'cm_b_s': 1.0 + nrm((n_even, CMLP_GROUPS, CHUNK), 0.02),
        'od_w_in': nrm((n_odd, D, ODD_IN), D ** -0.5),
        'od_w_out': nrm((n_odd, ODD_MIX, D), beta * ODD_MIX ** -0.5),
        'qn_g': 1.0 + nrm((n_odd, HEAD_DIM), 0.02),
        'kn_g': 1.0 + nrm((n_odd, HEAD_DIM), 0.02),
        'sink': nrm((n_odd, D_Q_HEADS), 0.5),
    }


def reference(x, c, ctx, c_ctx, ada_w, ada_b, ln1_g, ln1_b, ln2_g, ln2_b, ffn_w_in, ffn_w_out,
              ev_w_in, ev_w_out, rg_conv_w, rg_conv_b, rg_gate_w, rg_gate_b, rg_lambda, cm_w_s, cm_b_s,
              od_w_in, od_w_out, qn_g, kn_g, sink):
    alpha = (2.0 * DEPTH) ** 0.25
    T = x.shape[1]
    cos, sin = rope_tables(T, x.dtype)
    s_lat = jax.nn.silu(c)
    s_ctx = jax.nn.silu(c_ctx)
    h, hc = x, ctx
    for l in range(DEPTH):
        last = l == DEPTH - 1
        sh1, sc1, g1, sh2, sc2, g2 = jnp.split((s_lat @ ada_w[l] + ada_b[l])[:, None, :], 6, axis=-1)
        csh1, csc1, cg1, csh2, csc2, cg2 = jnp.split(s_ctx @ ada_w[l] + ada_b[l], 6, axis=-1)
        a_lat = modulate(h, sh1, sc1)
        a_ctx = modulate(hc, csh1, csc1)
        j = l // 2
        if l % 2 == 0:
            y, yc = even_mixer(a_lat, a_ctx, ev_w_in[j], ev_w_out[j], rg_conv_w[j], rg_conv_b[j],
                               rg_gate_w[j], rg_gate_b[j], rg_lambda[j], cm_w_s[j], cm_b_s[j], not last)
        else:
            y, yc = odd_mixer(a_lat, a_ctx, od_w_in[j], od_w_out[j], qn_g[j], kn_g[j], sink[j],
                              cos, sin, not last)
        h = layer_norm(alpha * h + g1 * y, ln1_g[l], ln1_b[l])
        h = layer_norm(alpha * h + g2 * swiglu(modulate(h, sh2, sc2), ffn_w_in[l], ffn_w_out[l]),
                       ln2_g[l], ln2_b[l])
        if not last:
            hc = layer_norm(alpha * hc + cg1 * yc, ln1_g[l], ln1_b[l])
            hc = layer_norm(alpha * hc + cg2 * swiglu(modulate(hc, csh2, csc2), ffn_w_in[l], ffn_w_out[l]),
                            ln2_g[l], ln2_b[l])
    return h
```

```cpp
#include <hip/hip_runtime.h>
#include <hip/hip_cooperative_groups.h>
#include <cstdio>
#include <cstdint>
namespace cg = cooperative_groups;

#define LAS __attribute__((address_space(3)))
typedef unsigned short bf16_t;
typedef short bf16x8 __attribute__((ext_vector_type(8)));
typedef float f32x4 __attribute__((ext_vector_type(4)));
typedef float f32x2 __attribute__((ext_vector_type(2)));
typedef unsigned u32x4 __attribute__((ext_vector_type(4)));
typedef unsigned u32x2 __attribute__((ext_vector_type(2)));

constexpr int DM = 1024, NB = 8, SEQ = 8192, CTXL = 256, ML = NB * SEQ, MC = NB * CTXL, MALL = ML + MC, FH = 2816, KVR = SEQ + CTXL;
constexpr int NTHR = 512, NWAVE = 8;
constexpr int LDS_BYTES = 131072 + 2048;
constexpr float ALPHA = 1.681792830507429f, LOG2E = 1.4426950408889634f;
constexpr float QSCALE = 0.125f * 1.4426950408889634f;

constexpr size_t SZ_ROWS_BF = (size_t)MALL * 1024 * 2;
constexpr size_t OFF_H = 0;
constexpr size_t OFF_W = OFF_H + (size_t)MALL * 1024 * 4;
constexpr size_t W_FFN_IN = 0;
constexpr size_t W_FFN_OUT = W_FFN_IN + 4ull * 5632 * 1024 * 2;
constexpr size_t W_EV_IN = W_FFN_OUT + 4ull * 1024 * 2816 * 2;
constexpr size_t W_EV_OUT = W_EV_IN + 2ull * 3072 * 1024 * 2;
constexpr size_t W_GATE = W_EV_OUT + 2ull * 1024 * 1536 * 2;
constexpr size_t W_OD_IN = W_GATE + 2ull * 2 * 8 * 256 * 128 * 2;
constexpr size_t W_OD_OUT = W_OD_IN + 2ull * 1536 * 1024 * 2;
constexpr size_t W_END = W_OD_OUT + 2ull * 1024 * 1024 * 2;
constexpr size_t OFF_MOD = OFF_W + W_END;
constexpr size_t OFF_Z = OFF_MOD + 4ull * 9 * 6144 * 4;
constexpr size_t OFF_R2 = OFF_Z + (size_t)MALL * 3072 * 2;
constexpr size_t OFF_SPL = OFF_R2 + 2 * SZ_ROWS_BF;
constexpr size_t WS_NEED = OFF_SPL + 16384;
constexpr size_t ZO_QKV = 0;
constexpr size_t ZO_O = (size_t)MALL * 1536 * 2;
constexpr size_t ZO_KK = ZO_O + SZ_ROWS_BF;
constexpr size_t ZO_VT = ZO_KK + 2ull * 8 * 2 * KVR * 64 * 2;
constexpr size_t DO_XC = 0;
constexpr size_t DO_SUMM = SZ_ROWS_BF;
constexpr size_t DO_CARRY = DO_SUMM + 8ull * 264 * 1024 * 8;

struct KArgs {
    const float* in[26];
    float* out; unsigned char* ws;
    int step_lo, step_hi;
    int steps[64];
};
enum { K_PROLOGUE = 0, K_MOD0, K_GEMM_EVIN, K_CONV_GMLP, K_GEMM_GATE, K_SCAN1, K_CARRY, K_SCAN2, K_GEMM_PLAIN, K_LN, K_GEMM_SWIGLU, K_QKPOST, K_ATTN, K_DUMP };
enum { PL_EVOUT = 0, PL_ODIN, PL_ODOUT, PL_FFNOUT };

typedef __bf16 bf16x2_t __attribute__((ext_vector_type(2)));
__device__ __forceinline__ unsigned cvt_pk_bf16(float lo, float hi) { f32x2 v = {lo, hi}; bf16x2_t b = __builtin_convertvector(v, bf16x2_t); return __builtin_bit_cast(unsigned, b); }
__device__ __forceinline__ float bf_lo(unsigned w) { return __uint_as_float(w << 16); }
__device__ __forceinline__ float bf_hi(unsigned w) { return __uint_as_float(w & 0xffff0000u); }
__device__ __forceinline__ float fast_sigmoid(float x) { return __builtin_amdgcn_rcpf(1.0f + __builtin_amdgcn_exp2f(-x * LOG2E)); }
__device__ __forceinline__ float silu_f(float x) { return x * fast_sigmoid(x); }
__device__ __forceinline__ float gelu_tanh(float x) { const float u = x + 0.044715f * x * x * x; return x * __builtin_amdgcn_rcpf(1.0f + __builtin_amdgcn_exp2f(-2.0f * 0.7978845608028654f * LOG2E * u)); }
__device__ __forceinline__ float wave_sum(float v) {
#pragma unroll
    for (int o = 1; o < 64; o <<= 1) v += __shfl_xor(v, o);
    return v;
}

namespace pg8 {
constexpr int BM = 256, BK = 64, HALF = 128, HTB = HALF * BK * 2, STAGE_BYTES = 8 * HTB, NXCD = 8, WGM = 8;
__host__ __device__ __forceinline__ int lds_byte(int r, int c) { const int st = (r >> 4) * 2 + (c >> 5), rr = r & 15, cc = c & 31, ob = rr * 64 + cc * 2; return st * 1024 + (ob ^ (((ob >> 9) & 1) << 5)); }
__host__ __device__ __forceinline__ void stage_rc(int b, int& R, int& C) { const int st = b / 1024, sb = b % 1024, swz = sb ^ (((sb >> 9) & 1) << 5); R = (st >> 1) * 16 + swz / 64; C = (st & 1) * 32 + (swz % 64) / 2; }
__host__ __device__ __forceinline__ int perm32(int rho) { const int n = rho >> 4, i = rho & 15; return 8 * (i >> 2) + 4 * n + (i & 3); }
struct Unit { int pm, pn; };
struct Gemm { const bf16_t* A; const bf16_t* Bt; int M, N, K, lda, a_pn_off; };
struct StaticOrder {
    int nM, nN, nwg, G, c;
    __device__ void init(int M, int N, int G_, int c_) { nM = M / BM; nN = N / BM; nwg = nM * nN; G = G_; c = c_; }
    __device__ bool next(int i, Unit& u) const {
        const long L = (long)i * G + c; if (L >= nwg) return false;
        int wgid = (int)L; { const int q = nwg / NXCD, r = nwg % NXCD, xcd = wgid % NXCD, off = wgid / NXCD; wgid = (xcd < r ? xcd * (q + 1) : r * (q + 1) + (xcd - r) * q) + off; }
        const int nig = WGM * nN, gid = wgid / nig, fm = gid * WGM, gsz = (nM - fm) < WGM ? (nM - fm) : WGM;
        u.pm = fm + ((wgid % nig) % gsz); u.pn = (wgid % nig) / gsz; return true;
    }
};
template <class Epi, bool ALIGN_EPI>
__device__ __forceinline__ void gemm_phase(int tid, LAS unsigned char* lds, const Gemm g, const StaticOrder& S, const Epi& E) {
    const int wid = __builtin_amdgcn_readfirstlane(tid >> 6), lane = tid & 63, wr = wid >> 2, wc = wid & 3, fr = lane & 15, fq = lane >> 4;
    const int K = g.K, nt = K / BK;
    unsigned voffA[2], voffB[2];
#pragma unroll
    for (int i = 0; i < 2; ++i) { int R, C; stage_rc(tid * 16 + i * 8192, R, C); const int Rb = Epi::PERM ? ((R & ~31) + perm32(R & 31)) : R;
        voffA[i] = (unsigned)(R * g.lda + C) * 2u; voffB[i] = (unsigned)(Rb * K + C) * 2u; }
    const size_t kstep = (size_t)(BK * 2);
    const size_t hstepA = (size_t)HALF * g.lda * 2, hstepB = (size_t)HALF * K * 2;
    const size_t tstepA = 2 * hstepA, tstepB = 2 * hstepB;
    const unsigned ldsw = (unsigned)wid * 1024u;
    const int aoff = lds_byte(wr * 64 + fr, fq * 8), boff = lds_byte(wc * 32 + fr, fq * 8);
#define PG8_SA(b, h) (((b) * 2 + (h)) * HTB)
#define PG8_SB(b, h) ((4 + (b) * 2 + (h)) * HTB)
#define PG8_STAGE(bufoff, gbase, voff) do { _Pragma("unroll") for (int _i = 0; _i < 2; ++_i) \
        __builtin_amdgcn_global_load_lds((const unsigned*)((const char*)(gbase) + (voff)[_i]), (LAS unsigned*)(lds + (bufoff) + ldsw + _i * 8192), 16, 0, 0); } while (0)
#define PG8_LDA(dst, b, h) do { _Pragma("unroll") for (int m = 0; m < 4; ++m) _Pragma("unroll") for (int k = 0; k < 2; ++k) dst[m][k] = *(const LAS bf16x8*)(lds + PG8_SA(b, h) + aoff + m * 2048 + k * 1024); } while (0)
#define PG8_LDB(dst, b, h) do { _Pragma("unroll") for (int n = 0; n < 2; ++n) _Pragma("unroll") for (int k = 0; k < 2; ++k) dst[n][k] = *(const LAS bf16x8*)(lds + PG8_SB(b, h) + boff + n * 2048 + k * 1024); } while (0)
#define PG8_MMA(ai, bj, At, Bt) do { __builtin_amdgcn_s_setprio(1); _Pragma("unroll") for (int m = 0; m < 4; ++m) _Pragma("unroll") for (int n = 0; n < 2; ++n) _Pragma("unroll") for (int k = 0; k < 2; ++k) \
        acc[ai][bj][m][n] = __builtin_amdgcn_mfma_f32_16x16x32_bf16(Bt[n][k], At[m][k], acc[ai][bj][m][n], 0, 0, 0); __builtin_amdgcn_s_setprio(0); } while (0)
#define PG8_WAIT_V(n) asm volatile("s_waitcnt vmcnt(" #n ")" ::: "memory")
#define PG8_WAIT_L(n) asm volatile("s_waitcnt lgkmcnt(" #n ")" ::: "memory")
#define PG8_BAR __builtin_amdgcn_s_barrier()
#define PG8_SCHED __builtin_amdgcn_sched_barrier(0)
    Unit cur, nxt; int ui = 0;
    if (!S.next(0, cur)) return;
    f32x4 acc[2][2][4][2];
#pragma unroll
    for (int a = 0; a < 2; ++a)
#pragma unroll
        for (int b = 0; b < 2; ++b)
#pragma unroll
            for (int m = 0; m < 4; ++m)
#pragma unroll
                for (int n = 0; n < 2; ++n) acc[a][b][m][n] = (f32x4){0.f, 0.f, 0.f, 0.f};
    bf16x8 At[4][2], B0[2][2], B1[2][2];
    const char* cA = (const char*)g.A + (size_t)cur.pm * tstepA + (size_t)cur.pn * (size_t)g.a_pn_off; const char* cB = (const char*)g.Bt + (size_t)cur.pn * tstepB;
    PG8_STAGE(PG8_SB(0, 0), cB, voffB); PG8_STAGE(PG8_SB(0, 1), cB + hstepB, voffB); PG8_STAGE(PG8_SA(0, 0), cA, voffA); PG8_STAGE(PG8_SA(0, 1), cA + hstepA, voffA);
    if (wr == 1) PG8_BAR;
    PG8_WAIT_V(2); PG8_BAR;
    PG8_STAGE(PG8_SB(1, 0), cB + kstep, voffB); PG8_STAGE(PG8_SA(1, 0), cA + kstep, voffA); PG8_STAGE(PG8_SB(1, 1), cB + hstepB + kstep, voffB);
    PG8_WAIT_V(6); PG8_BAR;
    for (;;) {
        const bool has_next = S.next(ui + 1, nxt);
        const char* nA = has_next ? (const char*)g.A + (size_t)nxt.pm * tstepA + (size_t)nxt.pn * (size_t)g.a_pn_off : cA; const char* nB = has_next ? (const char*)g.Bt + (size_t)nxt.pn * tstepB : cB;
        for (int t = 0; t < nt; t += 2) {
            const bool last = (t == nt - 2);
            const char* a1 = cA + (size_t)(t + 1) * kstep;
            const char* a2 = last ? nA : cA + (size_t)(t + 2) * kstep; const char* b2 = last ? nB : cB + (size_t)(t + 2) * kstep;
            const char* a3 = a2 + kstep; const char* b3 = b2 + kstep;
            PG8_LDB(B0, 0, 0); PG8_LDB(B1, 0, 1); PG8_SCHED; PG8_LDA(At, 0, 0); PG8_STAGE(PG8_SA(1, 1), a1 + hstepA, voffA);
            PG8_WAIT_V(8); PG8_WAIT_L(0); PG8_BAR; PG8_MMA(0, 0, At, B0); PG8_MMA(0, 1, At, B1); PG8_BAR; PG8_SCHED;
            PG8_LDA(At, 0, 1); PG8_STAGE(PG8_SB(0, 0), b2, voffB); PG8_STAGE(PG8_SB(0, 1), b2 + hstepB, voffB); PG8_STAGE(PG8_SA(0, 0), a2, voffA);
            PG8_WAIT_V(8); PG8_WAIT_L(0); PG8_BAR; PG8_MMA(1, 0, At, B0); PG8_MMA(1, 1, At, B1); PG8_BAR; PG8_SCHED;
            PG8_LDB(B0, 1, 0); PG8_LDB(B1, 1, 1); PG8_SCHED; PG8_LDA(At, 1, 0); PG8_STAGE(PG8_SA(0, 1), a2 + hstepA, voffA);
            PG8_WAIT_V(8); PG8_WAIT_L(0); PG8_BAR; PG8_MMA(0, 0, At, B0); PG8_MMA(0, 1, At, B1); PG8_BAR; PG8_SCHED;
            PG8_LDA(At, 1, 1); PG8_STAGE(PG8_SB(1, 0), b3, voffB); PG8_STAGE(PG8_SB(1, 1), b3 + hstepB, voffB); PG8_STAGE(PG8_SA(1, 0), a3, voffA);
            PG8_WAIT_V(8); PG8_WAIT_L(0); PG8_BAR; PG8_MMA(1, 0, At, B0); PG8_MMA(1, 1, At, B1); PG8_BAR; PG8_SCHED;
        }
        if constexpr (ALIGN_EPI) { if (wr == 0) PG8_BAR; }
        E(acc, cur, wr, wc, fr, fq);
        if (!has_next) break;
#pragma unroll
        for (int a = 0; a < 2; ++a)
#pragma unroll
            for (int b = 0; b < 2; ++b)
#pragma unroll
                for (int m = 0; m < 4; ++m)
#pragma unroll
                    for (int n = 0; n < 2; ++n) acc[a][b][m][n] = (f32x4){0.f, 0.f, 0.f, 0.f};
        cur = nxt; cA = nA; cB = nB; ++ui;
        if constexpr (ALIGN_EPI) { if (wr == 1) PG8_BAR; }
    }
    PG8_WAIT_V(0);
    if constexpr (!ALIGN_EPI) { if (wr == 0) PG8_BAR; }
    PG8_BAR;
#undef PG8_SA
#undef PG8_SB
#undef PG8_STAGE
#undef PG8_LDA
#undef PG8_LDB
#undef PG8_MMA
#undef PG8_WAIT_V
#undef PG8_WAIT_L
#undef PG8_BAR
#undef PG8_SCHED
}
}

struct EpiStore {
    static constexpr bool PERM = true;
    bf16_t* O; int ldc; int gelu_tiles;
    __device__ __forceinline__ void operator()(const f32x4 (&acc)[2][2][4][2], const pg8::Unit& u, int wr, int wc, int fr, int fq) const {
        const int row0 = u.pm * 256 + wr * 64 + fr, col0 = u.pn * 256 + wc * 32 + 8 * fq; const bool act = u.pn < gelu_tiles;
#pragma unroll
        for (int ai = 0; ai < 2; ++ai)
#pragma unroll
            for (int m = 0; m < 4; ++m) { bf16_t* rowp = O + (size_t)(row0 + ai * 128 + m * 16) * ldc + col0;
#pragma unroll
                for (int bj = 0; bj < 2; ++bj) { f32x4 v0 = acc[ai][bj][m][0], v1 = acc[ai][bj][m][1];
                    if (act) {
#pragma unroll
                        for (int e = 0; e < 4; ++e) { v0[e] = gelu_tanh(v0[e]); v1[e] = gelu_tanh(v1[e]); } }
                    u32x4 w; w.x = cvt_pk_bf16(v0[0], v0[1]); w.y = cvt_pk_bf16(v0[2], v0[3]); w.z = cvt_pk_bf16(v1[0], v1[1]); w.w = cvt_pk_bf16(v1[2], v1[3]);
                    *(u32x4*)(rowp + bj * 128) = w; } }
    }
};
struct EpiSwiglu {
    static constexpr bool PERM = true;
    bf16_t* O; int ldc;
    __device__ __forceinline__ void operator()(const f32x4 (&acc)[2][2][4][2], const pg8::Unit& u, int wr, int wc, int fr, int fq) const {
        const int row0 = u.pm * 256 + wr * 64 + fr, col0 = u.pn * 128 + wc * 32 + 8 * fq;
#pragma unroll
        for (int ai = 0; ai < 2; ++ai)
#pragma unroll
            for (int m = 0; m < 4; ++m) { bf16_t* rowp = O + (size_t)(row0 + ai * 128 + m * 16) * ldc + col0;
                f32x4 v0, v1;
#pragma unroll
                for (int e = 0; e < 4; ++e) { v0[e] = silu_f(acc[ai][0][m][0][e]) * acc[ai][1][m][0][e]; v1[e] = silu_f(acc[ai][0][m][1][e]) * acc[ai][1][m][1][e]; }
                u32x4 w; w.x = cvt_pk_bf16(v0[0], v0[1]); w.y = cvt_pk_bf16(v0[2], v0[3]); w.z = cvt_pk_bf16(v1[0], v1[1]); w.w = cvt_pk_bf16(v1[2], v1[3]);
                *(u32x4*)rowp = w; }
    }
};
struct EpiGate {
    static constexpr bool PERM = true;
    bf16_t* LA; bf16_t* BBo; const bf16_t* XC; const float* gb_r; const float* gb_i; const float* spl;
    __device__ __forceinline__ void operator()(const f32x4 (&acc)[2][2][4][2], const pg8::Unit& u, int wr, int wc, int fr, int fq) const {
        const int row0 = u.pm * 256 + wr * 64 + fr, ch0 = u.pn * 128 + wc * 32 + 8 * fq;
#pragma unroll
        for (int ai = 0; ai < 2; ++ai)
#pragma unroll
            for (int m = 0; m < 4; ++m) { const size_t off = (size_t)(row0 + ai * 128 + m * 16) * 1024 + ch0;
                const u32x4 xw = *(const u32x4*)(XC + off);
                u32x4 w1, w2;
#pragma unroll
                for (int n = 0; n < 2; ++n) {
                    const f32x4 br = *(const f32x4*)(gb_r + ch0 + 4 * n), bi = *(const f32x4*)(gb_i + ch0 + 4 * n), sp = *(const f32x4*)(spl + ch0 + 4 * n);
                    const unsigned xa = n == 0 ? xw.x : xw.z, xb = n == 0 ? xw.y : xw.w;
                    const float xv[4] = {bf_lo(xa), bf_hi(xa), bf_lo(xb), bf_hi(xb)};
                    float la[4], bb[4];
#pragma unroll
                    for (int e = 0; e < 4; ++e) { const float gr = acc[ai][0][m][n][e] + br[e], gi = acc[ai][1][m][n][e] + bi[e];
                        const float l_ = sp[e] * fast_sigmoid(gr); la[e] = l_;
                        const float om = fmaxf(0.0f, 1.0f - __builtin_amdgcn_exp2f(2.0f * LOG2E * l_)); bb[e] = __builtin_amdgcn_sqrtf(om) * fast_sigmoid(gi) * xv[e]; }
                    if (n == 0) { w1.x = cvt_pk_bf16(la[0], la[1]); w1.y = cvt_pk_bf16(la[2], la[3]); w2.x = cvt_pk_bf16(bb[0], bb[1]); w2.y = cvt_pk_bf16(bb[2], bb[3]); }
                    else { w1.z = cvt_pk_bf16(la[0], la[1]); w1.w = cvt_pk_bf16(la[2], la[3]); w2.z = cvt_pk_bf16(bb[0], bb[1]); w2.w = cvt_pk_bf16(bb[2], bb[3]); }
                }
                *(u32x4*)(LA + off) = w1; *(u32x4*)(BBo + off) = w2; }
    }
};

__device__ __forceinline__ int colmap(int id, int n) {
    if (id == 1) { const int t = n >> 8, w = n & 255; return w < 128 ? t * 128 + w : FH + t * 128 + (w - 128); }
    if (id == 2) return n < 1024 ? n : (n < 2048 ? n + 1024 : n - 1024);
    return n;
}
__device__ __forceinline__ void tr_item(const float* W, int ldsrc, int K, bf16_t* WT, int n0, int k0, int mapid, LAS float* scr, int lane) {
    const int sc = colmap(mapid, n0 + (lane & 31));
#pragma unroll 8
    for (int i = 0; i < 32; ++i) { const int kk = 2 * i + (lane >> 5); scr[kk * 33 + (lane & 31)] = W[(size_t)(k0 + kk) * ldsrc + sc]; }
    asm volatile("s_waitcnt lgkmcnt(0)" ::: "memory");
    const int c = lane & 7;
#pragma unroll
    for (int j = 0; j < 4; ++j) { const int n = (lane >> 3) + 8 * j; const LAS float* s = scr + (8 * c) * 33 + n;
        u32x4 o; o.x = cvt_pk_bf16(s[0 * 33], s[1 * 33]); o.y = cvt_pk_bf16(s[2 * 33], s[3 * 33]); o.z = cvt_pk_bf16(s[4 * 33], s[5 * 33]); o.w = cvt_pk_bf16(s[6 * 33], s[7 * 33]);
        *(u32x4*)(WT + (size_t)(n0 + n) * K + k0 + 8 * c) = o; }
    asm volatile("s_waitcnt lgkmcnt(0)" ::: "memory");
}
__device__ __forceinline__ void phase_prologue(const KArgs& a, const int tid, LAS unsigned char* lds) {
    const int lane = tid & 63, wave = tid >> 6;
    LAS float* sv = (LAS float*)(lds + 73728);
    LAS float* part = (LAS float*)(lds + 110592);
    float* MOD = (float*)(a.ws + OFF_MOD);
    for (int i = tid; i < 9 * 1024; i += NTHR) { const int s = i >> 10, k = i & 1023; const float v = s < 8 ? a.in[1][s * 1024 + k] : a.in[3][k]; sv[i] = v / (1.0f + __expf(-v)); }
    __syncthreads();
    for (int item = blockIdx.x; item < 384; item += gridDim.x) {
        const int l = item / 96, n0 = (item % 96) * 64;
        const float* w = a.in[4] + (size_t)l * 1024 * 6144 + n0 + lane;
        float acc[9];
#pragma unroll
        for (int s = 0; s < 9; ++s) acc[s] = 0.f;
        const int k0 = wave * 128;
#pragma unroll 4
        for (int k = 0; k < 128; ++k) { const float wv = w[(size_t)(k0 + k) * 6144];
#pragma unroll
            for (int s = 0; s < 9; ++s) acc[s] += sv[s * 1024 + k0 + k] * wv; }
#pragma unroll
        for (int s = 0; s < 9; ++s) part[(wave * 9 + s) * 64 + lane] = acc[s];
        __syncthreads();
        for (int idx = tid; idx < 576; idx += NTHR) { const int s = idx >> 6, n = idx & 63; float r = a.in[5][l * 6144 + n0 + n];
#pragma unroll
            for (int w8 = 0; w8 < 8; ++w8) r += part[(w8 * 9 + s) * 64 + n];
            MOD[(size_t)(l * 9 + s) * 6144 + n0 + n] = r; }
        __syncthreads();
    }
    for (int i = blockIdx.x * NTHR + tid; i < 4096; i += gridDim.x * NTHR) ((float*)(a.ws + OFF_SPL))[i] = -8.0f * log1pf(__expf(-a.in[18][i]));
    LAS float* scr = (LAS float*)(lds + wave * 8448);
    unsigned char* WB = a.ws + OFF_W;
    const int gw = blockIdx.x * NWAVE + wave, NGW = gridDim.x * NWAVE;
    for (int it = gw; it < 24576; it += NGW) {
        int r = it;
        if (r < 11264) { const int l = r / 2816, q = r % 2816, kb = q / 176, nb = q % 176;
            tr_item(a.in[10] + (size_t)l * 1024 * 5632, 5632, 1024, (bf16_t*)(WB + W_FFN_IN) + (size_t)l * 5632 * 1024, nb * 32, kb * 64, 1, scr, lane); continue; }
        r -= 11264;
        if (r < 5632) { const int l = r / 1408, q = r % 1408, kb = q / 32, nb = q % 32;
            tr_item(a.in[11] + (size_t)l * 2816 * 1024, 1024, 2816, (bf16_t*)(WB + W_FFN_OUT) + (size_t)l * 1024 * 2816, nb * 32, kb * 64, 0, scr, lane); continue; }
        r -= 5632;
        if (r < 3072) { const int j = r / 1536, q = r % 1536, kb = q / 96, nb = q % 96;
            tr_item(a.in[12] + (size_t)j * 1024 * 3072, 3072, 1024, (bf16_t*)(WB + W_EV_IN) + (size_t)j * 3072 * 1024, nb * 32, kb * 64, 2, scr, lane); continue; }
        r -= 3072;
        if (r < 1536) { const int j = r / 768, q = r % 768, kb = q / 32, nb = q % 32;
            tr_item(a.in[13] + (size_t)j * 1536 * 1024, 1024, 1536, (bf16_t*)(WB + W_EV_OUT) + (size_t)j * 1024 * 1536, nb * 32, kb * 64, 0, scr, lane); continue; }
        r -= 1536;
        if (r < 512) { const int blk = r >> 3, q = r & 7, kb = q >> 2, nb = q & 3; const int h = blk & 7, k = (blk >> 3) & 1, d = (blk >> 4) & 1, j = blk >> 5;
            tr_item(a.in[16] + (size_t)blk * 16384, 128, 128, (bf16_t*)(WB + W_GATE) + (size_t)j * (2 * 8 * 256 * 128) + (size_t)((d * 8 + h) * 256 + k * 128) * 128, nb * 32, kb * 64, 0, scr, lane); continue; }
        r -= 512;
        if (r < 1536) { const int j = r / 768, q = r % 768, kb = q / 48, nb = q % 48;
            tr_item(a.in[21] + (size_t)j * 1024 * 1536, 1536, 1024, (bf16_t*)(WB + W_OD_IN) + (size_t)j * 1536 * 1024, nb * 32, kb * 64, 0, scr, lane); continue; }
        r -= 1536;
        { const int j = r / 512, q = r % 512, kb = q / 32, nb = q % 32;
            tr_item(a.in[22] + (size_t)j * 1024 * 1024, 1024, 1024, (bf16_t*)(WB + W_OD_OUT) + (size_t)j * 1024 * 1024, nb * 32, kb * 64, 0, scr, lane); }
    }
}

__device__ __forceinline__ void phase_ln(const KArgs& a, const int tid, int l, int which) {
    const int lane = tid & 63, wave = tid >> 6;
    const int gw = blockIdx.x * NWAVE + wave, NGW = gridDim.x * NWAVE;
    float* H = (float*)(a.ws + OFF_H); const float* MOD = (const float*)(a.ws + OFF_MOD);
    bf16_t* A = (bf16_t*)(a.ws + OFF_R2); const bf16_t* Y = (const bf16_t*)(a.ws + OFF_R2 + SZ_ROWS_BF);
    const bool final_ = (l == 3 && which == 2), from_in = (which == 0) || (which == 1 && l == 0);
    const int Mrows = (l == 3 && which != 0) ? ML : MALL;
    const float* gam = which == 1 ? a.in[6] + l * 1024 : a.in[8] + l * 1024; const float* bet = which == 1 ? a.in[7] + l * 1024 : a.in[9] + l * 1024;
    const int lm = which == 0 ? 0 : (which == 1 ? l : l + 1), shi = which == 1 ? 3 : 0, sci = which == 1 ? 4 : 1, gi = which == 1 ? 2 : 5;
    for (int row = gw; row < Mrows; row += NGW) {
        const int ms = row < ML ? (row >> 13) : 8;
        const float* src = from_in ? (row < ML ? a.in[0] + (size_t)row * 1024 : a.in[2] + (size_t)(row - ML) * 1024) : H + (size_t)row * 1024;
        f32x4 v[4];
#pragma unroll
        for (int j = 0; j < 4; ++j) v[j] = *(const f32x4*)(src + 4 * lane + 256 * j);
        if (which != 0) {
            const float* gp = MOD + (size_t)(l * 9 + ms) * 6144 + gi * 1024; float s = 0.f;
#pragma unroll
            for (int j = 0; j < 4; ++j) { const u32x2 yw = *(const u32x2*)(Y + (size_t)row * 1024 + 4 * lane + 256 * j); const f32x4 g = *(const f32x4*)(gp + 4 * lane + 256 * j);
                v[j][0] = ALPHA * v[j][0] + g[0] * bf_lo(yw.x); v[j][1] = ALPHA * v[j][1] + g[1] * bf_hi(yw.x); v[j][2] = ALPHA * v[j][2] + g[2] * bf_lo(yw.y); v[j][3] = ALPHA * v[j][3] + g[3] * bf_hi(yw.y);
                s += (v[j][0] + v[j][1]) + (v[j][2] + v[j][3]); }
            const float mean = wave_sum(s) * (1.0f / 1024.0f); float s2 = 0.f;
#pragma unroll
            for (int j = 0; j < 4; ++j) { v[j] = v[j] - mean; s2 += (v[j][0] * v[j][0] + v[j][1] * v[j][1]) + (v[j][2] * v[j][2] + v[j][3] * v[j][3]); }
            const float rstd = rsqrtf(wave_sum(s2) * (1.0f / 1024.0f) + 1e-6f);
            float* dst = final_ ? a.out + (size_t)row * 1024 : H + (size_t)row * 1024;
#pragma unroll
            for (int j = 0; j < 4; ++j) { const f32x4 gm = *(const f32x4*)(gam + 4 * lane + 256 * j), bt = *(const f32x4*)(bet + 4 * lane + 256 * j);
                v[j] = v[j] * rstd * gm + bt; *(f32x4*)(dst + 4 * lane + 256 * j) = v[j]; }
        }
        if (!final_) {
            const float* shp = MOD + (size_t)(lm * 9 + ms) * 6144 + shi * 1024; const float* scp = MOD + (size_t)(lm * 9 + ms) * 6144 + sci * 1024;
#pragma unroll
            for (int j = 0; j < 4; ++j) { const f32x4 sh = *(const f32x4*)(shp + 4 * lane + 256 * j), sc = *(const f32x4*)(scp + 4 * lane + 256 * j);
                const f32x4 o = v[j] * (sc + 1.0f) + sh; u32x2 w; w.x = cvt_pk_bf16(o[0], o[1]); w.y = cvt_pk_bf16(o[2], o[3]);
                *(u32x2*)(A + (size_t)row * 1024 + 4 * lane + 256 * j) = w; }
        }
    }
}

__device__ __forceinline__ void phase_conv_gmlp(const KArgs& a, const int tid, int jl, LAS unsigned char* lds) {
    const int lane = tid & 63, wave = tid >> 6;
    bf16_t* Z = (bf16_t*)(a.ws + OFF_Z);
    LAS bf16_t* VNT = (LAS bf16_t*)lds;
    const float* Wsp = a.in[19] + (size_t)jl * 4 * 128 * 128; const float* Bsp = a.in[20] + (size_t)jl * 4 * 128;
    for (int item = blockIdx.x; item < 528 * 4; item += gridDim.x) {
        const int ci = item >> 2, g = item & 3;
        const int row0 = ci < 512 ? ci * 128 : ML + (ci - 512) * 128;
        for (int rr = 0; rr < 16; ++rr) { const int q = wave * 16 + rr;
            const u32x4 w = *(const u32x4*)(Z + (size_t)(row0 + q) * 3072 + 1536 + 8 * lane);
            float x[8] = {bf_lo(w.x), bf_hi(w.x), bf_lo(w.y), bf_hi(w.y), bf_lo(w.z), bf_hi(w.z), bf_lo(w.w), bf_hi(w.w)};
            float s = 0.f;
#pragma unroll
            for (int e = 0; e < 8; ++e) s += x[e];
            const float mean = wave_sum(s) * (1.0f / 512.0f); float s2 = 0.f;
#pragma unroll
            for (int e = 0; e < 8; ++e) { x[e] -= mean; s2 += x[e] * x[e]; }
            const float rstd = rsqrtf(wave_sum(s2) * (1.0f / 512.0f) + 1e-6f);
            if ((lane >> 4) == g) {
#pragma unroll
                for (int e = 0; e < 8; e += 2) { const unsigned pk = cvt_pk_bf16(x[e] * rstd, x[e + 1] * rstd);
                    VNT[(8 * (lane & 15) + e) * 136 + q] = (bf16_t)(pk & 0xffffu); VNT[(8 * (lane & 15) + e + 1) * 136 + q] = (bf16_t)(pk >> 16); } }
        }
        bf16x8 bfr[4];
        { const float* wp = Wsp + (size_t)(g * 128 + wave * 16 + (lane & 15)) * 128 + 8 * (lane >> 4);
#pragma unroll
          for (int ks = 0; ks < 4; ++ks) { const f32x4 w0 = *(const f32x4*)(wp + 32 * ks), w1 = *(const f32x4*)(wp + 32 * ks + 4);
              u32x4 p; p.x = cvt_pk_bf16(w0[0], w0[1]); p.y = cvt_pk_bf16(w0[2], w0[3]); p.z = cvt_pk_bf16(w1[0], w1[1]); p.w = cvt_pk_bf16(w1[2], w1[3]); bfr[ks] = __builtin_bit_cast(bf16x8, p); } }
        __syncthreads();
        const int p = wave * 16 + (lane & 15); const float bias = Bsp[g * 128 + p];
        bf16_t* urow = Z + (size_t)(row0 + p) * 3072 + 1024 + g * 128;
#pragma unroll
        for (int dt = 0; dt < 8; ++dt) {
            f32x4 acc = (f32x4){0.f, 0.f, 0.f, 0.f};
#pragma unroll
            for (int ks = 0; ks < 4; ++ks) { const bf16x8 af = *(const LAS bf16x8*)(VNT + (16 * dt + (lane & 15)) * 136 + 32 * ks + 8 * (lane >> 4));
                acc = __builtin_amdgcn_mfma_f32_16x16x32_bf16(af, bfr[ks], acc, 0, 0, 0); }
            bf16_t* up = urow + 16 * dt + 4 * (lane >> 4); const u32x2 uw = *(const u32x2*)up;
            u32x2 o; o.x = cvt_pk_bf16(bf_lo(uw.x) * (acc[0] + bias), bf_hi(uw.x) * (acc[1] + bias)); o.y = cvt_pk_bf16(bf_lo(uw.y) * (acc[2] + bias), bf_hi(uw.y) * (acc[3] + bias));
            *(u32x2*)up = o;
        }
        __syncthreads();
    }
    bf16_t* XC = (bf16_t*)((unsigned char*)a.out + DO_XC);
    const float* cw = a.in[14] + (size_t)jl * 4 * 1024; const float* cb = a.in[15] + (size_t)jl * 1024;
    for (int idx = blockIdx.x * NTHR + tid; idx < MALL * 128; idx += gridDim.x * NTHR) {
        const int row = idx >> 7, c0 = (idx & 127) * 8;
        int t, len; if (row < ML) { t = row & 8191; len = SEQ; } else { t = (row - ML) & 255; len = CTXL; }
        float o[8];
#pragma unroll
        for (int e = 0; e < 8; ++e) o[e] = cb[c0 + e];
#pragma unroll
        for (int k = 0; k < 4; ++k) { const int tt = t - 2 + k;
            if (tt >= 0 && tt < len) { const u32x4 w = *(const u32x4*)(Z + (size_t)(row - 2 + k) * 3072 + 2048 + c0);
                const f32x4 w0 = *(const f32x4*)(cw + k * 1024 + c0), w1 = *(const f32x4*)(cw + k * 1024 + c0 + 4);
                o[0] += bf_lo(w.x) * w0[0]; o[1] += bf_hi(w.x) * w0[1]; o[2] += bf_lo(w.y) * w0[2]; o[3] += bf_hi(w.y) * w0[3];
                o[4] += bf_lo(w.z) * w1[0]; o[5] += bf_hi(w.z) * w1[1]; o[6] += bf_lo(w.w) * w1[2]; o[7] += bf_hi(w.w) * w1[3]; } }
        u32x4 ow; ow.x = cvt_pk_bf16(o[0], o[1]); ow.y = cvt_pk_bf16(o[2], o[3]); ow.z = cvt_pk_bf16(o[4], o[5]); ow.w = cvt_pk_bf16(o[6], o[7]);
        *(u32x4*)(XC + (size_t)row * 1024 + c0) = ow;
    }
}

__device__ __forceinline__ int scan_row(int d, int b, int sc, int i) {
    if (d == 0) return sc < 8 ? ML + b * 256 + sc * 32 + i : b * SEQ + (sc - 8) * 32 + i;
    return sc < 8 ? ML + b * 256 + 255 - (sc * 32 + i) : b * SEQ + 8191 - ((sc - 8) * 32 + i);
}
__device__ __forceinline__ void phase_scan(const KArgs& a, const int tid, int d, int pass) {
    const bf16_t* LA = (const bf16_t*)(a.ws + OFF_R2); const bf16_t* BBp = (const bf16_t*)(a.ws + OFF_R2 + SZ_ROWS_BF);
    bf16_t* Z = (bf16_t*)(a.ws + OFF_Z);
    float* SUMM = (float*)((unsigned char*)a.out + DO_SUMM); const float* CAR = (const float*)((unsigned char*)a.out + DO_CARRY);
    for (int item = blockIdx.x; item < 8 * 264; item += gridDim.x) {
        const int b = item / 264, sc = item % 264; const int ch = 2 * tid;
        float h0 = 0.f, h1 = 0.f, p0 = 0.f, p1 = 0.f;
        if (pass == 2) { const f32x2 c = *(const f32x2*)(CAR + (size_t)item * 1024 + ch); h0 = c.x; h1 = c.y; }
#pragma unroll 4
        for (int i = 0; i < 32; ++i) { const int row = scan_row(d, b, sc, i);
            const unsigned lw = *(const unsigned*)(LA + (size_t)row * 1024 + ch), bw = *(const unsigned*)(BBp + (size_t)row * 1024 + ch);
            const float l0 = bf_lo(lw), l1 = bf_hi(lw);
            h0 = __builtin_amdgcn_exp2f(l0 * LOG2E) * h0 + bf_lo(bw); h1 = __builtin_amdgcn_exp2f(l1 * LOG2E) * h1 + bf_hi(bw);
            if (pass == 1) { p0 += l0; p1 += l1; }
            else if (d == 0) { *(unsigned*)(Z + (size_t)row * 3072 + 2048 + ch) = cvt_pk_bf16(h0, h1); }
            else { const unsigned fw = *(const unsigned*)(Z + (size_t)row * 3072 + 2048 + ch), gw = *(const unsigned*)(Z + (size_t)row * 3072 + ch);
                *(unsigned*)(Z + (size_t)row * 3072 + ch) = cvt_pk_bf16(bf_lo(gw) * (bf_lo(fw) + h0), bf_hi(gw) * (bf_hi(fw) + h1)); }
        }
        if (pass == 1) *(f32x4*)(SUMM + ((size_t)item * 1024 + ch) * 2) = (f32x4){p0, h0, p1, h1};
    }
}
__device__ __forceinline__ void phase_carry(const KArgs& a, const int tid) {
    const float* SUMM = (const float*)((unsigned char*)a.out + DO_SUMM); float* CAR = (float*)((unsigned char*)a.out + DO_CARRY);
    const int gid = blockIdx.x * NTHR + tid;
    if (gid < 8192) { const int b = gid >> 10, ch = gid & 1023; float c = 0.f;
#pragma unroll 8
        for (int sc = 0; sc < 264; ++sc) { const size_t o = (size_t)(b * 264 + sc) * 1024 + ch; const f32x2 s = *(const f32x2*)(SUMM + o * 2);
            CAR[o] = c; c = __builtin_amdgcn_exp2f(s.x * LOG2E) * c + s.y; } }
}

__device__ __forceinline__ void phase_qkpost(const KArgs& a, const int tid, int jl) {
    bf16_t* Zq = (bf16_t*)(a.ws + OFF_Z + ZO_QKV); bf16_t* KK = (bf16_t*)(a.ws + OFF_Z + ZO_KK); bf16_t* VT = (bf16_t*)(a.ws + OFF_Z + ZO_VT);
    const float* qn = a.in[23] + jl * 64; const float* kn = a.in[24] + jl * 64;
    for (int idx = blockIdx.x * NTHR + tid; idx < 24 * MALL; idx += gridDim.x * NTHR) {
        const int slot = idx / MALL, row = idx - slot * MALL;
        const bool lat = row < ML; const int t = lat ? (row & 8191) : ((row - ML) & 255), b = lat ? (row >> 13) : ((row - ML) >> 8);
        const int kvrow = lat ? 256 + t : t;
        bf16_t* src = Zq + (size_t)row * 1536 + slot * 64;
        float v[64];
#pragma unroll
        for (int c = 0; c < 8; ++c) { const u32x4 w = *(const u32x4*)(src + 8 * c);
            v[8 * c] = bf_lo(w.x); v[8 * c + 1] = bf_hi(w.x); v[8 * c + 2] = bf_lo(w.y); v[8 * c + 3] = bf_hi(w.y); v[8 * c + 4] = bf_lo(w.z); v[8 * c + 5] = bf_hi(w.z); v[8 * c + 6] = bf_lo(w.w); v[8 * c + 7] = bf_hi(w.w); }
        const bool isv = (slot == 18 || slot == 19 || slot == 22 || slot == 23);
        if (isv) { const int type = slot >= 22, hh = slot & 1;
            bf16_t* dst = VT + (size_t)((type * 8 + b) * 2 + hh) * 64 * KVR + kvrow;
#pragma unroll
            for (int dd = 0; dd < 64; dd += 2) { const unsigned pk = cvt_pk_bf16(v[dd], v[dd + 1]); dst[(size_t)dd * KVR] = (bf16_t)(pk & 0xffffu); dst[(size_t)(dd + 1) * KVR] = (bf16_t)(pk >> 16); }
            continue; }
        const bool isq = slot < 16;
        if (slot < 8 || slot == 16 || slot == 17) { const float* g = slot < 8 ? qn : kn; float ss = 0.f;
#pragma unroll
            for (int dd = 0; dd < 64; ++dd) ss += v[dd] * v[dd];
            const float r = rsqrtf(ss * (1.0f / 64.0f) + 1e-6f);
#pragma unroll
            for (int dd = 0; dd < 64; ++dd) v[dd] = v[dd] * r * g[dd]; }
        if (lat) { const float pr = (float)(t >> 6), pc = (float)(t & 63);
#pragma unroll
            for (int f = 0; f < 16; ++f) { const float invf = exp2f(-(float)f * 0.8304820237218406f) * 0.15915494309189535f;
                { const float rev = pr * invf, cs = __builtin_amdgcn_cosf(rev), sn = __builtin_amdgcn_sinf(rev); const float x1 = v[f], x2 = v[16 + f]; v[f] = x1 * cs - x2 * sn; v[16 + f] = x2 * cs + x1 * sn; }
                { const float rev = pc * invf, cs = __builtin_amdgcn_cosf(rev), sn = __builtin_amdgcn_sinf(rev); const float x1 = v[32 + f], x2 = v[48 + f]; v[32 + f] = x1 * cs - x2 * sn; v[48 + f] = x2 * cs + x1 * sn; } } }
        bf16_t* dst;
        if (isq) { dst = src;
#pragma unroll
            for (int dd = 0; dd < 64; ++dd) v[dd] *= QSCALE; }
        else { const int type = slot >= 20, hh = slot & 1; dst = KK + ((size_t)((type * 8 + b) * 2 + hh) * KVR + kvrow) * 64; }
#pragma unroll
        for (int c = 0; c < 8; ++c) { u32x4 w; w.x = cvt_pk_bf16(v[8 * c], v[8 * c + 1]); w.y = cvt_pk_bf16(v[8 * c + 2], v[8 * c + 3]); w.z = cvt_pk_bf16(v[8 * c + 4], v[8 * c + 5]); w.w = cvt_pk_bf16(v[8 * c + 6], v[8 * c + 7]);
            *(u32x4*)(dst + 8 * c) = w; }
    }
}

__device__ __forceinline__ void phase_attn(const KArgs& a, const int tid, int jl, bool with_ctx) {
    const int lane = tid & 63, wave = tid >> 6, l15 = lane & 15, lg = lane >> 4;
    const bf16_t* Zq = (const bf16_t*)(a.ws + OFF_Z + ZO_QKV); const bf16_t* KK = (const bf16_t*)(a.ws + OFF_Z + ZO_KK); const bf16_t* VT = (const bf16_t*)(a.ws + OFF_Z + ZO_VT);
    bf16_t* O = (bf16_t*)(a.ws + OFF_Z + ZO_O);
    const float* sinkp = a.in[25] + jl * 8;
    const int gw = blockIdx.x * NWAVE + wave, NGW = gridDim.x * NWAVE;
    const int nitems = with_ctx ? 16384 + 512 : 16384;
    for (int item = gw; item < nitems; item += NGW) {
        int mode, bg, qtile;
        if (item < 8192) { mode = 0; bg = item >> 9; qtile = item & 511; }
        else if (item < 16384) { mode = 1; bg = (item - 8192) >> 9; qtile = item & 511; }
        else if (item < 16384 + 256) { mode = 2; bg = (item - 16384) >> 4; qtile = item & 15; }
        else { mode = 3; bg = (item - 16640) >> 4; qtile = item & 15; }
        const int b = bg >> 1, g = bg & 1, type = mode & 1;
        const int rowbase = (mode < 2) ? b * SEQ + 16 * qtile : ML + b * CTXL + 16 * qtile;
        const int qcol = type * 512 + g * 256;
        const bf16_t* Kb = KK + (size_t)((type * 8 + b) * 2 + g) * KVR * 64;
        const bf16_t* Vb = VT + (size_t)((type * 8 + b) * 2 + g) * 64 * KVR;
        const int nA = (mode == 0) ? 264 : 8;
        int lo = 0, nB = 0; const int q0 = 16 * qtile;
        if (mode == 1) { lo = q0 >= 128 ? ((q0 - 128) >> 5) : 0; int hi = ((q0 + 143) >> 5) + 1; if (hi > 256) hi = 256; nB = hi - lo; }
        const int ntot = nA + nB;
        bf16x8 qf[4][2];
        { const bf16_t* qp = Zq + (size_t)(rowbase + l15) * 1536 + qcol + 8 * lg;
#pragma unroll
          for (int qt = 0; qt < 4; ++qt)
#pragma unroll
              for (int ks = 0; ks < 2; ++ks) qf[qt][ks] = *(const bf16x8*)(qp + 64 * qt + 32 * ks); }
        f32x4 oacc[4][4]; float mrun[4], lsum[4];
#pragma unroll
        for (int qt = 0; qt < 4; ++qt) { mrun[qt] = -1e30f; lsum[qt] = 0.f;
#pragma unroll
            for (int dt = 0; dt < 4; ++dt) oacc[qt][dt] = (f32x4){0.f, 0.f, 0.f, 0.f}; }
        bf16x8 kf[2][2]; u32x2 vlo[4], vhi[4];
        const bf16_t* kp = Kb + (size_t)l15 * 64 + 8 * lg; const bf16_t* vp = Vb + (size_t)l15 * KVR + 4 * lg;
#define LOAD_KV(KF, VLO, VHI, kvrow0) do { \
        _Pragma("unroll") for (int kt = 0; kt < 2; ++kt) _Pragma("unroll") for (int ks = 0; ks < 2; ++ks) KF[kt][ks] = *(const bf16x8*)(kp + (size_t)((kvrow0) + 16 * kt) * 64 + 32 * ks); \
        _Pragma("unroll") for (int dt = 0; dt < 4; ++dt) { VLO[dt] = *(const u32x2*)(vp + (size_t)(16 * dt) * KVR + (kvrow0)); VHI[dt] = *(const u32x2*)(vp + (size_t)(16 * dt) * KVR + (kvrow0) + 16); } } while (0)
        LOAD_KV(kf, vlo, vhi, 0);
        for (int blk = 0; blk < ntot; ++blk) {
            const int nb_ = (blk + 1 < ntot) ? blk + 1 : blk;
            const int kvnext = nb_ < nA ? 32 * nb_ : 256 + 32 * (lo + nb_ - nA);
            bf16x8 kfn[2][2]; u32x2 vlon[4], vhin[4];
            LOAD_KV(kfn, vlon, vhin, kvnext);
            const bool masked = blk >= nA; const int kpos0 = 32 * (lo + blk - nA) + 4 * lg;
            bf16x8 vf[4];
#pragma unroll
            for (int dt = 0; dt < 4; ++dt) { u32x4 w; w.x = vlo[dt].x; w.y = vlo[dt].y; w.z = vhi[dt].x; w.w = vhi[dt].y; vf[dt] = __builtin_bit_cast(bf16x8, w); }
#pragma unroll
            for (int qt = 0; qt < 4; ++qt) {
                f32x4 s0 = (f32x4){0.f, 0.f, 0.f, 0.f}, s1 = (f32x4){0.f, 0.f, 0.f, 0.f};
                s0 = __builtin_amdgcn_mfma_f32_16x16x32_bf16(kf[0][0], qf[qt][0], s0, 0, 0, 0); s0 = __builtin_amdgcn_mfma_f32_16x16x32_bf16(kf[0][1], qf[qt][1], s0, 0, 0, 0);
                s1 = __builtin_amdgcn_mfma_f32_16x16x32_bf16(kf[1][0], qf[qt][0], s1, 0, 0, 0); s1 = __builtin_amdgcn_mfma_f32_16x16x32_bf16(kf[1][1], qf[qt][1], s1, 0, 0, 0);
                if (masked) { const int qpos = q0 + l15;
#pragma unroll
                    for (int r = 0; r < 4; ++r) { const int d0 = kpos0 + r - qpos, d1 = d0 + 16;
                        if (d0 > 128 || d0 < -128) s0[r] = -1e30f; if (d1 > 128 || d1 < -128) s1[r] = -1e30f; } }
                float mx = fmaxf(fmaxf(fmaxf(s0[0], s0[1]), fmaxf(s0[2], s0[3])), fmaxf(fmaxf(s1[0], s1[1]), fmaxf(s1[2], s1[3])));
                mx = fmaxf(mx, __shfl_xor(mx, 16)); mx = fmaxf(mx, __shfl_xor(mx, 32));
                const float mnew = fmaxf(mrun[qt], mx), al = __builtin_amdgcn_exp2f(mrun[qt] - mnew); mrun[qt] = mnew;
                float ps = 0.f;
#pragma unroll
                for (int r = 0; r < 4; ++r) { s0[r] = __builtin_amdgcn_exp2f(s0[r] - mnew); s1[r] = __builtin_amdgcn_exp2f(s1[r] - mnew); ps += s0[r] + s1[r]; }
                lsum[qt] = lsum[qt] * al + ps;
                u32x4 pw; pw.x = cvt_pk_bf16(s0[0], s0[1]); pw.y = cvt_pk_bf16(s0[2], s0[3]); pw.z = cvt_pk_bf16(s1[0], s1[1]); pw.w = cvt_pk_bf16(s1[2], s1[3]);
                const bf16x8 pf = __builtin_bit_cast(bf16x8, pw);
#pragma unroll
                for (int dt = 0; dt < 4; ++dt) { oacc[qt][dt] = oacc[qt][dt] * al; oacc[qt][dt] = __builtin_amdgcn_mfma_f32_16x16x32_bf16(vf[dt], pf, oacc[qt][dt], 0, 0, 0); }
            }
#pragma unroll
            for (int kt = 0; kt < 2; ++kt)
#pragma unroll
                for (int ks = 0; ks < 2; ++ks) kf[kt][ks] = kfn[kt][ks];
#pragma unroll
            for (int dt = 0; dt < 4; ++dt) { vlo[dt] = vlon[dt]; vhi[dt] = vhin[dt]; }
        }
#undef LOAD_KV
#pragma unroll
        for (int qt = 0; qt < 4; ++qt) { float lt = lsum[qt]; lt += __shfl_xor(lt, 16); lt += __shfl_xor(lt, 32);
            if (type == 1) lt += __builtin_amdgcn_exp2f(sinkp[4 * g + qt] * LOG2E - mrun[qt]);
            const float inv = 1.0f / lt;
            bf16_t* op = O + (size_t)(rowbase + l15) * 1024 + qcol + 64 * qt + 4 * lg;
#pragma unroll
            for (int dt = 0; dt < 4; ++dt) { u32x2 w; w.x = cvt_pk_bf16(oacc[qt][dt][0] * inv, oacc[qt][dt][1] * inv); w.y = cvt_pk_bf16(oacc[qt][dt][2] * inv, oacc[qt][dt][3] * inv);
                *(u32x2*)(op + 16 * dt) = w; } }
    }
}

__global__ void __launch_bounds__(NTHR, 2) trunk_fwd(KArgs a) {
    extern __shared__ __attribute__((aligned(16))) unsigned char lds_raw[];
    LAS unsigned char* lds = (LAS unsigned char*)lds_raw;
    cg::grid_group grid = cg::this_grid();
    unsigned char* ws = a.ws; unsigned char* WB = ws + OFF_W;
    for (int si = a.step_lo; si < a.step_hi; ++si) {
        int tid = threadIdx.x; asm volatile("" : "+v"(tid));
        const int st = a.steps[si], kind = st & 0xff, l = (st >> 8) & 0xf, arg = (st >> 12) & 0xf, jl = l >> 1;
        const int Mrows = (l == 3) ? ML : MALL;
#ifdef ONLY
        if (kind != ONLY) continue;
#endif
        switch (kind) {
        case K_PROLOGUE: phase_prologue(a, tid, lds); break;
        case K_MOD0: phase_ln(a, tid, 0, 0); break;
        case K_LN: phase_ln(a, tid, l, arg); break;
        case K_GEMM_EVIN: {
            pg8::Gemm g{(const bf16_t*)(ws + OFF_R2), (const bf16_t*)(WB + W_EV_IN) + (size_t)jl * 3072 * 1024, MALL, 3072, 1024, 1024, 0};
            pg8::StaticOrder S; S.init(MALL, 3072, gridDim.x, blockIdx.x);
            EpiStore E{(bf16_t*)(ws + OFF_Z), 3072, 8};
            pg8::gemm_phase<EpiStore, true>(tid, lds, g, S, E); break; }
        case K_GEMM_PLAIN: {
            pg8::Gemm g; EpiStore E; int M_, N_;
            if (arg == PL_EVOUT) { g = pg8::Gemm{(const bf16_t*)(ws + OFF_Z), (const bf16_t*)(WB + W_EV_OUT) + (size_t)jl * 1024 * 1536, MALL, 1024, 1536, 3072, 0}; M_ = MALL; N_ = 1024; E = EpiStore{(bf16_t*)(ws + OFF_R2 + SZ_ROWS_BF), 1024, 0}; }
            else if (arg == PL_ODIN) { g = pg8::Gemm{(const bf16_t*)(ws + OFF_R2), (const bf16_t*)(WB + W_OD_IN) + (size_t)jl * 1536 * 1024, MALL, 1536, 1024, 1024, 0}; M_ = MALL; N_ = 1536; E = EpiStore{(bf16_t*)(ws + OFF_Z + ZO_QKV), 1536, 0}; }
            else if (arg == PL_ODOUT) { g = pg8::Gemm{(const bf16_t*)(ws + OFF_Z + ZO_O), (const bf16_t*)(WB + W_OD_OUT) + (size_t)jl * 1024 * 1024, Mrows, 1024, 1024, 1024, 0}; M_ = Mrows; N_ = 1024; E = EpiStore{(bf16_t*)(ws + OFF_R2 + SZ_ROWS_BF), 1024, 0}; }
            else { g = pg8::Gemm{(const bf16_t*)(ws + OFF_Z), (const bf16_t*)(WB + W_FFN_OUT) + (size_t)l * 1024 * 2816, Mrows, 1024, 2816, 2816, 0}; M_ = Mrows; N_ = 1024; E = EpiStore{(bf16_t*)(ws + OFF_R2 + SZ_ROWS_BF), 1024, 0}; }
            pg8::StaticOrder S; S.init(M_, N_, gridDim.x, blockIdx.x);
            pg8::gemm_phase<EpiStore, true>(tid, lds, g, S, E); break; }
        case K_GEMM_SWIGLU: {
            pg8::Gemm g{(const bf16_t*)(ws + OFF_R2), (const bf16_t*)(WB + W_FFN_IN) + (size_t)l * 5632 * 1024, Mrows, 5632, 1024, 1024, 0};
            pg8::StaticOrder S; S.init(Mrows, 5632, gridDim.x, blockIdx.x);
            EpiSwiglu E{(bf16_t*)(ws + OFF_Z), 2816};
            pg8::gemm_phase<EpiSwiglu, true>(tid, lds, g, S, E); break; }
        case K_GEMM_GATE: {
            const int d = arg;
            pg8::Gemm g{(const bf16_t*)((unsigned char*)a.out + DO_XC), (const bf16_t*)(WB + W_GATE) + (size_t)jl * (2 * 8 * 256 * 128) + (size_t)d * 8 * 256 * 128, MALL, 2048, 128, 1024, 256};
            pg8::StaticOrder S; S.init(MALL, 2048, gridDim.x, blockIdx.x);
            EpiGate E{(bf16_t*)(ws + OFF_R2), (bf16_t*)(ws + OFF_R2 + SZ_ROWS_BF), (const bf16_t*)((unsigned char*)a.out + DO_XC),
                      a.in[17] + (size_t)((jl * 2 + d) * 2 + 0) * 1024, a.in[17] + (size_t)((jl * 2 + d) * 2 + 1) * 1024, (const float*)(ws + OFF_SPL) + (size_t)(jl * 2 + d) * 1024};
            pg8::gemm_phase<EpiGate, true>(tid, lds, g, S, E); break; }
        case K_CONV_GMLP: phase_conv_gmlp(a, tid, jl, lds); break;
        case K_SCAN1: phase_scan(a, tid, arg, 1); break;
        case K_CARRY: phase_carry(a, tid); break;
        case K_SCAN2: phase_scan(a, tid, arg, 2); break;
        case K_QKPOST: phase_qkpost(a, tid, jl); break;
        case K_ATTN: phase_attn(a, tid, jl, l != 3); break;
        case K_DUMP: {
            const float* H = (const float*)(ws + OFF_H); const bf16_t* A_ = (const bf16_t*)(ws + OFF_R2); const bf16_t* Y_ = (const bf16_t*)(ws + OFF_R2 + SZ_ROWS_BF); const bf16_t* Z_ = (const bf16_t*)(ws + OFF_Z);
            for (size_t i = (size_t)blockIdx.x * NTHR + tid; i < (size_t)ML * 1024; i += (size_t)gridDim.x * NTHR) { const size_t row = i >> 10, c = i & 1023;
                a.out[i] = H[i] + bf_lo(A_[i]) + bf_lo(Y_[i]) + bf_lo(Z_[row * 3072 + c]) + bf_lo(Z_[row * 3072 + 1024 + c]) + bf_lo(Z_[row * 3072 + 2048 + c]); }
            break; }
        default: break;
        }
        if (si + 1 < a.step_hi) grid.sync();
    }
}

extern "C" void kernel_launch(void* const* d_in, const int* in_sizes, int n_in, void* d_out, int out_size, void* d_ws, size_t ws_size, hipStream_t stream) {
    static int grid = 0;
    if (grid == 0) {
        if (n_in != 26 || out_size != ML * 1024 || ws_size < WS_NEED) { fprintf(stderr, "kernel_launch: unexpected problem (n_in %d out %d ws %zu need %zu)\n", n_in, out_size, ws_size, (size_t)WS_NEED); grid = -1; return; }
        int dev = 0, cus = 0, per_cu = 0;
        (void)hipGetDevice(&dev); (void)hipDeviceGetAttribute(&cus, hipDeviceAttributeMultiprocessorCount, dev);
        if (hipFuncSetAttribute((const void*)trunk_fwd, hipFuncAttributeMaxDynamicSharedMemorySize, LDS_BYTES) != hipSuccess) fprintf(stderr, "kernel_launch: hipFuncSetAttribute failed\n");
        if (hipOccupancyMaxActiveBlocksPerMultiprocessor(&per_cu, (const void*)trunk_fwd, NTHR, LDS_BYTES) != hipSuccess || per_cu < 1) { fprintf(stderr, "kernel_launch: occupancy query says %d\n", per_cu); per_cu = 1; }
        (void)hipGetLastError();
        if (per_cu > 1) per_cu = 1;
        grid = cus * per_cu;
    }
    if (grid < 0) return;
    KArgs a{};
    for (int i = 0; i < 26; ++i) a.in[i] = (const float*)d_in[i];
    a.out = (float*)d_out; a.ws = (unsigned char*)d_ws;
    int n = 0;
#define STEP(kind, l, arg) a.steps[n++] = (kind) | ((l) << 8) | ((arg) << 12)
    STEP(K_PROLOGUE, 0, 0); STEP(K_MOD0, 0, 0);
    for (int l = 0; l < 4; ++l) {
        if ((l & 1) == 0) {
            STEP(K_GEMM_EVIN, l, 0); STEP(K_CONV_GMLP, l, 0);
            for (int d = 0; d < 2; ++d) { STEP(K_GEMM_GATE, l, d); STEP(K_SCAN1, l, d); STEP(K_CARRY, l, d); STEP(K_SCAN2, l, d); }
            STEP(K_GEMM_PLAIN, l, PL_EVOUT);
        } else {
            STEP(K_GEMM_PLAIN, l, PL_ODIN); STEP(K_QKPOST, l, 0); STEP(K_ATTN, l, 0); STEP(K_GEMM_PLAIN, l, PL_ODOUT);
        }
        STEP(K_LN, l, 1); STEP(K_GEMM_SWIGLU, l, 0); STEP(K_GEMM_PLAIN, l, PL_FFNOUT); STEP(K_LN, l, 2);
    }
#undef STEP
#ifdef TRUNC
    n = TRUNC; a.steps[n++] = K_DUMP;
#endif
    a.step_lo = 0; a.step_hi = n;
    void* args[] = {&a};
#ifndef FORCE_MULTI
#define FORCE_MULTI 0
#endif
    hipError_t e = FORCE_MULTI ? hipErrorUnknown : hipLaunchCooperativeKernel((const void*)trunk_fwd, dim3(grid), dim3(NTHR), args, LDS_BYTES, stream);
    if (e != hipSuccess) {
        if (!FORCE_MULTI) fprintf(stderr, "kernel_launch: cooperative launch failed: %s (grid %d); falling back to one launch per step\n", hipGetErrorString(e), grid);
        (void)hipGetLastError();
        for (int s = 0; s < n; ++s) { a.step_lo = s; a.step_hi = s + 1; hipLaunchKernelGGL(trunk_fwd, dim3(grid), dim3(NTHR), LDS_BYTES, stream, a); }
    }
}
```

```cpp
#include <hip/hip_runtime.h>
#include <hip/hip_cooperative_groups.h>
#include <cstdio>
#include <cstdint>
#include <hip/hip_bf16.h>
#include <cmath>
namespace cg = cooperative_groups;

#define LAS __attribute__((address_space(3)))
typedef unsigned short bf16_t;
typedef short bf16x8 __attribute__((ext_vector_type(8)));
typedef float f32x4 __attribute__((ext_vector_type(4)));
typedef float f32x2 __attribute__((ext_vector_type(2)));
typedef unsigned u32x4 __attribute__((ext_vector_type(4)));
typedef unsigned u32x2 __attribute__((ext_vector_type(2)));

constexpr int DM = 1024, NB = 8, SEQ = 8192, CTXL = 256, ML = NB * SEQ, MC = NB * CTXL, MALL = ML + MC, FH = 2816, KVR = SEQ + CTXL;
constexpr int NTHR = 512, NWAVE = 8;
constexpr int LDS_BYTES = 131072 + 2048;
constexpr float ALPHA = 1.681792830507429f, LOG2E = 1.4426950408889634f;
constexpr float QSCALE = 0.125f * 1.4426950408889634f;

constexpr size_t SZ_ROWS_BF = (size_t)MALL * 1024 * 2;
constexpr size_t OFF_H = 0;
constexpr size_t OFF_W = OFF_H + (size_t)MALL * 1024 * 4;
constexpr size_t W_FFN_IN = 0;
constexpr size_t W_FFN_OUT = W_FFN_IN + 4ull * 5632 * 1024 * 2;
constexpr size_t W_EV_IN = W_FFN_OUT + 4ull * 1024 * 2816 * 2;
constexpr size_t W_EV_OUT = W_EV_IN + 2ull * 3072 * 1024 * 2;
constexpr size_t W_GATE = W_EV_OUT + 2ull * 1024 * 1536 * 2;
constexpr size_t W_OD_IN = W_GATE + 2ull * 2 * 8 * 256 * 128 * 2;
constexpr size_t W_OD_OUT = W_OD_IN + 2ull * 1536 * 1024 * 2;
constexpr size_t W_END = W_OD_OUT + 2ull * 1024 * 1024 * 2;
constexpr size_t OFF_MOD = OFF_W + W_END;
constexpr size_t OFF_Z = OFF_MOD + 4ull * 9 * 6144 * 4;
constexpr size_t OFF_R2 = OFF_Z + (size_t)MALL * 3072 * 2;
constexpr size_t OFF_SPL = OFF_R2 + 2 * SZ_ROWS_BF;
constexpr size_t WS_NEED = OFF_SPL + 16384;
constexpr size_t ZO_QKV = 0;
constexpr size_t ZO_O = (size_t)MALL * 1536 * 2;
constexpr size_t ZO_KK = ZO_O + SZ_ROWS_BF;
constexpr size_t ZO_VT = ZO_KK + 2ull * 8 * 2 * KVR * 64 * 2;
constexpr size_t DO_VV = 0;
constexpr size_t DO_XC = 0;
constexpr size_t DO_SUMM = SZ_ROWS_BF;
constexpr size_t DO_CARRY = DO_SUMM + 8ull * 264 * 1024 * 8;

struct KArgs {
    const float* in[26];
    float* out; unsigned char* ws;
    int step_lo, step_hi;
    int steps[64];
};
enum { K_PROLOGUE = 0, K_MOD0, K_GEMM_EVIN, K_CONV_GMLP, K_GEMM_GATE, K_SCAN1, K_CARRY, K_SCAN2, K_GEMM_PLAIN, K_LN, K_GEMM_SWIGLU, K_QKPOST, K_ATTN, K_DUMP };
enum { PL_EVOUT = 0, PL_ODIN, PL_ODOUT, PL_FFNOUT };

typedef __bf16 bf16x2_t __attribute__((ext_vector_type(2)));
__device__ __forceinline__ unsigned cvt_pk_bf16(float lo, float hi) { f32x2 v = {lo, hi}; bf16x2_t b = __builtin_convertvector(v, bf16x2_t); return __builtin_bit_cast(unsigned, b); }
__device__ __forceinline__ float bf_lo(unsigned w) { return __uint_as_float(w << 16); }
__device__ __forceinline__ float bf_hi(unsigned w) { return __uint_as_float(w & 0xffff0000u); }
__device__ __forceinline__ float fast_sigmoid(float x) { return __builtin_amdgcn_rcpf(1.0f + __builtin_amdgcn_exp2f(-x * LOG2E)); }
__device__ __forceinline__ float silu_f(float x) { return x * fast_sigmoid(x); }
__device__ __forceinline__ float gelu_tanh(float x) { const float u = x + 0.044715f * x * x * x; return x * __builtin_amdgcn_rcpf(1.0f + __builtin_amdgcn_exp2f(-2.0f * 0.7978845608028654f * LOG2E * u)); }
__device__ __forceinline__ float wave_sum(float v) {
#pragma unroll
    for (int o = 1; o < 64; o <<= 1) v += __shfl_xor(v, o);
    return v;
}

namespace pg8 {
constexpr int BM = 256, BK = 64, HALF = 128, HTB = HALF * BK * 2, STAGE_BYTES = 8 * HTB, NXCD = 8, WGM = 8;
__host__ __device__ __forceinline__ int lds_byte(int r, int c) { const int st = (r >> 4) * 2 + (c >> 5), rr = r & 15, cc = c & 31, ob = rr * 64 + cc * 2; return st * 1024 + (ob ^ (((ob >> 9) & 1) << 5)); }
__host__ __device__ __forceinline__ void stage_rc(int b, int& R, int& C) { const int st = b / 1024, sb = b % 1024, swz = sb ^ (((sb >> 9) & 1) << 5); R = (st >> 1) * 16 + swz / 64; C = (st & 1) * 32 + (swz % 64) / 2; }
__host__ __device__ __forceinline__ int perm32(int rho) { const int n = rho >> 4, i = rho & 15; return 8 * (i >> 2) + 4 * n + (i & 3); }
struct Unit { int pm, pn; };
struct Gemm { const bf16_t* A; const bf16_t* Bt; int M, N, K, lda, a_pn_off; };
struct StaticOrder {
    int nM, nN, nwg, G, c;
    __device__ void init(int M, int N, int G_, int c_) { nM = M / BM; nN = N / BM; nwg = nM * nN; G = G_; c = c_; }
    __device__ bool next(int i, Unit& u) const {
        const long L = (long)i * G + c; if (L >= nwg) return false;
        int wgid = (int)L; { const int q = nwg / NXCD, r = nwg % NXCD, xcd = wgid % NXCD, off = wgid / NXCD; wgid = (xcd < r ? xcd * (q + 1) : r * (q + 1) + (xcd - r) * q) + off; }
        const int nig = WGM * nN, gid = wgid / nig, fm = gid * WGM, gsz = (nM - fm) < WGM ? (nM - fm) : WGM;
        u.pm = fm + ((wgid % nig) % gsz); u.pn = (wgid % nig) / gsz; return true;
    }
};
template <class Epi, bool ALIGN_EPI>
__device__ __forceinline__ void gemm_phase(int tid, LAS unsigned char* lds, const Gemm g, const StaticOrder& S, const Epi& E) {
    const int wid = __builtin_amdgcn_readfirstlane(tid >> 6), lane = tid & 63, wr = wid >> 2, wc = wid & 3, fr = lane & 15, fq = lane >> 4;
    const int K = g.K, nt = K / BK;
    unsigned voffA[2], voffB[2];
#pragma unroll
    for (int i = 0; i < 2; ++i) { int R, C; stage_rc(tid * 16 + i * 8192, R, C); const int Rb = Epi::PERM ? ((R & ~31) + perm32(R & 31)) : R;
        voffA[i] = (unsigned)(R * g.lda + C) * 2u; voffB[i] = (unsigned)(Rb * K + C) * 2u; }
    const size_t kstep = (size_t)(BK * 2);
    const size_t hstepA = (size_t)HALF * g.lda * 2, hstepB = (size_t)HALF * K * 2;
    const size_t tstepA = 2 * hstepA, tstepB = 2 * hstepB;
    const unsigned ldsw = (unsigned)wid * 1024u;
    const int aoff = lds_byte(wr * 64 + fr, fq * 8), boff = lds_byte(wc * 32 + fr, fq * 8);
#define PG8_SA(b, h) (((b) * 2 + (h)) * HTB)
#define PG8_SB(b, h) ((4 + (b) * 2 + (h)) * HTB)
#define PG8_STAGE(bufoff, gbase, voff) do { _Pragma("unroll") for (int _i = 0; _i < 2; ++_i) \
        __builtin_amdgcn_global_load_lds((const unsigned*)((const char*)(gbase) + (voff)[_i]), (LAS unsigned*)(lds + (bufoff) + ldsw + _i * 8192), 16, 0, 0); } while (0)
#define PG8_LDA(dst, b, h) do { _Pragma("unroll") for (int m = 0; m < 4; ++m) _Pragma("unroll") for (int k = 0; k < 2; ++k) dst[m][k] = *(const LAS bf16x8*)(lds + PG8_SA(b, h) + aoff + m * 2048 + k * 1024); } while (0)
#define PG8_LDB(dst, b, h) do { _Pragma("unroll") for (int n = 0; n < 2; ++n) _Pragma("unroll") for (int k = 0; k < 2; ++k) dst[n][k] = *(const LAS bf16x8*)(lds + PG8_SB(b, h) + boff + n * 2048 + k * 1024); } while (0)
#define PG8_MMA(ai, bj, At, Bt) do { __builtin_amdgcn_s_setprio(1); _Pragma("unroll") for (int m = 0; m < 4; ++m) _Pragma("unroll") for (int n = 0; n < 2; ++n) _Pragma("unroll") for (int k = 0; k < 2; ++k) \
        acc[ai][bj][m][n] = __builtin_amdgcn_mfma_f32_16x16x32_bf16(Bt[n][k], At[m][k], acc[ai][bj][m][n], 0, 0, 0); __builtin_amdgcn_s_setprio(0); } while (0)
#define PG8_WAIT_V(n) asm volatile("s_waitcnt vmcnt(" #n ")" ::: "memory")
#define PG8_WAIT_L(n) asm volatile("s_waitcnt lgkmcnt(" #n ")" ::: "memory")
#define PG8_BAR __builtin_amdgcn_s_barrier()
#define PG8_SCHED __builtin_amdgcn_sched_barrier(0)
    Unit cur, nxt; int ui = 0;
    if (!S.next(0, cur)) return;
    f32x4 acc[2][2][4][2];
#pragma unroll
    for (int a = 0; a < 2; ++a)
#pragma unroll
        for (int b = 0; b < 2; ++b)
#pragma unroll
            for (int m = 0; m < 4; ++m)
#pragma unroll
                for (int n = 0; n < 2; ++n) acc[a][b][m][n] = (f32x4){0.f, 0.f, 0.f, 0.f};
    bf16x8 At[4][2], B0[2][2], B1[2][2];
    const char* cA = (const char*)g.A + (size_t)cur.pm * tstepA + (size_t)cur.pn * (size_t)g.a_pn_off; const char* cB = (const char*)g.Bt + (size_t)cur.pn * tstepB;
    PG8_STAGE(PG8_SB(0, 0), cB, voffB); PG8_STAGE(PG8_SB(0, 1), cB + hstepB, voffB); PG8_STAGE(PG8_SA(0, 0), cA, voffA); PG8_STAGE(PG8_SA(0, 1), cA + hstepA, voffA);
    if (wr == 1) PG8_BAR;
    PG8_WAIT_V(2); PG8_BAR;
    PG8_STAGE(PG8_SB(1, 0), cB + kstep, voffB); PG8_STAGE(PG8_SA(1, 0), cA + kstep, voffA); PG8_STAGE(PG8_SB(1, 1), cB + hstepB + kstep, voffB);
    PG8_WAIT_V(6); PG8_BAR;
    for (;;) {
        const bool has_next = S.next(ui + 1, nxt);
        const char* nA = has_next ? (const char*)g.A + (size_t)nxt.pm * tstepA + (size_t)nxt.pn * (size_t)g.a_pn_off : cA; const char* nB = has_next ? (const char*)g.Bt + (size_t)nxt.pn * tstepB : cB;
        for (int t = 0; t < nt; t += 2) {
            const bool last = (t == nt - 2);
            const char* a1 = cA + (size_t)(t + 1) * kstep;
            const char* a2 = last ? nA : cA + (size_t)(t + 2) * kstep; const char* b2 = last ? nB : cB + (size_t)(t + 2) * kstep;
            const char* a3 = a2 + kstep; const char* b3 = b2 + kstep;
            PG8_LDB(B0, 0, 0); PG8_LDB(B1, 0, 1); PG8_SCHED; PG8_LDA(At, 0, 0); PG8_STAGE(PG8_SA(1, 1), a1 + hstepA, voffA);
            PG8_WAIT_V(8); PG8_WAIT_L(0); PG8_BAR; PG8_MMA(0, 0, At, B0); PG8_MMA(0, 1, At, B1); PG8_BAR; PG8_SCHED;
            PG8_LDA(At, 0, 1); PG8_STAGE(PG8_SB(0, 0), b2, voffB); PG8_STAGE(PG8_SB(0, 1), b2 + hstepB, voffB); PG8_STAGE(PG8_SA(0, 0), a2, voffA);
            PG8_WAIT_V(8); PG8_WAIT_L(0); PG8_BAR; PG8_MMA(1, 0, At, B0); PG8_MMA(1, 1, At, B1); PG8_BAR; PG8_SCHED;
            PG8_LDB(B0, 1, 0); PG8_LDB(B1, 1, 1); PG8_SCHED; PG8_LDA(At, 1, 0); PG8_STAGE(PG8_SA(0, 1), a2 + hstepA, voffA);
            PG8_WAIT_V(8); PG8_WAIT_L(0); PG8_BAR; PG8_MMA(0, 0, At, B0); PG8_MMA(0, 1, At, B1); PG8_BAR; PG8_SCHED;
            PG8_LDA(At, 1, 1); PG8_STAGE(PG8_SB(1, 0), b3, voffB); PG8_STAGE(PG8_SB(1, 1), b3 + hstepB, voffB); PG8_STAGE(PG8_SA(1, 0), a3, voffA);
            PG8_WAIT_V(8); PG8_WAIT_L(0); PG8_BAR; PG8_MMA(1, 0, At, B0); PG8_MMA(1, 1, At, B1); PG8_BAR; PG8_SCHED;
        }
        if constexpr (ALIGN_EPI) { if (wr == 0) PG8_BAR; }
        E(acc, cur, wr, wc, fr, fq);
        if (!has_next) break;
#pragma unroll
        for (int a = 0; a < 2; ++a)
#pragma unroll
            for (int b = 0; b < 2; ++b)
#pragma unroll
                for (int m = 0; m < 4; ++m)
#pragma unroll
                    for (int n = 0; n < 2; ++n) acc[a][b][m][n] = (f32x4){0.f, 0.f, 0.f, 0.f};
        cur = nxt; cA = nA; cB = nB; ++ui;
        if constexpr (ALIGN_EPI) { if (wr == 1) PG8_BAR; }
    }
    PG8_WAIT_V(0);
    if constexpr (!ALIGN_EPI) { if (wr == 0) PG8_BAR; }
    PG8_BAR;
#undef PG8_SA
#undef PG8_SB
#undef PG8_STAGE
#undef PG8_LDA
#undef PG8_LDB
#undef PG8_MMA
#undef PG8_WAIT_V
#undef PG8_WAIT_L
#undef PG8_BAR
#undef PG8_SCHED
}
}

struct EpiStore {
    static constexpr bool PERM = true;
    bf16_t* O; int ldc; int gelu_tiles;
    __device__ __forceinline__ void operator()(const f32x4 (&acc)[2][2][4][2], const pg8::Unit& u, int wr, int wc, int fr, int fq) const {
        const int row0 = u.pm * 256 + wr * 64 + fr, col0 = u.pn * 256 + wc * 32 + 8 * fq; const bool act = u.pn < gelu_tiles;
#pragma unroll
        for (int ai = 0; ai < 2; ++ai)
#pragma unroll
            for (int m = 0; m < 4; ++m) { bf16_t* rowp = O + (size_t)(row0 + ai * 128 + m * 16) * ldc + col0;
#pragma unroll
                for (int bj = 0; bj < 2; ++bj) { f32x4 v0 = acc[ai][bj][m][0], v1 = acc[ai][bj][m][1];
                    if (act) {
#pragma unroll
                        for (int e = 0; e < 4; ++e) { v0[e] = gelu_tanh(v0[e]); v1[e] = gelu_tanh(v1[e]); } }
                    u32x4 w; w.x = cvt_pk_bf16(v0[0], v0[1]); w.y = cvt_pk_bf16(v0[2], v0[3]); w.z = cvt_pk_bf16(v1[0], v1[1]); w.w = cvt_pk_bf16(v1[2], v1[3]);
                    *(u32x4*)(rowp + bj * 128) = w; } }
    }
};
struct EpiSwiglu {
    static constexpr bool PERM = true;
    bf16_t* O; int ldc;
    __device__ __forceinline__ void operator()(const f32x4 (&acc)[2][2][4][2], const pg8::Unit& u, int wr, int wc, int fr, int fq) const {
        const int row0 = u.pm * 256 + wr * 64 + fr, col0 = u.pn * 128 + wc * 32 + 8 * fq;
#pragma unroll
        for (int ai = 0; ai < 2; ++ai)
#pragma unroll
            for (int m = 0; m < 4; ++m) { bf16_t* rowp = O + (size_t)(row0 + ai * 128 + m * 16) * ldc + col0;
                f32x4 v0, v1;
#pragma unroll
                for (int e = 0; e < 4; ++e) { v0[e] = silu_f(acc[ai][0][m][0][e]) * acc[ai][1][m][0][e]; v1[e] = silu_f(acc[ai][0][m][1][e]) * acc[ai][1][m][1][e]; }
                u32x4 w; w.x = cvt_pk_bf16(v0[0], v0[1]); w.y = cvt_pk_bf16(v0[2], v0[3]); w.z = cvt_pk_bf16(v1[0], v1[1]); w.w = cvt_pk_bf16(v1[2], v1[3]);
                *(u32x4*)rowp = w; }
    }
};
struct EpiGate {
    static constexpr bool PERM = true;
    bf16_t* LA; bf16_t* BBo; const bf16_t* XC; const float* gb_r; const float* gb_i; const float* spl;
    __device__ __forceinline__ void operator()(const f32x4 (&acc)[2][2][4][2], const pg8::Unit& u, int wr, int wc, int fr, int fq) const {
        const int row0 = u.pm * 256 + wr * 64 + fr, ch0 = u.pn * 128 + wc * 32 + 8 * fq;
#pragma unroll
        for (int ai = 0; ai < 2; ++ai)
#pragma unroll
            for (int m = 0; m < 4; ++m) { const size_t off = (size_t)(row0 + ai * 128 + m * 16) * 1024 + ch0;
                const u32x4 xw = *(const u32x4*)(XC + off);
                u32x4 w1, w2;
#pragma unroll
                for (int n = 0; n < 2; ++n) {
                    const f32x4 br = *(const f32x4*)(gb_r + ch0 + 4 * n), bi = *(const f32x4*)(gb_i + ch0 + 4 * n), sp = *(const f32x4*)(spl + ch0 + 4 * n);
                    const unsigned xa = n == 0 ? xw.x : xw.z, xb = n == 0 ? xw.y : xw.w;
                    const float xv[4] = {bf_lo(xa), bf_hi(xa), bf_lo(xb), bf_hi(xb)};
                    float la[4], bb[4];
#pragma unroll
                    for (int e = 0; e < 4; ++e) { const float gr = acc[ai][0][m][n][e] + br[e], gi = acc[ai][1][m][n][e] + bi[e];
                        const float l_ = sp[e] * fast_sigmoid(gr); la[e] = l_;
                        const float om = fmaxf(0.0f, 1.0f - __builtin_amdgcn_exp2f(2.0f * LOG2E * l_)); bb[e] = __builtin_amdgcn_sqrtf(om) * fast_sigmoid(gi) * xv[e]; }
                    if (n == 0) { w1.x = cvt_pk_bf16(la[0], la[1]); w1.y = cvt_pk_bf16(la[2], la[3]); w2.x = cvt_pk_bf16(bb[0], bb[1]); w2.y = cvt_pk_bf16(bb[2], bb[3]); }
                    else { w1.z = cvt_pk_bf16(la[0], la[1]); w1.w = cvt_pk_bf16(la[2], la[3]); w2.z = cvt_pk_bf16(bb[0], bb[1]); w2.w = cvt_pk_bf16(bb[2], bb[3]); }
                }
                *(u32x4*)(LA + off) = w1; *(u32x4*)(BBo + off) = w2; }
    }
};

__device__ __forceinline__ int colmap(int id, int n) {
    if (id == 1) { const int t = n >> 8, w = n & 255; return w < 128 ? t * 128 + w : FH + t * 128 + (w - 128); }
    if (id == 2) return n < 1024 ? n : (n < 2048 ? n + 1024 : n - 1024);
    return n;
}
__device__ __forceinline__ void tr_item(const float* W, int ldsrc, int K, bf16_t* WT, int n0, int k0, int mapid, LAS float* scr, int lane) {
    const int sc = colmap(mapid, n0 + (lane & 31));
#pragma unroll 8
    for (int i = 0; i < 32; ++i) { const int kk = 2 * i + (lane >> 5); scr[kk * 33 + (lane & 31)] = W[(size_t)(k0 + kk) * ldsrc + sc]; }
    asm volatile("s_waitcnt lgkmcnt(0)" ::: "memory");
    const int c = lane & 7;
#pragma unroll
    for (int j = 0; j < 4; ++j) { const int n = (lane >> 3) + 8 * j; const LAS float* s = scr + (8 * c) * 33 + n;
        u32x4 o; o.x = cvt_pk_bf16(s[0 * 33], s[1 * 33]); o.y = cvt_pk_bf16(s[2 * 33], s[3 * 33]); o.z = cvt_pk_bf16(s[4 * 33], s[5 * 33]); o.w = cvt_pk_bf16(s[6 * 33], s[7 * 33]);
        *(u32x4*)(WT + (size_t)(n0 + n) * K + k0 + 8 * c) = o; }
    asm volatile("s_waitcnt lgkmcnt(0)" ::: "memory");
}
__device__ __forceinline__ void phase_prologue(const KArgs& a, const int z, const int tid, LAS unsigned char* lds) {
    const int lane = tid & 63, wave = tid >> 6;
    LAS float* sv = (LAS float*)(lds + 73728);
    LAS float* part = (LAS float*)(lds + 110592);
    float* MOD = (float*)((a.ws + z) + OFF_MOD);
    for (int i = tid; i < 9 * 1024; i += NTHR) { const int s = i >> 10, k = i & 1023; const float v = s < 8 ? a.in[z + 1][s * 1024 + k] : a.in[z + 3][k]; sv[i] = v / (1.0f + __expf(-v)); }
    __syncthreads();
    for (int item = blockIdx.x; item < 384; item += gridDim.x) {
        const int l = item / 96, n0 = (item % 96) * 64;
        const float* w = a.in[z + 4] + (size_t)l * 1024 * 6144 + n0 + lane;
        float acc[9];
#pragma unroll
        for (int s = 0; s < 9; ++s) acc[s] = 0.f;
        const int k0 = wave * 128;
#pragma unroll 4
        for (int k = 0; k < 128; ++k) { const float wv = w[(size_t)(k0 + k) * 6144];
#pragma unroll
            for (int s = 0; s < 9; ++s) acc[s] += sv[s * 1024 + k0 + k] * wv; }
#pragma unroll
        for (int s = 0; s < 9; ++s) part[(wave * 9 + s) * 64 + lane] = acc[s];
        __syncthreads();
        for (int idx = tid; idx < 576; idx += NTHR) { const int s = idx >> 6, n = idx & 63; float r = a.in[z + 5][l * 6144 + n0 + n];
#pragma unroll
            for (int w8 = 0; w8 < 8; ++w8) r += part[(w8 * 9 + s) * 64 + n];
            MOD[(size_t)(l * 9 + s) * 6144 + n0 + n] = r; }
        __syncthreads();
    }
    for (int i = blockIdx.x * NTHR + tid; i < 4096; i += gridDim.x * NTHR) ((float*)((a.ws + z) + OFF_SPL))[i] = -8.0f * log1pf(__expf(-a.in[z + 18][i]));
    LAS float* scr = (LAS float*)(lds + wave * 8448);
    unsigned char* WB = (a.ws + z) + OFF_W;
    const int gw = blockIdx.x * NWAVE + wave, NGW = gridDim.x * NWAVE;
    for (int it = gw; it < 24576; it += NGW) {
        int r = it;
        if (r < 11264) { const int l = r / 2816, q = r % 2816, kb = q / 176, nb = q % 176;
            tr_item(a.in[z + 10] + (size_t)l * 1024 * 5632, 5632, 1024, (bf16_t*)(WB + W_FFN_IN) + (size_t)l * 5632 * 1024, nb * 32, kb * 64, 1, scr, lane); continue; }
        r -= 11264;
        if (r < 5632) { const int l = r / 1408, q = r % 1408, kb = q / 32, nb = q % 32;
            tr_item(a.in[z + 11] + (size_t)l * 2816 * 1024, 1024, 2816, (bf16_t*)(WB + W_FFN_OUT) + (size_t)l * 1024 * 2816, nb * 32, kb * 64, 0, scr, lane); continue; }
        r -= 5632;
        if (r < 3072) { const int j = r / 1536, q = r % 1536, kb = q / 96, nb = q % 96;
            tr_item(a.in[z + 12] + (size_t)j * 1024 * 3072, 3072, 1024, (bf16_t*)(WB + W_EV_IN) + (size_t)j * 3072 * 1024, nb * 32, kb * 64, 2, scr, lane); continue; }
        r -= 3072;
        if (r < 1536) { const int j = r / 768, q = r % 768, kb = q / 32, nb = q % 32;
            tr_item(a.in[z + 13] + (size_t)j * 1536 * 1024, 1024, 1536, (bf16_t*)(WB + W_EV_OUT) + (size_t)j * 1024 * 1536, nb * 32, kb * 64, 0, scr, lane); continue; }
        r -= 1536;
        if (r < 512) { const int blk = r >> 3, q = r & 7, kb = q >> 2, nb = q & 3; const int h = blk & 7, k = (blk >> 3) & 1, d = (blk >> 4) & 1, j = blk >> 5;
            tr_item(a.in[z + 16] + (size_t)blk * 16384, 128, 128, (bf16_t*)(WB + W_GATE) + (size_t)j * (2 * 8 * 256 * 128) + (size_t)((d * 8 + h) * 256 + k * 128) * 128, nb * 32, kb * 64, 0, scr, lane); continue; }
        r -= 512;
        if (r < 1536) { const int j = r / 768, q = r % 768, kb = q / 48, nb = q % 48;
            tr_item(a.in[z + 21] + (size_t)j * 1024 * 1536, 1536, 1024, (bf16_t*)(WB + W_OD_IN) + (size_t)j * 1536 * 1024, nb * 32, kb * 64, 0, scr, lane); continue; }
        r -= 1536;
        { const int j = r / 512, q = r % 512, kb = q / 32, nb = q % 32;
            tr_item(a.in[z + 22] + (size_t)j * 1024 * 1024, 1024, 1024, (bf16_t*)(WB + W_OD_OUT) + (size_t)j * 1024 * 1024, nb * 32, kb * 64, 0, scr, lane); }
    }
}

__device__ __forceinline__ void phase_ln(const KArgs& a, const int z, const int tid, int l, int which) {
    const int lane = tid & 63, wave = tid >> 6;
    const int gw = blockIdx.x * NWAVE + wave, NGW = gridDim.x * NWAVE;
    float* H = (float*)((a.ws + z) + OFF_H); const float* MOD = (const float*)((a.ws + z) + OFF_MOD);
    bf16_t* A = (bf16_t*)((a.ws + z) + OFF_R2); const bf16_t* Y = (const bf16_t*)((a.ws + z) + OFF_R2 + SZ_ROWS_BF);
    const bool final_ = (l == 3 && which == 2), from_in = (which == 0) || (which == 1 && l == 0);
    const int Mrows = (l == 3 && which != 0) ? ML : MALL;
    const float* gam = which == 1 ? a.in[z + 6] + l * 1024 : a.in[z + 8] + l * 1024; const float* bet = which == 1 ? a.in[z + 7] + l * 1024 : a.in[z + 9] + l * 1024;
    const int lm = which == 0 ? 0 : (which == 1 ? l : l + 1), shi = which == 1 ? 3 : 0, sci = which == 1 ? 4 : 1, gi = which == 1 ? 2 : 5;
    for (int row = gw; row < Mrows; row += NGW) {
        const int ms = row < ML ? (row >> 13) : 8;
        const float* src = from_in ? (row < ML ? a.in[z + 0] + (size_t)row * 1024 : a.in[z + 2] + (size_t)(row - ML) * 1024) : H + (size_t)row * 1024;
        f32x4 v[4];
#pragma unroll
        for (int j = 0; j < 4; ++j) v[j] = *(const f32x4*)(src + 4 * lane + 256 * j);
        if (which != 0) {
            const float* gp = MOD + (size_t)(l * 9 + ms) * 6144 + gi * 1024; float s = 0.f;
#pragma unroll
            for (int j = 0; j < 4; ++j) { const u32x2 yw = *(const u32x2*)(Y + (size_t)row * 1024 + 4 * lane + 256 * j); const f32x4 g = *(const f32x4*)(gp + 4 * lane + 256 * j);
                v[j][0] = ALPHA * v[j][0] + g[0] * bf_lo(yw.x); v[j][1] = ALPHA * v[j][1] + g[1] * bf_hi(yw.x); v[j][2] = ALPHA * v[j][2] + g[2] * bf_lo(yw.y); v[j][3] = ALPHA * v[j][3] + g[3] * bf_hi(yw.y);
                s += (v[j][0] + v[j][1]) + (v[j][2] + v[j][3]); }
            const float mean = wave_sum(s) * (1.0f / 1024.0f); float s2 = 0.f;
#pragma unroll
            for (int j = 0; j < 4; ++j) { v[j] = v[j] - mean; s2 += (v[j][0] * v[j][0] + v[j][1] * v[j][1]) + (v[j][2] * v[j][2] + v[j][3] * v[j][3]); }
            const float rstd = rsqrtf(wave_sum(s2) * (1.0f / 1024.0f) + 1e-6f);
            float* dst = final_ ? (a.out + z) + (size_t)row * 1024 : H + (size_t)row * 1024;
#pragma unroll
            for (int j = 0; j < 4; ++j) { const f32x4 gm = *(const f32x4*)(gam + 4 * lane + 256 * j), bt = *(const f32x4*)(bet + 4 * lane + 256 * j);
                v[j] = v[j] * rstd * gm + bt; *(f32x4*)(dst + 4 * lane + 256 * j) = v[j]; }
        }
        if (!final_) {
            const float* shp = MOD + (size_t)(lm * 9 + ms) * 6144 + shi * 1024; const float* scp = MOD + (size_t)(lm * 9 + ms) * 6144 + sci * 1024;
#pragma unroll
            for (int j = 0; j < 4; ++j) { const f32x4 sh = *(const f32x4*)(shp + 4 * lane + 256 * j), sc = *(const f32x4*)(scp + 4 * lane + 256 * j);
                const f32x4 o = v[j] * (sc + 1.0f) + sh; u32x2 w; w.x = cvt_pk_bf16(o[0], o[1]); w.y = cvt_pk_bf16(o[2], o[3]);
                *(u32x2*)(A + (size_t)row * 1024 + 4 * lane + 256 * j) = w; }
        }
    }
}

__device__ __forceinline__ void phase_conv_gmlp(const KArgs& a, const int z, const int tid, int jl, LAS unsigned char* lds) {
    const int lane = tid & 63, wave = tid >> 6;
    bf16_t* Z = (bf16_t*)((a.ws + z) + OFF_Z);
    LAS bf16_t* VNT = (LAS bf16_t*)lds;
    const float* Wsp = a.in[z + 19] + (size_t)jl * 4 * 128 * 128; const float* Bsp = a.in[z + 20] + (size_t)jl * 4 * 128;
    for (int item = blockIdx.x; item < 528 * 4; item += gridDim.x) {
        const int ci = item >> 2, g = item & 3;
        const int row0 = ci < 512 ? ci * 128 : ML + (ci - 512) * 128;
        for (int rr = 0; rr < 16; ++rr) { const int q = wave * 16 + rr;
            const u32x4 w = *(const u32x4*)(Z + (size_t)(row0 + q) * 3072 + 1536 + 8 * lane);
            float x[8] = {bf_lo(w.x), bf_hi(w.x), bf_lo(w.y), bf_hi(w.y), bf_lo(w.z), bf_hi(w.z), bf_lo(w.w), bf_hi(w.w)};
            float s = 0.f;
#pragma unroll
            for (int e = 0; e < 8; ++e) s += x[e];
            const float mean = wave_sum(s) * (1.0f / 512.0f); float s2 = 0.f;
#pragma unroll
            for (int e = 0; e < 8; ++e) { x[e] -= mean; s2 += x[e] * x[e]; }
            const float rstd = rsqrtf(wave_sum(s2) * (1.0f / 512.0f) + 1e-6f);
            if ((lane >> 4) == g) {
#pragma unroll
                for (int e = 0; e < 8; e += 2) { const unsigned pk = cvt_pk_bf16(x[e] * rstd, x[e + 1] * rstd);
                    VNT[(8 * (lane & 15) + e) * 136 + q] = (bf16_t)(pk & 0xffffu); VNT[(8 * (lane & 15) + e + 1) * 136 + q] = (bf16_t)(pk >> 16); } }
        }
        bf16x8 bfr[4];
        { const float* wp = Wsp + (size_t)(g * 128 + wave * 16 + (lane & 15)) * 128 + 8 * (lane >> 4);
#pragma unroll
          for (int ks = 0; ks < 4; ++ks) { const f32x4 w0 = *(const f32x4*)(wp + 32 * ks), w1 = *(const f32x4*)(wp + 32 * ks + 4);
              u32x4 p; p.x = cvt_pk_bf16(w0[0], w0[1]); p.y = cvt_pk_bf16(w0[2], w0[3]); p.z = cvt_pk_bf16(w1[0], w1[1]); p.w = cvt_pk_bf16(w1[2], w1[3]); bfr[ks] = __builtin_bit_cast(bf16x8, p); } }
        __syncthreads();
        const int p = wave * 16 + (lane & 15); const float bias = Bsp[g * 128 + p];
        bf16_t* urow = Z + (size_t)(row0 + p) * 3072 + 1024 + g * 128;
#pragma unroll
        for (int dt = 0; dt < 8; ++dt) {
            f32x4 acc = (f32x4){0.f, 0.f, 0.f, 0.f};
#pragma unroll
            for (int ks = 0; ks < 4; ++ks) { const bf16x8 af = *(const LAS bf16x8*)(VNT + (16 * dt + (lane & 15)) * 136 + 32 * ks + 8 * (lane >> 4));
                acc = __builtin_amdgcn_mfma_f32_16x16x32_bf16(af, bfr[ks], acc, 0, 0, 0); }
            bf16_t* up = urow + 16 * dt + 4 * (lane >> 4); const u32x2 uw = *(const u32x2*)up;
            u32x2 o; o.x = cvt_pk_bf16(bf_lo(uw.x) * (acc[0] + bias), bf_hi(uw.x) * (acc[1] + bias)); o.y = cvt_pk_bf16(bf_lo(uw.y) * (acc[2] + bias), bf_hi(uw.y) * (acc[3] + bias));
            *(u32x2*)up = o;
        }
        __syncthreads();
    }
    bf16_t* XC = (bf16_t*)((unsigned char*)(a.out + z) + DO_XC);
    const float* cw = a.in[z + 14] + (size_t)jl * 4 * 1024; const float* cb = a.in[z + 15] + (size_t)jl * 1024;
    for (int idx = blockIdx.x * NTHR + tid; idx < MALL * 128; idx += gridDim.x * NTHR) {
        const int row = idx >> 7, c0 = (idx & 127) * 8;
        int t, len; if (row < ML) { t = row & 8191; len = SEQ; } else { t = (row - ML) & 255; len = CTXL; }
        float o[8];
#pragma unroll
        for (int e = 0; e < 8; ++e) o[e] = cb[c0 + e];
#pragma unroll
        for (int k = 0; k < 4; ++k) { const int tt = t - 2 + k;
            if (tt >= 0 && tt < len) { const u32x4 w = *(const u32x4*)(Z + (size_t)(row - 2 + k) * 3072 + 2048 + c0);
                const f32x4 w0 = *(const f32x4*)(cw + k * 1024 + c0), w1 = *(const f32x4*)(cw + k * 1024 + c0 + 4);
                o[0] += bf_lo(w.x) * w0[0]; o[1] += bf_hi(w.x) * w0[1]; o[2] += bf_lo(w.y) * w0[2]; o[3] += bf_hi(w.y) * w0[3];
                o[4] += bf_lo(w.z) * w1[0]; o[5] += bf_hi(w.z) * w1[1]; o[6] += bf_lo(w.w) * w1[2]; o[7] += bf_hi(w.w) * w1[3]; } }
        u32x4 ow; ow.x = cvt_pk_bf16(o[0], o[1]); ow.y = cvt_pk_bf16(o[2], o[3]); ow.z = cvt_pk_bf16(o[4], o[5]); ow.w = cvt_pk_bf16(o[6], o[7]);
        *(u32x4*)(XC + (size_t)row * 1024 + c0) = ow;
    }
}

__device__ __forceinline__ int scan_row(int d, int b, int sc, int i) {
    if (d == 0) return sc < 8 ? ML + b * 256 + sc * 32 + i : b * SEQ + (sc - 8) * 32 + i;
    return sc < 8 ? ML + b * 256 + 255 - (sc * 32 + i) : b * SEQ + 8191 - ((sc - 8) * 32 + i);
}
__device__ __forceinline__ void phase_scan(const KArgs& a, const int z, const int tid, int d, int pass) {
    const bf16_t* LA = (const bf16_t*)((a.ws + z) + OFF_R2); const bf16_t* BBp = (const bf16_t*)((a.ws + z) + OFF_R2 + SZ_ROWS_BF);
    bf16_t* Z = (bf16_t*)((a.ws + z) + OFF_Z);
    float* SUMM = (float*)((unsigned char*)(a.out + z) + DO_SUMM); const float* CAR = (const float*)((unsigned char*)(a.out + z) + DO_CARRY);
    for (int item = blockIdx.x; item < 8 * 264; item += gridDim.x) {
        const int b = item / 264, sc = item % 264; const int ch = 2 * tid;
        float h0 = 0.f, h1 = 0.f, p0 = 0.f, p1 = 0.f;
        if (pass == 2) { const f32x2 c = *(const f32x2*)(CAR + (size_t)item * 1024 + ch); h0 = c.x; h1 = c.y; }
#pragma unroll 4
        for (int i = 0; i < 32; ++i) { const int row = scan_row(d, b, sc, i);
            const unsigned lw = *(const unsigned*)(LA + (size_t)row * 1024 + ch), bw = *(const unsigned*)(BBp + (size_t)row * 1024 + ch);
            const float l0 = bf_lo(lw), l1 = bf_hi(lw);
            h0 = __builtin_amdgcn_exp2f(l0 * LOG2E) * h0 + bf_lo(bw); h1 = __builtin_amdgcn_exp2f(l1 * LOG2E) * h1 + bf_hi(bw);
            if (pass == 1) { p0 += l0; p1 += l1; }
            else if (d == 0) { *(unsigned*)(Z + (size_t)row * 3072 + 2048 + ch) = cvt_pk_bf16(h0, h1); }
            else { const unsigned fw = *(const unsigned*)(Z + (size_t)row * 3072 + 2048 + ch), gw = *(const unsigned*)(Z + (size_t)row * 3072 + ch);
                *(unsigned*)(Z + (size_t)row * 3072 + ch) = cvt_pk_bf16(bf_lo(gw) * (bf_lo(fw) + h0), bf_hi(gw) * (bf_hi(fw) + h1)); }
        }
        if (pass == 1) *(f32x4*)(SUMM + ((size_t)item * 1024 + ch) * 2) = (f32x4){p0, h0, p1, h1};
    }
}
__device__ __forceinline__ void phase_carry(const KArgs& a, const int z, const int tid) {
    const float* SUMM = (const float*)((unsigned char*)(a.out + z) + DO_SUMM); float* CAR = (float*)((unsigned char*)(a.out + z) + DO_CARRY);
    const int gid = blockIdx.x * NTHR + tid;
    if (gid < 8192) { const int b = gid >> 10, ch = gid & 1023; float c = 0.f;
#pragma unroll 8
        for (int sc = 0; sc < 264; ++sc) { const size_t o = (size_t)(b * 264 + sc) * 1024 + ch; const f32x2 s = *(const f32x2*)(SUMM + o * 2);
            CAR[o] = c; c = __builtin_amdgcn_exp2f(s.x * LOG2E) * c + s.y; } }
}

__device__ __forceinline__ void phase_qkpost(const KArgs& a, const int z, const int tid, int jl) {
    bf16_t* Zq = (bf16_t*)((a.ws + z) + OFF_Z + ZO_QKV); bf16_t* KK = (bf16_t*)((a.ws + z) + OFF_Z + ZO_KK); bf16_t* VT = (bf16_t*)((a.ws + z) + OFF_Z + ZO_VT);
    const float* qn = a.in[z + 23] + jl * 64; const float* kn = a.in[z + 24] + jl * 64;
    for (int idx = blockIdx.x * NTHR + tid; idx < 24 * MALL; idx += gridDim.x * NTHR) {
        const int slot = idx / MALL, row = idx - slot * MALL;
        const bool lat = row < ML; const int t = lat ? (row & 8191) : ((row - ML) & 255), b = lat ? (row >> 13) : ((row - ML) >> 8);
        const int kvrow = lat ? 256 + t : t;
        bf16_t* src = Zq + (size_t)row * 1536 + slot * 64;
        float v[64];
#pragma unroll
        for (int c = 0; c < 8; ++c) { const u32x4 w = *(const u32x4*)(src + 8 * c);
            v[8 * c] = bf_lo(w.x); v[8 * c + 1] = bf_hi(w.x); v[8 * c + 2] = bf_lo(w.y); v[8 * c + 3] = bf_hi(w.y); v[8 * c + 4] = bf_lo(w.z); v[8 * c + 5] = bf_hi(w.z); v[8 * c + 6] = bf_lo(w.w); v[8 * c + 7] = bf_hi(w.w); }
        const bool isv = (slot == 18 || slot == 19 || slot == 22 || slot == 23);
        if (isv) { const int type = slot >= 22, hh = slot & 1;
            if (type == 0) { bf16_t* vv = (bf16_t*)((unsigned char*)(a.out + z) + DO_VV) + ((size_t)(b * 2 + hh) * KVR + kvrow) * 64;
#pragma unroll
                for (int c = 0; c < 8; ++c) *(u32x4*)(vv + 8 * c) = *(const u32x4*)(src + 8 * c); }
            bf16_t* dst = VT + (size_t)((type * 8 + b) * 2 + hh) * 64 * KVR + kvrow;
#pragma unroll
            for (int dd = 0; dd < 64; dd += 2) { const unsigned pk = cvt_pk_bf16(v[dd], v[dd + 1]); dst[(size_t)dd * KVR] = (bf16_t)(pk & 0xffffu); dst[(size_t)(dd + 1) * KVR] = (bf16_t)(pk >> 16); }
            continue; }
        const bool isq = slot < 16;
        if (slot < 8 || slot == 16 || slot == 17) { const float* g = slot < 8 ? qn : kn; float ss = 0.f;
#pragma unroll
            for (int dd = 0; dd < 64; ++dd) ss += v[dd] * v[dd];
            const float r = rsqrtf(ss * (1.0f / 64.0f) + 1e-6f);
#pragma unroll
            for (int dd = 0; dd < 64; ++dd) v[dd] = v[dd] * r * g[dd]; }
        if (lat) { const float pr = (float)(t >> 6), pc = (float)(t & 63);
#pragma unroll
            for (int f = 0; f < 16; ++f) { const float invf = exp2f(-(float)f * 0.8304820237218406f) * 0.15915494309189535f;
                { const float rev = pr * invf, cs = __builtin_amdgcn_cosf(rev), sn = __builtin_amdgcn_sinf(rev); const float x1 = v[f], x2 = v[16 + f]; v[f] = x1 * cs - x2 * sn; v[16 + f] = x2 * cs + x1 * sn; }
                { const float rev = pc * invf, cs = __builtin_amdgcn_cosf(rev), sn = __builtin_amdgcn_sinf(rev); const float x1 = v[32 + f], x2 = v[48 + f]; v[32 + f] = x1 * cs - x2 * sn; v[48 + f] = x2 * cs + x1 * sn; } } }
        bf16_t* dst;
        if (isq) { dst = src;
#pragma unroll
            for (int dd = 0; dd < 64; ++dd) v[dd] *= QSCALE; }
        else { const int type = slot >= 20, hh = slot & 1; dst = KK + ((size_t)((type * 8 + b) * 2 + hh) * KVR + kvrow) * 64; }
#pragma unroll
        for (int c = 0; c < 8; ++c) { u32x4 w; w.x = cvt_pk_bf16(v[8 * c], v[8 * c + 1]); w.y = cvt_pk_bf16(v[8 * c + 2], v[8 * c + 3]); w.z = cvt_pk_bf16(v[8 * c + 4], v[8 * c + 5]); w.w = cvt_pk_bf16(v[8 * c + 6], v[8 * c + 7]);
            *(u32x4*)(dst + 8 * c) = w; }
    }
}

namespace attn_body {
using bf16=__hip_bfloat16;
using bf16x8=__attribute__((ext_vector_type(8)))short;
using s16x4=__attribute__((ext_vector_type(4)))short;
using f32x16=__attribute__((ext_vector_type(16)))float;
using u32x4=__attribute__((ext_vector_type(4)))unsigned;
constexpr int D=64;
constexpr int NW=8,QBLK=32,QB=QBLK*NW,KVBLK=64;
constexpr int ATTN_UNIT_ROWS=QB;
__device__ __forceinline__ int crow(int r,int hi){return (r&3)+8*(r>>2)+4*hi;}
#define SBAR() __builtin_amdgcn_sched_barrier(0)
constexpr int NSLOT=3, SLOTB=8192;
constexpr int LDS_K=0, LDS_V=NSLOT*SLOTB, LDS_WS=2*NSLOT*SLOTB, LDS_OST=LDS_WS+NW*64*4, LDS_BYTES=LDS_OST+NW*4096;
constexpr float C2=0.125f*1.4426950408889634f;
__device__ __forceinline__ void glds16(const void*gsrc,unsigned lds_dst){unsigned keep;
  asm volatile("s_mov_b32 %0, m0\n\ts_mov_b32 m0, %2\n\ts_nop 0\n\tglobal_load_lds_dwordx4 %1, off\n\ts_mov_b32 m0, %0":"=&s"(keep):"v"(gsrc),"s"(lds_dst):"memory");}
__device__ __forceinline__ float max3f(float a,float b,float c){float r;asm("v_max3_f32 %0, %1, %2, %3":"=v"(r):"v"(a),"v"(b),"v"(c));return r;}
__device__ __forceinline__ float max2f(float a,float b){float r;asm("v_max_f32_e32 %0, %1, %2":"=v"(r):"v"(a),"v"(b));return r;}
__device__ __forceinline__ float fadd_s(float a,float b){float r;asm("v_add_f32_e32 %0, %1, %2":"=v"(r):"v"(a),"v"(b));return r;}
__device__ __forceinline__ float fsub_s(float a,float b){float r;asm("v_sub_f32_e32 %0, %1, %2":"=v"(r):"v"(a),"v"(b));return r;}
typedef float f32x2_t __attribute__((ext_vector_type(2))); typedef __bf16 bf16x2_t __attribute__((ext_vector_type(2)));
__device__ __forceinline__ unsigned cvtpk_s(float lo,float hi){f32x2_t v={lo,hi};bf16x2_t b=__builtin_convertvector(v,bf16x2_t);return __builtin_bit_cast(unsigned,b);}
#define WAIT_BAR(N) asm volatile("s_waitcnt vmcnt(" #N ") lgkmcnt(0)\n\ts_barrier":::"memory")

__device__ __forceinline__ void qkt(f32x16&p0,f32x16&p1,const char*Kslot,const bf16x8*qr,const f32x16&negm,int r32,int hi){
  const char*kb=Kslot+hi*1024+r32*16;
  #pragma unroll
  for(int d0=0;d0<4;++d0){
    const bf16x8 b0=*reinterpret_cast<const bf16x8*>(kb+d0*2048);
    const bf16x8 b1=*reinterpret_cast<const bf16x8*>(kb+d0*2048+512);
    if(d0==0){p0=__builtin_amdgcn_mfma_f32_32x32x16_bf16(b0,qr[0],negm,0,0,0);p1=__builtin_amdgcn_mfma_f32_32x32x16_bf16(b1,qr[0],negm,0,0,0);}
    else{p0=__builtin_amdgcn_mfma_f32_32x32x16_bf16(b0,qr[d0],p0,0,0,0);p1=__builtin_amdgcn_mfma_f32_32x32x16_bf16(b1,qr[d0],p1,0,0,0);}}
}
typedef __attribute__((address_space(3))) const char* lds_cptr;
typedef short v4i16_t __attribute__((ext_vector_type(4)));
__device__ __forceinline__ void kload8(bf16x8*kf,lds_cptr kp){
  kf[0]=*(const __attribute__((address_space(3))) bf16x8*)(kp);      kf[1]=*(const __attribute__((address_space(3))) bf16x8*)(kp+512);
  kf[2]=*(const __attribute__((address_space(3))) bf16x8*)(kp+2048); kf[3]=*(const __attribute__((address_space(3))) bf16x8*)(kp+2560);
  kf[4]=*(const __attribute__((address_space(3))) bf16x8*)(kp+4096); kf[5]=*(const __attribute__((address_space(3))) bf16x8*)(kp+4608);
  kf[6]=*(const __attribute__((address_space(3))) bf16x8*)(kp+6144); kf[7]=*(const __attribute__((address_space(3))) bf16x8*)(kp+6656);
}
__device__ __forceinline__ void kload2(bf16x8*kf,lds_cptr kp,int j){ kf[2*j]=*(const __attribute__((address_space(3))) bf16x8*)(kp+j*2048); kf[2*j+1]=*(const __attribute__((address_space(3))) bf16x8*)(kp+j*2048+512); }
__device__ __forceinline__ s16x4 vtr(lds_cptr p){ return __builtin_bit_cast(s16x4,__builtin_amdgcn_ds_read_tr16_b64_v4i16((__attribute__((address_space(3))) v4i16_t*)p)); }
__device__ __forceinline__ float rowmax(const f32x16&p0,const f32x16&p1){
  float a=max3f(p0[0],p0[1],p1[0]),b=max3f(p0[2],p0[3],p1[1]);a=max3f(a,p1[2],p1[3]);
  #pragma unroll
  for(int r=4;r<16;r+=4){a=max3f(a,p0[r],p0[r+1]);b=max3f(b,p0[r+2],p0[r+3]);a=max3f(a,p1[r],p1[r+1]);b=max3f(b,p1[r+2],p1[r+3]);}
  const float m=max2f(a,b);
  auto rr=__builtin_amdgcn_permlane32_swap(__float_as_uint(m),__float_as_uint(m),false,false);
  return max2f(__uint_as_float(rr[0]),__uint_as_float(rr[1]));
}
__device__ __forceinline__ void pv(f32x16*o,int vb,bf16x8 pa0,bf16x8 pa1,bf16x8 pa2,bf16x8 pa3){
  #pragma unroll
  for(int d0=0;d0<2;++d0){s16x4 lo[4],hi[4];
    #pragma unroll
    for(int ks=0;ks<4;++ks){
      asm volatile("ds_read_b64_tr_b16 %0,%1 offset:%c2":"=&v"(lo[ks]):"v"(vb),"i"(d0*4096+ks*1024):"memory");
      asm volatile("ds_read_b64_tr_b16 %0,%1 offset:%c2":"=&v"(hi[ks]):"v"(vb),"i"(d0*4096+ks*1024+512):"memory");}
    asm volatile("s_waitcnt lgkmcnt(0)":::"memory");SBAR();
    #define PK(k) (bf16x8){lo[k][0],lo[k][1],lo[k][2],lo[k][3],hi[k][0],hi[k][1],hi[k][2],hi[k][3]}
    o[d0]=__builtin_amdgcn_mfma_f32_32x32x16_bf16(pa0,PK(0),o[d0],0,0,0);
    o[d0]=__builtin_amdgcn_mfma_f32_32x32x16_bf16(pa1,PK(1),o[d0],0,0,0);
    o[d0]=__builtin_amdgcn_mfma_f32_32x32x16_bf16(pa2,PK(2),o[d0],0,0,0);
    o[d0]=__builtin_amdgcn_mfma_f32_32x32x16_bf16(pa3,PK(3),o[d0],0,0,0);
    #undef PK
  }
}

#ifndef ATTN_STORE16
#define ATTN_STORE16(p,v) (*(u32x4*)(p)=(v))
#endif
template<int THRL> __device__ __forceinline__ void attn_unit(const bf16*Qb,int PQ,const bf16*__restrict__ Kh,int PK,const bf16*__restrict__ Vh,int PV,bf16*Ob,int PO,const int NT,char*shm,const int tid){
  const int lane=tid&63,r32=lane&31,hi=lane>>5; const int wid=__builtin_amdgcn_readfirstlane(tid>>6);
  const bf16*Qw=Qb+(long)(wid*QBLK)*PQ;
  const unsigned lds0=(unsigned)(uintptr_t)shm;
  float*wsf=(float*)(shm+LDS_WS)+wid*64;
  const bf16*ksrc=Kh+(long)lane*PK+wid*8;
  const bf16*vsrc=Vh+(long)(16*(wid&3)+(lane>>2))*PV+(wid>>2)*32+(lane&3)*8;
  const unsigned kdst=lds0+LDS_K+wid*1024, vdst=lds0+LDS_V+wid*1024;
  #define DMA_K(t,slot) glds16(ksrc+(long)(t)*KVBLK*PK,(unsigned)__builtin_amdgcn_readfirstlane(kdst+(slot)))
  #define DMA_V(t,slot) glds16(vsrc+(long)(t)*KVBLK*PV,(unsigned)__builtin_amdgcn_readfirstlane(vdst+(slot)))
  const int vb0=(int)(lds0+LDS_V)+((lane>>4)&1)*32+(lane&3)*8+(4*hi+((lane&15)>>2))*64;
  const char*Kbase=shm+LDS_K; bf16x8 kf[8];
  const lds_cptr shm3=(lds_cptr)shm; const lds_cptr kp0=shm3+LDS_K+hi*1024+r32*16; const lds_cptr vp0=shm3+LDS_V+((lane>>4)&1)*32+(lane&3)*8+(4*hi+((lane&15)>>2))*64;
  DMA_K(0,0);DMA_V(0,0);DMA_K(1,SLOTB);
  bf16x8 qr[4];
  #pragma unroll
  for(int d0=0;d0<4;++d0)qr[d0]=*reinterpret_cast<const bf16x8*>(&Qw[(long)r32*PQ+d0*16+hi*8]);
  float mhat=0.f,l_reg=0.f;f32x16 o[2];o[0]=f32x16{};o[1]=f32x16{};f32x16 negm=f32x16{};asm volatile("":"+v"(negm));
  #define CMASK(P0,P1,t) do{}while(0)
  bool resc=false;
  #define START(P0,P1) do{ const float rm=rowmax(P0,P1); resc=false; \
    { const float dl=rm; mhat=fadd_s(mhat,dl); \
      _Pragma("unroll") for(int r=0;r<16;++r){P0[r]=fsub_s(P0[r],dl);P1[r]=fsub_s(P1[r],dl);} \
      _Pragma("unroll") for(int r=0;r<16;++r)negm[r]=-mhat; asm volatile("":"+v"(negm)); } \
    _Pragma("unroll") for(int r=0;r<16;++r)P0[r]=__builtin_amdgcn_exp2f(P0[r]); }while(0)
  #define RESC() do{ if(resc){ asm volatile("s_waitcnt lgkmcnt(0)":::"memory"); \
      _Pragma("unroll") for(int d_=0;d_<2;++d_) _Pragma("unroll") for(int r=0;r<16;++r)o[d_][r]*=wsf[crow(r,hi)]; } }while(0)
  f32x16 pA0,pA1,pB0,pB1;
  int sl_prev=0,sl_cur=0,sl_next=SLOTB;
  #define ROT() do{sl_prev=sl_cur;sl_cur=sl_next;sl_next=(sl_next==(NSLOT-1)*SLOTB)?0:sl_next+SLOTB;}while(0)
  DMA_K(2,2*SLOTB);
  WAIT_BAR(3);
  qkt(pA0,pA1,Kbase,qr,negm,r32,hi);asm volatile("s_nop 15\n\ts_nop 7":"+v"(pA0),"+v"(pA1));CMASK(pA0,pA1,0);
  START(pA0,pA1);
  _Pragma("unroll") for(int r=0;r<16;++r)pA1[r]=__builtin_amdgcn_exp2f(pA1[r]);
  WAIT_BAR(0);
  DMA_K(3,0);DMA_V(1,SLOTB);
  ROT();
  kload8(kf,kp0+sl_cur);
  WAIT_BAR(2);
  s16x4 vlo[8],vhi[8]; u32x4 pw0,pw1,pw2,pw3;
  #define PKW(P,B) cvtpk_s(P[B],P[B+1])
  #define PAF(k) __builtin_bit_cast(bf16x8,pw##k)
  #define VFR(i) (bf16x8){vlo[i][0],vlo[i][1],vlo[i][2],vlo[i][3],vhi[i][0],vhi[i][1],vhi[i][2],vhi[i][3]}
  #define PIN(x) asm volatile("":"+v"(x))
  #define MX3(a,b,c) __builtin_fmaxf(__builtin_fmaxf((a),(b)),(c))
  #define GAPA(MF,A0,A1,A2,A3,W0,W1,PW) do{ MF; sacc+=A0; sacc+=A1; sacc+=A2; sacc+=A3; PIN(sacc); W0; W1; PIN(PW); SBAR(); }while(0)
  #define EX(v) __builtin_amdgcn_exp2f(v)
  #define GAPB(MF,X,B) do{ MF; X[B]=EX(X[B]); X[B+1]=EX(X[B+1]); X[B+2]=EX(X[B+2]); X[B+3]=EX(X[B+3]); PIN(X); SBAR(); }while(0)
  #define VRD(i) do{ vlo[i]=vtr(vp_+(((i)>>2)*4096+((i)&3)*1024)); vhi[i]=vtr(vp_+(((i)>>2)*4096+((i)&3)*1024+512)); }while(0)
  #define KRD(G,j) do{ if(G){ kload2(kf,kp0+sl_next,j); SBAR(); } }while(0)
  #define STEP(C0,C1,P0,P1,t,GK,GV,GL) do{ SBAR(); \
    const lds_cptr vp_=vp0+sl_prev; \
    VRD(0); SBAR(); float sacc=(P0[0]+P0[1]); \
    GAPA(C0=__builtin_amdgcn_mfma_f32_32x32x16_bf16(kf[0],qr[0],negm,0,0,0), P0[2],P0[3],P0[4],P0[5],     pw0[0]=PKW(P0,0), pw0[1]=PKW(P0,2), pw0); \
    VRD(4); SBAR(); GAPA(C1=__builtin_amdgcn_mfma_f32_32x32x16_bf16(kf[1],qr[0],negm,0,0,0), P0[6],P0[7],P0[8],P0[9],     pw0[2]=PKW(P0,4), pw0[3]=PKW(P0,6), pw0); \
    VRD(1); SBAR(); GAPA(C0=__builtin_amdgcn_mfma_f32_32x32x16_bf16(kf[2],qr[1],C0,0,0,0),   P0[10],P0[11],P0[12],P0[13], pw1[0]=PKW(P0,8), pw1[1]=PKW(P0,10), pw1); \
    VRD(5); SBAR(); GAPA(C1=__builtin_amdgcn_mfma_f32_32x32x16_bf16(kf[3],qr[1],C1,0,0,0),   P0[14],P0[15],P1[0],P1[1],   pw1[2]=PKW(P0,12),pw1[3]=PKW(P0,14), pw1); \
    VRD(2); SBAR(); GAPA(C0=__builtin_amdgcn_mfma_f32_32x32x16_bf16(kf[4],qr[2],C0,0,0,0),   P1[2],P1[3],P1[4],P1[5],     pw2[0]=PKW(P1,0), pw2[1]=PKW(P1,2), pw2); \
    VRD(6); SBAR(); GAPA(C1=__builtin_amdgcn_mfma_f32_32x32x16_bf16(kf[5],qr[2],C1,0,0,0),   P1[6],P1[7],P1[8],P1[9],     pw2[2]=PKW(P1,4), pw2[3]=PKW(P1,6), pw2); \
    VRD(3); SBAR(); GAPA(C0=__builtin_amdgcn_mfma_f32_32x32x16_bf16(kf[6],qr[3],C0,0,0,0),   P1[10],P1[11],P1[12],P1[13], pw3[0]=PKW(P1,8), pw3[1]=PKW(P1,10), pw3); \
    VRD(7); SBAR(); GAPA(C1=__builtin_amdgcn_mfma_f32_32x32x16_bf16(kf[7],qr[3],C1,0,0,0),   P1[14],P1[15],0.f,0.f,       pw3[2]=PKW(P1,12),pw3[3]=PKW(P1,14), pw3); \
    l_reg+=sacc; \
    if(GK){DMA_K((t)+3,sl_cur);} if(GV){DMA_V((t)+1,sl_next);} \
    CMASK(C0,C1,t); \
    { float a=MX3(C0[0],C0[1],C1[0]),b=MX3(C0[2],C0[3],C1[1]); a=MX3(a,C1[2],C1[3]); \
      _Pragma("unroll") for(int r=4;r<16;r+=4){a=MX3(a,C0[r],C0[r+1]);b=MX3(b,C0[r+2],C0[r+3]);a=MX3(a,C1[r],C1[r+1]);b=MX3(b,C1[r+2],C1[r+3]);} \
      float rm=__builtin_fmaxf(a,b); { auto rr=__builtin_amdgcn_permlane32_swap(__float_as_uint(rm),__float_as_uint(rm),false,false); rm=__builtin_fmaxf(__uint_as_float(rr[0]),__uint_as_float(rr[1])); } \
      resc=false; \
      if(__builtin_expect(__any(rm>(float)THRL),0)){ const float dl=__builtin_fmaxf(rm,0.f); mhat+=dl; \
        _Pragma("unroll") for(int r=0;r<16;++r){C0[r]-=dl;C1[r]-=dl;} \
        _Pragma("unroll") for(int r=0;r<16;++r)negm[r]=-mhat; asm volatile("":"+v"(negm)); \
        const float f=__builtin_amdgcn_exp2f(-dl); l_reg*=f; if(hi==0)wsf[r32]=f; resc=true; } } \
    SBAR(); \
    GAPB(o[0]=__builtin_amdgcn_mfma_f32_32x32x16_bf16(PAF(0),VFR(0),o[0],0,0,0), C0,0); \
    GAPB(o[1]=__builtin_amdgcn_mfma_f32_32x32x16_bf16(PAF(0),VFR(4),o[1],0,0,0), C0,4); \
    KRD(GL,0); GAPB(o[0]=__builtin_amdgcn_mfma_f32_32x32x16_bf16(PAF(1),VFR(1),o[0],0,0,0), C0,8); \
    KRD(GL,1); GAPB(o[1]=__builtin_amdgcn_mfma_f32_32x32x16_bf16(PAF(1),VFR(5),o[1],0,0,0), C0,12); \
    KRD(GL,2); GAPB(o[0]=__builtin_amdgcn_mfma_f32_32x32x16_bf16(PAF(2),VFR(2),o[0],0,0,0), C1,0); \
    KRD(GL,3); GAPB(o[1]=__builtin_amdgcn_mfma_f32_32x32x16_bf16(PAF(2),VFR(6),o[1],0,0,0), C1,4); \
    GAPB(o[0]=__builtin_amdgcn_mfma_f32_32x32x16_bf16(PAF(3),VFR(3),o[0],0,0,0), C1,8); \
    GAPB(o[1]=__builtin_amdgcn_mfma_f32_32x32x16_bf16(PAF(3),VFR(7),o[1],0,0,0), C1,12); \
    }while(0)
  int t=1;
  #undef CMASK
  #define CMASK(P0,P1,t) do{}while(0)
  for(;t+5<NT;t+=2){
    STEP(pB0,pB1,pA0,pA1,t,true,true,true);     WAIT_BAR(2); RESC(); ROT();
    STEP(pA0,pA1,pB0,pB1,t+1,true,true,true);   WAIT_BAR(2); RESC(); ROT();
  }
  #undef CMASK
  #define CMASK(P0,P1,t) do{}while(0)
  #define ENDW(tt) do{ if((tt)+3<NT){WAIT_BAR(2);} else if((tt)+2<NT){WAIT_BAR(1);} else {WAIT_BAR(0);} }while(0)
  for(;t+1<NT;t+=2){
    STEP(pB0,pB1,pA0,pA1,t,(t+3<NT),(t+1<NT),(t+1<NT));       ENDW(t);   RESC(); ROT();
    STEP(pA0,pA1,pB0,pB1,t+1,(t+4<NT),(t+2<NT),(t+2<NT));     ENDW(t+1); RESC(); ROT();
  }
  STEP(pB0,pB1,pA0,pA1,NT-1,false,false,false); RESC();
  { float sacc=pB0[0]+pB0[1]; _Pragma("unroll") for(int r=2;r<16;++r)sacc+=pB0[r]; _Pragma("unroll") for(int r=0;r<16;++r)sacc+=pB1[r]; l_reg+=sacc;
    pw0=(u32x4){PKW(pB0,0),PKW(pB0,2),PKW(pB0,4),PKW(pB0,6)};pw1=(u32x4){PKW(pB0,8),PKW(pB0,10),PKW(pB0,12),PKW(pB0,14)};pw2=(u32x4){PKW(pB1,0),PKW(pB1,2),PKW(pB1,4),PKW(pB1,6)};pw3=(u32x4){PKW(pB1,8),PKW(pB1,10),PKW(pB1,12),PKW(pB1,14)};
    SBAR(); pv(o,vb0+sl_cur,PAF(0),PAF(1),PAF(2),PAF(3)); }
  #undef PKW
  #undef PAF
  #undef VFR
  #undef PIN
  #undef MX3
  #undef GAPA
  #undef GAPB
  #undef EX
  #undef VRD
  #undef KRD
  #undef STEP
  #undef ENDW
  {auto rr=__builtin_amdgcn_permlane32_swap(__float_as_uint(l_reg),__float_as_uint(l_reg),false,false);l_reg=__uint_as_float(rr[0])+__uint_as_float(rr[1]);}
  if(hi==0)wsf[32+r32]=l_reg;asm volatile("s_waitcnt lgkmcnt(0)":::"memory");
  float rli[16];
  #pragma unroll
  for(int r=0;r<16;++r)rli[r]=__builtin_amdgcn_rcpf(wsf[32+crow(r,hi)]);
  bf16*Ow=Ob+(long)(wid*QBLK)*PO;
  { bf16*stg=(bf16*)(shm+LDS_OST)+wid*2048;
    #pragma unroll
    for(int r=0;r<16;++r){const int orow=crow(r,hi);
      #pragma unroll
      for(int d0=0;d0<2;++d0)stg[orow*64+d0*32+r32]=__float2bfloat16(o[d0][r]*rli[r]);}
    asm volatile("s_waitcnt lgkmcnt(0)":::"memory");
    #pragma unroll
    for(int i=0;i<4;++i){const int row=i*8+(lane>>3),ch=lane&7; const u32x4 v=*(const u32x4*)(stg+row*64+ch*8); ATTN_STORE16(Ow+(long)row*PO+ch*8,v);} }
  asm volatile("s_waitcnt lgkmcnt(0)\n\ts_barrier":::"memory");
  #undef DMA_K
  #undef DMA_V
  #undef CMASK
  #undef START
  #undef RESC
  #undef ROT
}
constexpr int ATTN_LDS_BYTES=LDS_BYTES;
#undef SBAR
#undef WAIT_BAR
}
__device__ __forceinline__ void phase_attn(const KArgs& a, const int z, const int tid, int jl, bool with_ctx, char* lds_gen) {
    const int lane = tid & 63, wave = tid >> 6, l15 = lane & 15, lg = lane >> 4;
    const bf16_t* Zq = (const bf16_t*)((a.ws + z) + OFF_Z + ZO_QKV); const bf16_t* KK = (const bf16_t*)((a.ws + z) + OFF_Z + ZO_KK); const bf16_t* VT = (const bf16_t*)((a.ws + z) + OFF_Z + ZO_VT);
    bf16_t* O = (bf16_t*)((a.ws + z) + OFF_Z + ZO_O);
    const float* sinkp = a.in[z + 25] + jl * 8;
    const int gw = blockIdx.x * NWAVE + wave, NGW = gridDim.x * NWAVE;
    const int nitems = with_ctx ? 16384 + 512 : 16384;
    {
        const bf16_t* VV = (const bf16_t*)((unsigned char*)(a.out + z) + DO_VV);
        const int G = gridDim.x, bx = blockIdx.x, vcu = (G % 8 == 0) ? (bx % 8) * (G / 8) + bx / 8 : bx, per = (2048 + G - 1) / G;
        for (int i = 0; i < per; ++i) { const int u = vcu * per + i; if (u >= 2048) break;
            const int bh = u >> 5, qb = u & 31, b = bh >> 3, h = bh & 7, g = h >> 2;
            attn_body::attn_unit<8>((const attn_body::bf16*)(Zq + (size_t)(b * SEQ + qb * 256) * 1536 + h * 64), 1536,
                                    (const attn_body::bf16*)(KK + (size_t)(b * 2 + g) * KVR * 64), 64, (const attn_body::bf16*)(VV + (size_t)(b * 2 + g) * KVR * 64), 64,
                                    (attn_body::bf16*)(O + (size_t)(b * SEQ + qb * 256) * 1024 + h * 64), 1024, KVR / 64, lds_gen, tid); }
    }
    for (int item = 8192 + gw; item < nitems; item += NGW) {
        int mode, bg, qtile;
        if (item < 8192) { mode = 0; bg = item >> 9; qtile = item & 511; }
        else if (item < 16384) { mode = 1; bg = (item - 8192) >> 9; qtile = item & 511; }
        else if (item < 16384 + 256) { mode = 2; bg = (item - 16384) >> 4; qtile = item & 15; }
        else { mode = 3; bg = (item - 16640) >> 4; qtile = item & 15; }
        const int b = bg >> 1, g = bg & 1, type = mode & 1;
        const int rowbase = (mode < 2) ? b * SEQ + 16 * qtile : ML + b * CTXL + 16 * qtile;
        const int qcol = type * 512 + g * 256;
        const bf16_t* Kb = KK + (size_t)((type * 8 + b) * 2 + g) * KVR * 64;
        const bf16_t* Vb = VT + (size_t)((type * 8 + b) * 2 + g) * 64 * KVR;
        const int nA = (mode == 0) ? 264 : 8;
        int lo = 0, nB = 0; const int q0 = 16 * qtile;
        if (mode == 1) { lo = q0 >= 128 ? ((q0 - 128) >> 5) : 0; int hi = ((q0 + 143) >> 5) + 1; if (hi > 256) hi = 256; nB = hi - lo; }
        const int ntot = nA + nB;
        bf16x8 qf[4][2];
        { const bf16_t* qp = Zq + (size_t)(rowbase + l15) * 1536 + qcol + 8 * lg;
#pragma unroll
          for (int qt = 0; qt < 4; ++qt)
#pragma unroll
              for (int ks = 0; ks < 2; ++ks) qf[qt][ks] = *(const bf16x8*)(qp + 64 * qt + 32 * ks); }
        f32x4 oacc[4][4]; float mrun[4], lsum[4];
#pragma unroll
        for (int qt = 0; qt < 4; ++qt) { mrun[qt] = -1e30f; lsum[qt] = 0.f;
#pragma unroll
            for (int dt = 0; dt < 4; ++dt) oacc[qt][dt] = (f32x4){0.f, 0.f, 0.f, 0.f}; }
        bf16x8 kf[2][2]; u32x2 vlo[4], vhi[4];
        const bf16_t* kp = Kb + (size_t)l15 * 64 + 8 * lg; const bf16_t* vp = Vb + (size_t)l15 * KVR + 4 * lg;
#define LOAD_KV(KF, VLO, VHI, kvrow0) do { \
        _Pragma("unroll") for (int kt = 0; kt < 2; ++kt) _Pragma("unroll") for (int ks = 0; ks < 2; ++ks) KF[kt][ks] = *(const bf16x8*)(kp + (size_t)((kvrow0) + 16 * kt) * 64 + 32 * ks); \
        _Pragma("unroll") for (int dt = 0; dt < 4; ++dt) { VLO[dt] = *(const u32x2*)(vp + (size_t)(16 * dt) * KVR + (kvrow0)); VHI[dt] = *(const u32x2*)(vp + (size_t)(16 * dt) * KVR + (kvrow0) + 16); } } while (0)
        LOAD_KV(kf, vlo, vhi, 0);
        for (int blk = 0; blk < ntot; ++blk) {
            const int nb_ = (blk + 1 < ntot) ? blk + 1 : blk;
            const int kvnext = nb_ < nA ? 32 * nb_ : 256 + 32 * (lo + nb_ - nA);
            bf16x8 kfn[2][2]; u32x2 vlon[4], vhin[4];
            LOAD_KV(kfn, vlon, vhin, kvnext);
            const bool masked = blk >= nA; const int kpos0 = 32 * (lo + blk - nA) + 4 * lg;
            bf16x8 vf[4];
#pragma unroll
            for (int dt = 0; dt < 4; ++dt) { u32x4 w; w.x = vlo[dt].x; w.y = vlo[dt].y; w.z = vhi[dt].x; w.w = vhi[dt].y; vf[dt] = __builtin_bit_cast(bf16x8, w); }
#pragma unroll
            for (int qt = 0; qt < 4; ++qt) {
                f32x4 s0 = (f32x4){0.f, 0.f, 0.f, 0.f}, s1 = (f32x4){0.f, 0.f, 0.f, 0.f};
                s0 = __builtin_amdgcn_mfma_f32_16x16x32_bf16(kf[0][0], qf[qt][0], s0, 0, 0, 0); s0 = __builtin_amdgcn_mfma_f32_16x16x32_bf16(kf[0][1], qf[qt][1], s0, 0, 0, 0);
                s1 = __builtin_amdgcn_mfma_f32_16x16x32_bf16(kf[1][0], qf[qt][0], s1, 0, 0, 0); s1 = __builtin_amdgcn_mfma_f32_16x16x32_bf16(kf[1][1], qf[qt][1], s1, 0, 0, 0);
                if (masked) { const int qpos = q0 + l15;
#pragma unroll
                    for (int r = 0; r < 4; ++r) { const int d0 = kpos0 + r - qpos, d1 = d0 + 16;
                        if (d0 > 128 || d0 < -128) s0[r] = -1e30f; if (d1 > 128 || d1 < -128) s1[r] = -1e30f; } }
                float mx = fmaxf(fmaxf(fmaxf(s0[0], s0[1]), fmaxf(s0[2], s0[3])), fmaxf(fmaxf(s1[0], s1[1]), fmaxf(s1[2], s1[3])));
                mx = fmaxf(mx, __shfl_xor(mx, 16)); mx = fmaxf(mx, __shfl_xor(mx, 32));
                const float mnew = fmaxf(mrun[qt], mx), al = __builtin_amdgcn_exp2f(mrun[qt] - mnew); mrun[qt] = mnew;
                float ps = 0.f;
#pragma unroll
                for (int r = 0; r < 4; ++r) { s0[r] = __builtin_amdgcn_exp2f(s0[r] - mnew); s1[r] = __builtin_amdgcn_exp2f(s1[r] - mnew); ps += s0[r] + s1[r]; }
                lsum[qt] = lsum[qt] * al + ps;
                u32x4 pw; pw.x = cvt_pk_bf16(s0[0], s0[1]); pw.y = cvt_pk_bf16(s0[2], s0[3]); pw.z = cvt_pk_bf16(s1[0], s1[1]); pw.w = cvt_pk_bf16(s1[2], s1[3]);
                const bf16x8 pf = __builtin_bit_cast(bf16x8, pw);
#pragma unroll
                for (int dt = 0; dt < 4; ++dt) { oacc[qt][dt] = oacc[qt][dt] * al; oacc[qt][dt] = __builtin_amdgcn_mfma_f32_16x16x32_bf16(vf[dt], pf, oacc[qt][dt], 0, 0, 0); }
            }
#pragma unroll
            for (int kt = 0; kt < 2; ++kt)
#pragma unroll
                for (int ks = 0; ks < 2; ++ks) kf[kt][ks] = kfn[kt][ks];
#pragma unroll
            for (int dt = 0; dt < 4; ++dt) { vlo[dt] = vlon[dt]; vhi[dt] = vhin[dt]; }
        }
#undef LOAD_KV
#pragma unroll
        for (int qt = 0; qt < 4; ++qt) { float lt = lsum[qt]; lt += __shfl_xor(lt, 16); lt += __shfl_xor(lt, 32);
            if (type == 1) lt += __builtin_amdgcn_exp2f(sinkp[4 * g + qt] * LOG2E - mrun[qt]);
            const float inv = 1.0f / lt;
            bf16_t* op = O + (size_t)(rowbase + l15) * 1024 + qcol + 64 * qt + 4 * lg;
#pragma unroll
            for (int dt = 0; dt < 4; ++dt) { u32x2 w; w.x = cvt_pk_bf16(oacc[qt][dt][0] * inv, oacc[qt][dt][1] * inv); w.y = cvt_pk_bf16(oacc[qt][dt][2] * inv, oacc[qt][dt][3] * inv);
                *(u32x2*)(op + 16 * dt) = w; } }
    }
}

__global__ void __launch_bounds__(NTHR, 2) trunk_fwd(KArgs a) {
    extern __shared__ __attribute__((aligned(16))) unsigned char lds_raw[];
    LAS unsigned char* lds = (LAS unsigned char*)lds_raw;
    cg::grid_group grid = cg::this_grid();
    for (int si = a.step_lo; si < a.step_hi; ++si) {
        int tid = threadIdx.x; asm volatile("" : "+v"(tid));
        int z = 0; asm volatile("" : "+s"(z));
        unsigned char* ws = a.ws + z; unsigned char* WB = ws + OFF_W;
        const int st = a.steps[si], kind = st & 0xff, l = (st >> 8) & 0xf, arg = (st >> 12) & 0xf, jl = l >> 1;
        const int Mrows = (l == 3) ? ML : MALL;
#ifdef ONLY
        if (kind != ONLY) continue;
#endif
        switch (kind) {
        case K_PROLOGUE: phase_prologue(a, z, tid, lds); break;
        case K_MOD0: phase_ln(a, z, tid, 0, 0); break;
        case K_LN: phase_ln(a, z, tid, l, arg); break;
        case K_GEMM_EVIN: {
            pg8::Gemm g{(const bf16_t*)(ws + OFF_R2), (const bf16_t*)(WB + W_EV_IN) + (size_t)jl * 3072 * 1024, MALL, 3072, 1024, 1024, 0};
            pg8::StaticOrder S; S.init(MALL, 3072, gridDim.x, blockIdx.x);
            EpiStore E{(bf16_t*)(ws + OFF_Z), 3072, 8};
            pg8::gemm_phase<EpiStore, true>(tid, lds, g, S, E); break; }
        case K_GEMM_PLAIN: {
            pg8::Gemm g; EpiStore E; int M_, N_;
            if (arg == PL_EVOUT) { g = pg8::Gemm{(const bf16_t*)(ws + OFF_Z), (const bf16_t*)(WB + W_EV_OUT) + (size_t)jl * 1024 * 1536, MALL, 1024, 1536, 3072, 0}; M_ = MALL; N_ = 1024; E = EpiStore{(bf16_t*)(ws + OFF_R2 + SZ_ROWS_BF), 1024, 0}; }
            else if (arg == PL_ODIN) { g = pg8::Gemm{(const bf16_t*)(ws + OFF_R2), (const bf16_t*)(WB + W_OD_IN) + (size_t)jl * 1536 * 1024, MALL, 1536, 1024, 1024, 0}; M_ = MALL; N_ = 1536; E = EpiStore{(bf16_t*)(ws + OFF_Z + ZO_QKV), 1536, 0}; }
            else if (arg == PL_ODOUT) { g = pg8::Gemm{(const bf16_t*)(ws + OFF_Z + ZO_O), (const bf16_t*)(WB + W_OD_OUT) + (size_t)jl * 1024 * 1024, Mrows, 1024, 1024, 1024, 0}; M_ = Mrows; N_ = 1024; E = EpiStore{(bf16_t*)(ws + OFF_R2 + SZ_ROWS_BF), 1024, 0}; }
            else { g = pg8::Gemm{(const bf16_t*)(ws + OFF_Z), (const bf16_t*)(WB + W_FFN_OUT) + (size_t)l * 1024 * 2816, Mrows, 1024, 2816, 2816, 0}; M_ = Mrows; N_ = 1024; E = EpiStore{(bf16_t*)(ws + OFF_R2 + SZ_ROWS_BF), 1024, 0}; }
            pg8::StaticOrder S; S.init(M_, N_, gridDim.x, blockIdx.x);
            pg8::gemm_phase<EpiStore, true>(tid, lds, g, S, E); break; }
        case K_GEMM_SWIGLU: {
            pg8::Gemm g{(const bf16_t*)(ws + OFF_R2), (const bf16_t*)(WB + W_FFN_IN) + (size_t)l * 5632 * 1024, Mrows, 5632, 1024, 1024, 0};
            pg8::StaticOrder S; S.init(Mrows, 5632, gridDim.x, blockIdx.x);
            EpiSwiglu E{(bf16_t*)(ws + OFF_Z), 2816};
            pg8::gemm_phase<EpiSwiglu, true>(tid, lds, g, S, E); break; }
        case K_GEMM_GATE: {
            const int d = arg;
            pg8::Gemm g{(const bf16_t*)((unsigned char*)(a.out + z) + DO_XC), (const bf16_t*)(WB + W_GATE) + (size_t)jl * (2 * 8 * 256 * 128) + (size_t)d * 8 * 256 * 128, MALL, 2048, 128, 1024, 256};
            pg8::StaticOrder S; S.init(MALL, 2048, gridDim.x, blockIdx.x);
            EpiGate E{(bf16_t*)(ws + OFF_R2), (bf16_t*)(ws + OFF_R2 + SZ_ROWS_BF), (const bf16_t*)((unsigned char*)(a.out + z) + DO_XC),
                      a.in[z + 17] + (size_t)((jl * 2 + d) * 2 + 0) * 1024, a.in[z + 17] + (size_t)((jl * 2 + d) * 2 + 1) * 1024, (const float*)(ws + OFF_SPL) + (size_t)(jl * 2 + d) * 1024};
            pg8::gemm_phase<EpiGate, true>(tid, lds, g, S, E); break; }
        case K_CONV_GMLP: phase_conv_gmlp(a, z, tid, jl, lds); break;
        case K_SCAN1: phase_scan(a, z, tid, arg, 1); break;
        case K_CARRY: phase_carry(a, z, tid); break;
        case K_SCAN2: phase_scan(a, z, tid, arg, 2); break;
        case K_QKPOST: phase_qkpost(a, z, tid, jl); break;
        case K_ATTN: phase_attn(a, z, tid, jl, l != 3, (char*)lds_raw); break;
        case K_DUMP: {
            const float* H = (const float*)(ws + OFF_H); const bf16_t* A_ = (const bf16_t*)(ws + OFF_R2); const bf16_t* Y_ = (const bf16_t*)(ws + OFF_R2 + SZ_ROWS_BF); const bf16_t* Z_ = (const bf16_t*)(ws + OFF_Z);
            for (size_t i = (size_t)blockIdx.x * NTHR + tid; i < (size_t)ML * 1024; i += (size_t)gridDim.x * NTHR) { const size_t row = i >> 10, c = i & 1023;
                (a.out + z)[i] = H[i] + bf_lo(A_[i]) + bf_lo(Y_[i]) + bf_lo(Z_[row * 3072 + c]) + bf_lo(Z_[row * 3072 + 1024 + c]) + bf_lo(Z_[row * 3072 + 2048 + c]); }
            break; }
        default: break;
        }
        if (si + 1 < a.step_hi) grid.sync();
    }
}

extern "C" void kernel_launch(void* const* d_in, const int* in_sizes, int n_in, void* d_out, int out_size, void* d_ws, size_t ws_size, hipStream_t stream) {
    static int grid = 0;
    if (grid == 0) {
        if (n_in != 26 || out_size != ML * 1024 || ws_size < WS_NEED) { fprintf(stderr, "kernel_launch: unexpected problem (n_in %d out %d ws %zu need %zu)\n", n_in, out_size, ws_size, (size_t)WS_NEED); grid = -1; return; }
        int dev = 0, cus = 0, per_cu = 0;
        (void)hipGetDevice(&dev); (void)hipDeviceGetAttribute(&cus, hipDeviceAttributeMultiprocessorCount, dev);
        if (hipFuncSetAttribute((const void*)trunk_fwd, hipFuncAttributeMaxDynamicSharedMemorySize, LDS_BYTES) != hipSuccess) fprintf(stderr, "kernel_launch: hipFuncSetAttribute failed\n");
        if (hipOccupancyMaxActiveBlocksPerMultiprocessor(&per_cu, (const void*)trunk_fwd, NTHR, LDS_BYTES) != hipSuccess || per_cu < 1) { fprintf(stderr, "kernel_launch: occupancy query says %d\n", per_cu); per_cu = 1; }
        (void)hipGetLastError();
        if (per_cu > 1) per_cu = 1;
        grid = cus * per_cu;
    }
    if (grid < 0) return;
    KArgs a{};
    for (int i = 0; i < 26; ++i) a.in[i] = (const float*)d_in[i];
    a.out = (float*)d_out; a.ws = (unsigned char*)d_ws;
    int n = 0;
#define STEP(kind, l, arg) a.steps[n++] = (kind) | ((l) << 8) | ((arg) << 12)
    STEP(K_PROLOGUE, 0, 0); STEP(K_MOD0, 0, 0);
    for (int l = 0; l < 4; ++l) {
        if ((l & 1) == 0) {
            STEP(K_GEMM_EVIN, l, 0); STEP(K_CONV_GMLP, l, 0);
            for (int d = 0; d < 2; ++d) { STEP(K_GEMM_GATE, l, d); STEP(K_SCAN1, l, d); STEP(K_CARRY, l, d); STEP(K_SCAN2, l, d); }
            STEP(K_GEMM_PLAIN, l, PL_EVOUT);
        } else {
            STEP(K_GEMM_PLAIN, l, PL_ODIN); STEP(K_QKPOST, l, 0); STEP(K_ATTN, l, 0); STEP(K_GEMM_PLAIN, l, PL_ODOUT);
        }
        STEP(K_LN, l, 1); STEP(K_GEMM_SWIGLU, l, 0); STEP(K_GEMM_PLAIN, l, PL_FFNOUT); STEP(K_LN, l, 2);
    }
#undef STEP
#ifdef TRUNC
    n = TRUNC; a.steps[n++] = K_DUMP;
#endif
    a.step_lo = 0; a.step_hi = n;
    void* args[] = {&a};
#ifndef FORCE_MULTI
#define FORCE_MULTI 0
#endif
    hipError_t e = FORCE_MULTI ? hipErrorUnknown : hipLaunchCooperativeKernel((const void*)trunk_fwd, dim3(grid), dim3(NTHR), args, LDS_BYTES, stream);
    if (e != hipSuccess) {
        if (!FORCE_MULTI) fprintf(stderr, "kernel_launch: cooperative launch failed: %s (grid %d); falling back to one launch per step\n", hipGetErrorString(e), grid);
        (void)hipGetLastError();
        for (int s = 0; s < n; ++s) { a.step_lo = s; a.step_hi = s + 1; hipLaunchKernelGGL(trunk_fwd, dim3(grid), dim3(NTHR), LDS_BYTES, stream, a); }
    }
}
```

```cpp
#include <hip/hip_runtime.h>
#include <hip/hip_cooperative_groups.h>
#include <cstdio>
#include <cstdint>
#include <hip/hip_bf16.h>
#include <cmath>
namespace cg = cooperative_groups;

#define LAS __attribute__((address_space(3)))
typedef unsigned short bf16_t;
typedef short bf16x8 __attribute__((ext_vector_type(8)));
typedef float f32x4 __attribute__((ext_vector_type(4)));
typedef float f32x2 __attribute__((ext_vector_type(2)));
typedef unsigned u32x4 __attribute__((ext_vector_type(4)));
typedef unsigned u32x2 __attribute__((ext_vector_type(2)));

constexpr int DM = 1024, NB = 8, SEQ = 8192, CTXL = 256, ML = NB * SEQ, MC = NB * CTXL, MALL = ML + MC, FH = 2816, KVR = SEQ + CTXL;
constexpr int NTHR = 512, NWAVE = 8;
constexpr int LDS_BYTES = 131072 + 2048;
constexpr float ALPHA = 1.681792830507429f, LOG2E = 1.4426950408889634f;
constexpr float QSCALE = 0.125f * 1.4426950408889634f;

constexpr size_t SZ_ROWS_BF = (size_t)MALL * 1024 * 2;
constexpr size_t OFF_H = 0;
constexpr size_t OFF_W = OFF_H + (size_t)MALL * 1024 * 4;
constexpr size_t W_FFN_IN = 0;
constexpr size_t W_FFN_OUT = W_FFN_IN + 4ull * 5632 * 1024 * 2;
constexpr size_t W_EV_IN = W_FFN_OUT + 4ull * 1024 * 2816 * 2;
constexpr size_t W_EV_OUT = W_EV_IN + 2ull * 3072 * 1024 * 2;
constexpr size_t W_GATE = W_EV_OUT + 2ull * 1024 * 1536 * 2;
constexpr size_t W_OD_IN = W_GATE + 2ull * 2 * 8 * 256 * 128 * 2;
constexpr size_t W_OD_OUT = W_OD_IN + 2ull * 1536 * 1024 * 2;
constexpr size_t W_END = W_OD_OUT + 2ull * 1024 * 1024 * 2;
constexpr size_t OFF_MOD = OFF_W + W_END;
constexpr size_t OFF_Z = OFF_MOD + 4ull * 9 * 6144 * 4;
constexpr size_t OFF_R2 = OFF_Z + (size_t)MALL * 3072 * 2;
constexpr size_t OFF_SPL = OFF_R2 + 2 * SZ_ROWS_BF;
constexpr size_t OFF_BAR = OFF_SPL + 16384;
constexpr size_t WS_NEED = OFF_BAR + 16384;
constexpr size_t ZO_QKV = 0;
constexpr size_t ZO_O = (size_t)MALL * 1536 * 2;
constexpr size_t ZO_KK = ZO_O + SZ_ROWS_BF;
constexpr size_t ZO_VT = ZO_KK + 2ull * 8 * 2 * KVR * 64 * 2;
constexpr size_t DO_VV = 0;
constexpr size_t DO_XC = 0;
constexpr size_t DO_SUMM = SZ_ROWS_BF;
constexpr size_t DO_CARRY = DO_SUMM + 8ull * 264 * 1024 * 8;

struct KArgs {
    const float* in[26];
    float* out; unsigned char* ws;
    int step_lo, step_hi;
    int steps[96];
};
enum { K_PROLOGUE = 0, K_MOD0, K_GEMM_EVIN, K_CONV_GMLP, K_GEMM_GATE, K_SCAN1, K_CARRY, K_SCAN2, K_GEMM_PLAIN, K_LN, K_GEMM_SWIGLU, K_QKPOST, K_ATTN, K_DUMP };
enum { PL_EVOUT = 0, PL_ODIN, PL_ODOUT, PL_FFNOUT };

typedef __bf16 bf16x2_t __attribute__((ext_vector_type(2)));
__device__ __forceinline__ unsigned cvt_pk_bf16(float lo, float hi) { f32x2 v = {lo, hi}; bf16x2_t b = __builtin_convertvector(v, bf16x2_t); return __builtin_bit_cast(unsigned, b); }
__device__ __forceinline__ float bf_lo(unsigned w) { return __uint_as_float(w << 16); }
__device__ __forceinline__ float bf_hi(unsigned w) { return __uint_as_float(w & 0xffff0000u); }
__device__ __forceinline__ float fast_sigmoid(float x) { return __builtin_amdgcn_rcpf(1.0f + __builtin_amdgcn_exp2f(-x * LOG2E)); }
__device__ __forceinline__ float silu_f(float x) { return x * fast_sigmoid(x); }
__device__ __forceinline__ float gelu_tanh(float x) { const float u = x + 0.044715f * x * x * x; return x * __builtin_amdgcn_rcpf(1.0f + __builtin_amdgcn_exp2f(-2.0f * 0.7978845608028654f * LOG2E * u)); }
__device__ __forceinline__ void unpack8(const u32x4 w, float (&x)[8]) { x[0] = bf_lo(w.x); x[1] = bf_hi(w.x); x[2] = bf_lo(w.y); x[3] = bf_hi(w.y); x[4] = bf_lo(w.z); x[5] = bf_hi(w.z); x[6] = bf_lo(w.w); x[7] = bf_hi(w.w); }
__device__ __forceinline__ float wave_sum(float v) {
#pragma unroll
    for (int o = 1; o < 64; o <<= 1) v += __shfl_xor(v, o);
    return v;
}

namespace pg8 {
constexpr int BM = 256, BK = 64, HALF = 128, HTB = HALF * BK * 2, STAGE_BYTES = 8 * HTB, NXCD = 8, WGM = 4;
__host__ __device__ __forceinline__ int lds_byte(int r, int c) { const int st = (r >> 4) * 2 + (c >> 5), rr = r & 15, cc = c & 31, ob = rr * 64 + cc * 2; return st * 1024 + (ob ^ (((ob >> 9) & 1) << 5)); }
__host__ __device__ __forceinline__ void stage_rc(int b, int& R, int& C) { const int st = b / 1024, sb = b % 1024, swz = sb ^ (((sb >> 9) & 1) << 5); R = (st >> 1) * 16 + swz / 64; C = (st & 1) * 32 + (swz % 64) / 2; }
__host__ __device__ __forceinline__ int perm32(int rho) { const int n = rho >> 4, i = rho & 15; return 8 * (i >> 2) + 4 * n + (i & 3); }
struct Unit { int pm, pn; };
struct Gemm { const bf16_t* A; const bf16_t* Bt; int M, N, K, lda, a_pn_off; };
struct StaticOrder {
    int nM, nN, nwg, G, c;
    __device__ void init(int M, int N, int G_, int c_) { nM = M / BM; nN = N / BM; nwg = nM * nN; G = G_; c = c_; }
    __device__ bool next(int i, Unit& u) const {
        const long L = (long)i * G + c; if (L >= nwg) return false;
        int wgid = (int)L; { const int q = nwg / NXCD, r = nwg % NXCD, xcd = wgid % NXCD, off = wgid / NXCD; wgid = (xcd < r ? xcd * (q + 1) : r * (q + 1) + (xcd - r) * q) + off; }
        const int nig = WGM * nN, gid = wgid / nig, fm = gid * WGM, gsz = (nM - fm) < WGM ? (nM - fm) : WGM;
        u.pm = fm + ((wgid % nig) % gsz); u.pn = (wgid % nig) / gsz; return true;
    }
};
template <class Epi, bool ALIGN_EPI>
__device__ __forceinline__ void gemm_phase(int tid, LAS unsigned char* lds, const Gemm g, const StaticOrder& S, const Epi& E) {
    const int wid = __builtin_amdgcn_readfirstlane(tid >> 6), lane = tid & 63, wr = wid >> 2, wc = wid & 3, fr = lane & 15, fq = lane >> 4;
    const int K = g.K, nt = K / BK;
    unsigned voffA[2], voffB[2];
#pragma unroll
    for (int i = 0; i < 2; ++i) { int R, C; stage_rc(tid * 16 + i * 8192, R, C); const int Rb = Epi::PERM ? ((R & ~31) + perm32(R & 31)) : R;
        voffA[i] = (unsigned)(R * g.lda + C) * 2u; voffB[i] = (unsigned)(Rb * K + C) * 2u; }
    const size_t kstep = (size_t)(BK * 2);
    const size_t hstepA = (size_t)HALF * g.lda * 2, hstepB = (size_t)HALF * K * 2;
    const size_t tstepA = 2 * hstepA, tstepB = 2 * hstepB;
    const unsigned ldsw = (unsigned)wid * 1024u;
    const int aoff = lds_byte(wr * 64 + fr, fq * 8), boff = lds_byte(wc * 32 + fr, fq * 8);
#define PG8_SA(b, h) (((b) * 2 + (h)) * HTB)
#define PG8_SB(b, h) ((4 + (b) * 2 + (h)) * HTB)
#define PG8_STAGE(bufoff, gbase, voff) do { _Pragma("unroll") for (int _i = 0; _i < 2; ++_i) \
        __builtin_amdgcn_global_load_lds((const unsigned*)((const char*)(gbase) + (voff)[_i]), (LAS unsigned*)(lds + (bufoff) + ldsw + _i * 8192), 16, 0, 0); } while (0)
#define PG8_LDA(dst, b, h) do { _Pragma("unroll") for (int m = 0; m < 4; ++m) _Pragma("unroll") for (int k = 0; k < 2; ++k) dst[m][k] = *(const LAS bf16x8*)(lds + PG8_SA(b, h) + aoff + m * 2048 + k * 1024); } while (0)
#define PG8_LDB(dst, b, h) do { _Pragma("unroll") for (int n = 0; n < 2; ++n) _Pragma("unroll") for (int k = 0; k < 2; ++k) dst[n][k] = *(const LAS bf16x8*)(lds + PG8_SB(b, h) + boff + n * 2048 + k * 1024); } while (0)
#define PG8_MMA(ai, bj, At, Bt) do { __builtin_amdgcn_s_setprio(1); _Pragma("unroll") for (int m = 0; m < 4; ++m) _Pragma("unroll") for (int n = 0; n < 2; ++n) _Pragma("unroll") for (int k = 0; k < 2; ++k) \
        acc[ai][bj][m][n] = __builtin_amdgcn_mfma_f32_16x16x32_bf16(Bt[n][k], At[m][k], acc[ai][bj][m][n], 0, 0, 0); __builtin_amdgcn_s_setprio(0); } while (0)
#define PG8_WAIT_V(n) asm volatile("s_waitcnt vmcnt(" #n ")" ::: "memory")
#define PG8_WAIT_L(n) asm volatile("s_waitcnt lgkmcnt(" #n ")" ::: "memory")
#define PG8_BAR __builtin_amdgcn_s_barrier()
#define PG8_SCHED __builtin_amdgcn_sched_barrier(0)
    Unit cur, nxt; int ui = 0;
    if (!S.next(0, cur)) return;
    f32x4 acc[2][2][4][2];
#pragma unroll
    for (int a = 0; a < 2; ++a)
#pragma unroll
        for (int b = 0; b < 2; ++b)
#pragma unroll
            for (int m = 0; m < 4; ++m)
#pragma unroll
                for (int n = 0; n < 2; ++n) acc[a][b][m][n] = (f32x4){0.f, 0.f, 0.f, 0.f};
    bf16x8 At[4][2], B0[2][2], B1[2][2];
    const char* cA = (const char*)g.A + (size_t)cur.pm * tstepA + (size_t)cur.pn * (size_t)g.a_pn_off; const char* cB = (const char*)g.Bt + (size_t)cur.pn * tstepB;
    PG8_STAGE(PG8_SB(0, 0), cB, voffB); PG8_STAGE(PG8_SB(0, 1), cB + hstepB, voffB); PG8_STAGE(PG8_SA(0, 0), cA, voffA); PG8_STAGE(PG8_SA(0, 1), cA + hstepA, voffA);
    if (wr == 1) PG8_BAR;
    PG8_WAIT_V(2); PG8_BAR;
    PG8_STAGE(PG8_SB(1, 0), cB + kstep, voffB); PG8_STAGE(PG8_SA(1, 0), cA + kstep, voffA); PG8_STAGE(PG8_SB(1, 1), cB + hstepB + kstep, voffB);
    PG8_WAIT_V(6); PG8_BAR;
    for (;;) {
        const bool has_next = S.next(ui + 1, nxt);
        const char* nA = has_next ? (const char*)g.A + (size_t)nxt.pm * tstepA + (size_t)nxt.pn * (size_t)g.a_pn_off : cA; const char* nB = has_next ? (const char*)g.Bt + (size_t)nxt.pn * tstepB : cB;
        for (int t = 0; t < nt; t += 2) {
            const bool last = (t == nt - 2);
            const char* a1 = cA + (size_t)(t + 1) * kstep;
            const char* a2 = last ? nA : cA + (size_t)(t + 2) * kstep; const char* b2 = last ? nB : cB + (size_t)(t + 2) * kstep;
            const char* a3 = a2 + kstep; const char* b3 = b2 + kstep;
            PG8_LDB(B0, 0, 0); PG8_LDB(B1, 0, 1); PG8_SCHED; PG8_LDA(At, 0, 0); PG8_STAGE(PG8_SA(1, 1), a1 + hstepA, voffA);
            PG8_WAIT_V(8); PG8_WAIT_L(0); PG8_BAR; PG8_MMA(0, 0, At, B0); PG8_MMA(0, 1, At, B1); PG8_BAR; PG8_SCHED;
            PG8_LDA(At, 0, 1); PG8_STAGE(PG8_SB(0, 0), b2, voffB); PG8_STAGE(PG8_SB(0, 1), b2 + hstepB, voffB); PG8_STAGE(PG8_SA(0, 0), a2, voffA);
            PG8_WAIT_V(8); PG8_WAIT_L(0); PG8_BAR; PG8_MMA(1, 0, At, B0); PG8_MMA(1, 1, At, B1); PG8_BAR; PG8_SCHED;
            PG8_LDB(B0, 1, 0); PG8_LDB(B1, 1, 1); PG8_SCHED; PG8_LDA(At, 1, 0); PG8_STAGE(PG8_SA(0, 1), a2 + hstepA, voffA);
            PG8_WAIT_V(8); PG8_WAIT_L(0); PG8_BAR; PG8_MMA(0, 0, At, B0); PG8_MMA(0, 1, At, B1); PG8_BAR; PG8_SCHED;
            PG8_LDA(At, 1, 1); PG8_STAGE(PG8_SB(1, 0), b3, voffB); PG8_STAGE(PG8_SB(1, 1), b3 + hstepB, voffB); PG8_STAGE(PG8_SA(1, 0), a3, voffA);
            PG8_WAIT_V(8); PG8_WAIT_L(0); PG8_BAR; PG8_MMA(1, 0, At, B0); PG8_MMA(1, 1, At, B1); PG8_BAR; PG8_SCHED;
        }
        if constexpr (ALIGN_EPI) { if (wr == 0) PG8_BAR; }
        E(acc, cur, wr, wc, fr, fq);
        if (!has_next) break;
#pragma unroll
        for (int a = 0; a < 2; ++a)
#pragma unroll
            for (int b = 0; b < 2; ++b)
#pragma unroll
                for (int m = 0; m < 4; ++m)
#pragma unroll
                    for (int n = 0; n < 2; ++n) acc[a][b][m][n] = (f32x4){0.f, 0.f, 0.f, 0.f};
        cur = nxt; cA = nA; cB = nB; ++ui;
        if constexpr (ALIGN_EPI) { if (wr == 1) PG8_BAR; }
    }
    PG8_WAIT_V(0);
    if constexpr (!ALIGN_EPI) { if (wr == 0) PG8_BAR; }
    PG8_BAR;
#undef PG8_SA
#undef PG8_SB
#undef PG8_STAGE
#undef PG8_LDA
#undef PG8_LDB
#undef PG8_MMA
#undef PG8_WAIT_V
#undef PG8_WAIT_L
#undef PG8_BAR
#undef PG8_SCHED
}
}

struct EpiStore {
    static constexpr bool PERM = true;
    bf16_t* O; int ldc; int gelu_tiles;
    __device__ __forceinline__ void operator()(const f32x4 (&acc)[2][2][4][2], const pg8::Unit& u, int wr, int wc, int fr, int fq) const {
        const int row0 = u.pm * 256 + wr * 64 + fr, col0 = u.pn * 256 + wc * 32 + 8 * fq; const bool act = u.pn < gelu_tiles;
#pragma unroll
        for (int ai = 0; ai < 2; ++ai)
#pragma unroll
            for (int m = 0; m < 4; ++m) { bf16_t* rowp = O + (size_t)(row0 + ai * 128 + m * 16) * ldc + col0;
#pragma unroll
                for (int bj = 0; bj < 2; ++bj) { f32x4 v0 = acc[ai][bj][m][0], v1 = acc[ai][bj][m][1];
                    if (act) {
#pragma unroll
                        for (int e = 0; e < 4; ++e) { v0[e] = gelu_tanh(v0[e]); v1[e] = gelu_tanh(v1[e]); } }
                    u32x4 w; w.x = cvt_pk_bf16(v0[0], v0[1]); w.y = cvt_pk_bf16(v0[2], v0[3]); w.z = cvt_pk_bf16(v1[0], v1[1]); w.w = cvt_pk_bf16(v1[2], v1[3]);
                    *(u32x4*)(rowp + bj * 128) = w; } }
    }
};
struct EpiSwiglu {
    static constexpr bool PERM = true;
    bf16_t* O; int ldc;
    __device__ __forceinline__ void operator()(const f32x4 (&acc)[2][2][4][2], const pg8::Unit& u, int wr, int wc, int fr, int fq) const {
        const int row0 = u.pm * 256 + wr * 64 + fr, col0 = u.pn * 128 + wc * 32 + 8 * fq;
#pragma unroll
        for (int ai = 0; ai < 2; ++ai)
#pragma unroll
            for (int m = 0; m < 4; ++m) { bf16_t* rowp = O + (size_t)(row0 + ai * 128 + m * 16) * ldc + col0;
                f32x4 v0, v1;
#pragma unroll
                for (int e = 0; e < 4; ++e) { v0[e] = silu_f(acc[ai][0][m][0][e]) * acc[ai][1][m][0][e]; v1[e] = silu_f(acc[ai][0][m][1][e]) * acc[ai][1][m][1][e]; }
                u32x4 w; w.x = cvt_pk_bf16(v0[0], v0[1]); w.y = cvt_pk_bf16(v0[2], v0[3]); w.z = cvt_pk_bf16(v1[0], v1[1]); w.w = cvt_pk_bf16(v1[2], v1[3]);
                *(u32x4*)rowp = w; }
    }
};
struct EpiGate {
    static constexpr bool PERM = true;
    bf16_t* LA; bf16_t* BBo; const bf16_t* XC; const float* gb_r; const float* gb_i; const float* spl;
    __device__ __forceinline__ void operator()(const f32x4 (&acc)[2][2][4][2], const pg8::Unit& u, int wr, int wc, int fr, int fq) const {
        const int row0 = u.pm * 256 + wr * 64 + fr, ch0 = u.pn * 128 + wc * 32 + 8 * fq;
#pragma unroll
        for (int ai = 0; ai < 2; ++ai)
#pragma unroll
            for (int m = 0; m < 4; ++m) { const size_t off = (size_t)(row0 + ai * 128 + m * 16) * 1024 + ch0;
                const u32x4 xw = *(const u32x4*)(XC + off);
                u32x4 w1, w2;
#pragma unroll
                for (int n = 0; n < 2; ++n) {
                    const f32x4 br = *(const f32x4*)(gb_r + ch0 + 4 * n), bi = *(const f32x4*)(gb_i + ch0 + 4 * n), sp = *(const f32x4*)(spl + ch0 + 4 * n);
                    const unsigned xa = n == 0 ? xw.x : xw.z, xb = n == 0 ? xw.y : xw.w;
                    const float xv[4] = {bf_lo(xa), bf_hi(xa), bf_lo(xb), bf_hi(xb)};
                    float la[4], bb[4];
#pragma unroll
                    for (int e = 0; e < 4; ++e) { const float gr = acc[ai][0][m][n][e] + br[e], gi = acc[ai][1][m][n][e] + bi[e];
                        const float l_ = sp[e] * fast_sigmoid(gr); la[e] = l_;
                        const float om = fmaxf(0.0f, 1.0f - __builtin_amdgcn_exp2f(2.0f * LOG2E * l_)); bb[e] = __builtin_amdgcn_sqrtf(om) * fast_sigmoid(gi) * xv[e]; }
                    if (n == 0) { w1.x = cvt_pk_bf16(la[0], la[1]); w1.y = cvt_pk_bf16(la[2], la[3]); w2.x = cvt_pk_bf16(bb[0], bb[1]); w2.y = cvt_pk_bf16(bb[2], bb[3]); }
                    else { w1.z = cvt_pk_bf16(la[0], la[1]); w1.w = cvt_pk_bf16(la[2], la[3]); w2.z = cvt_pk_bf16(bb[0], bb[1]); w2.w = cvt_pk_bf16(bb[2], bb[3]); }
                }
                *(u32x4*)(LA + off) = w1; *(u32x4*)(BBo + off) = w2; }
    }
};

__device__ __forceinline__ int colmap(int id, int n) {
    if (id == 1) { const int t = n >> 8, w = n & 255; return w < 128 ? t * 128 + w : FH + t * 128 + (w - 128); }
    if (id == 2) return n < 1024 ? n : (n < 2048 ? n + 1024 : n - 1024);
    return n;
}
__device__ __forceinline__ void tr_item(const float* W, int ldsrc, int K, bf16_t* WT, int n0, int k0, int mapid, LAS float* scr, int lane) {
    const int sc = colmap(mapid, n0 + (lane & 31));
#pragma unroll 8
    for (int i = 0; i < 32; ++i) { const int kk = 2 * i + (lane >> 5); scr[kk * 33 + (lane & 31)] = W[(size_t)(k0 + kk) * ldsrc + sc]; }
    asm volatile("s_waitcnt lgkmcnt(0)" ::: "memory");
    const int c = lane & 7;
#pragma unroll
    for (int j = 0; j < 4; ++j) { const int n = (lane >> 3) + 8 * j; const LAS float* s = scr + (8 * c) * 33 + n;
        u32x4 o; o.x = cvt_pk_bf16(s[0 * 33], s[1 * 33]); o.y = cvt_pk_bf16(s[2 * 33], s[3 * 33]); o.z = cvt_pk_bf16(s[4 * 33], s[5 * 33]); o.w = cvt_pk_bf16(s[6 * 33], s[7 * 33]);
        *(u32x4*)(WT + (size_t)(n0 + n) * K + k0 + 8 * c) = o; }
    asm volatile("s_waitcnt lgkmcnt(0)" ::: "memory");
}
__device__ __forceinline__ void phase_prologue(const KArgs& a, const int z, const int tid, LAS unsigned char* lds) {
    const int lane = tid & 63, wave = tid >> 6;
    LAS float* sv = (LAS float*)(lds + 73728);
    LAS float* part = (LAS float*)(lds + 110592);
    float* MOD = (float*)((a.ws + z) + OFF_MOD);
    for (int i = tid; i < 9 * 1024; i += NTHR) { const int s = i >> 10, k = i & 1023; const float v = s < 8 ? a.in[z + 1][s * 1024 + k] : a.in[z + 3][k]; sv[i] = v / (1.0f + __expf(-v)); }
    __syncthreads();
    for (int item = blockIdx.x; item < 768; item += gridDim.x) {
        const int l = item / 192, n0 = (item % 192) * 32, ks = tid >> 5, cl = tid & 31;
        const float* w = a.in[z + 4] + (size_t)l * 1024 * 6144 + n0 + cl;
        float acc[9];
#pragma unroll
        for (int s = 0; s < 9; ++s) acc[s] = 0.f;
        const int k0 = ks * 64;
        for (int kb = 0; kb < 64; kb += 16) { float wv[16];
#pragma unroll
            for (int k = 0; k < 16; ++k) wv[k] = w[(size_t)(k0 + kb + k) * 6144];
#pragma unroll
            for (int k = 0; k < 16; ++k)
#pragma unroll
                for (int s = 0; s < 9; ++s) acc[s] += sv[s * 1024 + k0 + kb + k] * wv[k]; }
#pragma unroll
        for (int s = 0; s < 9; ++s) part[(ks * 9 + s) * 32 + cl] = acc[s];
        __syncthreads();
        for (int idx = tid; idx < 288; idx += NTHR) { const int s = idx >> 5, n = idx & 31; float r = a.in[z + 5][l * 6144 + n0 + n];
#pragma unroll
            for (int w16 = 0; w16 < 16; ++w16) r += part[(w16 * 9 + s) * 32 + n];
            MOD[(size_t)(l * 9 + s) * 6144 + n0 + n] = r; }
        __syncthreads();
    }
    for (int i = blockIdx.x * NTHR + tid; i < 4096; i += gridDim.x * NTHR) ((float*)((a.ws + z) + OFF_SPL))[i] = -8.0f * log1pf(__expf(-a.in[z + 18][i]));
    LAS float* scr = (LAS float*)(lds + wave * 8448);
    unsigned char* WB = (a.ws + z) + OFF_W;
    const int gw = blockIdx.x * NWAVE + wave, NGW = gridDim.x * NWAVE;
    for (int it = gw; it < 24576; it += NGW) {
        int r = it;
        if (r < 11264) { const int l = r / 2816, q = r % 2816, kb = q / 176, nb = q % 176;
            tr_item(a.in[z + 10] + (size_t)l * 1024 * 5632, 5632, 1024, (bf16_t*)(WB + W_FFN_IN) + (size_t)l * 5632 * 1024, nb * 32, kb * 64, 1, scr, lane); continue; }
        r -= 11264;
        if (r < 5632) { const int l = r / 1408, q = r % 1408, kb = q / 32, nb = q % 32;
            tr_item(a.in[z + 11] + (size_t)l * 2816 * 1024, 1024, 2816, (bf16_t*)(WB + W_FFN_OUT) + (size_t)l * 1024 * 2816, nb * 32, kb * 64, 0, scr, lane); continue; }
        r -= 5632;
        if (r < 3072) { const int j = r / 1536, q = r % 1536, kb = q / 96, nb = q % 96;
            tr_item(a.in[z + 12] + (size_t)j * 1024 * 3072, 3072, 1024, (bf16_t*)(WB + W_EV_IN) + (size_t)j * 3072 * 1024, nb * 32, kb * 64, 2, scr, lane); continue; }
        r -= 3072;
        if (r < 1536) { const int j = r / 768, q = r % 768, kb = q / 32, nb = q % 32;
            tr_item(a.in[z + 13] + (size_t)j * 1536 * 1024, 1024, 1536, (bf16_t*)(WB + W_EV_OUT) + (size_t)j * 1024 * 1536, nb * 32, kb * 64, 0, scr, lane); continue; }
        r -= 1536;
        if (r < 512) { const int blk = r >> 3, q = r & 7, kb = q >> 2, nb = q & 3; const int h = blk & 7, k = (blk >> 3) & 1, d = (blk >> 4) & 1, j = blk >> 5;
            tr_item(a.in[z + 16] + (size_t)blk * 16384, 128, 128, (bf16_t*)(WB + W_GATE) + (size_t)j * (2 * 8 * 256 * 128) + (size_t)((d * 8 + h) * 256 + k * 128) * 128, nb * 32, kb * 64, 0, scr, lane); continue; }
        r -= 512;
        if (r < 1536) { const int j = r / 768, q = r % 768, kb = q / 48, nb = q % 48;
            tr_item(a.in[z + 21] + (size_t)j * 1024 * 1536, 1536, 1024, (bf16_t*)(WB + W_OD_IN) + (size_t)j * 1536 * 1024, nb * 32, kb * 64, 0, scr, lane); continue; }
        r -= 1536;
        { const int j = r / 512, q = r % 512, kb = q / 32, nb = q % 32;
            tr_item(a.in[z + 22] + (size_t)j * 1024 * 1024, 1024, 1024, (bf16_t*)(WB + W_OD_OUT) + (size_t)j * 1024 * 1024, nb * 32, kb * 64, 0, scr, lane); }
    }
}

struct LnCtx { float* H; const float* MOD; bf16_t* A; const bf16_t* Y; const float* gam; const float* bet; float* outp; int l, which, lm, shi, sci, gi; bool final_, from_in; const float* xin; const float* cin; };
__device__ __forceinline__ const float* ln_src(const LnCtx& c, int row) { return c.from_in ? (row < ML ? c.xin + (size_t)row * 1024 : c.cin + (size_t)(row - ML) * 1024) : c.H + (size_t)row * 1024; }
__device__ __forceinline__ void ln_finish(const LnCtx& c, int lane, int row, f32x4 (&v)[4], const u32x2 (&yw)[4]) {
    const int ms = row < ML ? (row >> 13) : 8;
    if (c.which != 0) {
        const float* gp = c.MOD + (size_t)(c.l * 9 + ms) * 6144 + c.gi * 1024; float s = 0.f;
#pragma unroll
        for (int j = 0; j < 4; ++j) { const f32x4 g = *(const f32x4*)(gp + 4 * lane + 256 * j);
            v[j][0] = ALPHA * v[j][0] + g[0] * bf_lo(yw[j].x); v[j][1] = ALPHA * v[j][1] + g[1] * bf_hi(yw[j].x); v[j][2] = ALPHA * v[j][2] + g[2] * bf_lo(yw[j].y); v[j][3] = ALPHA * v[j][3] + g[3] * bf_hi(yw[j].y);
            s += (v[j][0] + v[j][1]) + (v[j][2] + v[j][3]); }
        const float mean = wave_sum(s) * (1.0f / 1024.0f); float s2 = 0.f;
#pragma unroll
        for (int j = 0; j < 4; ++j) { v[j] = v[j] - mean; s2 += (v[j][0] * v[j][0] + v[j][1] * v[j][1]) + (v[j][2] * v[j][2] + v[j][3] * v[j][3]); }
        const float rstd = rsqrtf(wave_sum(s2) * (1.0f / 1024.0f) + 1e-6f);
        float* dst = c.final_ ? c.outp + (size_t)row * 1024 : c.H + (size_t)row * 1024;
#pragma unroll
        for (int j = 0; j < 4; ++j) { const f32x4 gm = *(const f32x4*)(c.gam + 4 * lane + 256 * j), bt = *(const f32x4*)(c.bet + 4 * lane + 256 * j);
            v[j] = v[j] * rstd * gm + bt; *(f32x4*)(dst + 4 * lane + 256 * j) = v[j]; }
    }
    if (!c.final_) {
        const float* shp = c.MOD + (size_t)(c.lm * 9 + ms) * 6144 + c.shi * 1024; const float* scp = c.MOD + (size_t)(c.lm * 9 + ms) * 6144 + c.sci * 1024;
#pragma unroll
        for (int j = 0; j < 4; ++j) { const f32x4 sh = *(const f32x4*)(shp + 4 * lane + 256 * j), sc = *(const f32x4*)(scp + 4 * lane + 256 * j);
            const f32x4 o = v[j] * (sc + 1.0f) + sh; u32x2 w; w.x = cvt_pk_bf16(o[0], o[1]); w.y = cvt_pk_bf16(o[2], o[3]);
            *(u32x2*)(c.A + (size_t)row * 1024 + 4 * lane + 256 * j) = w; }
    }
}
__device__ __forceinline__ void phase_ln(const KArgs& a, const int z, const int tid, int l, int which, const int r_lo, const int r_hi, const int vb, const int nvb) {
    const int lane = tid & 63, wave = tid >> 6;
    const int gw = vb * NWAVE + wave, NGW = nvb * NWAVE;
    LnCtx c;
    c.H = (float*)((a.ws + z) + OFF_H); c.MOD = (const float*)((a.ws + z) + OFF_MOD);
    c.A = (bf16_t*)((a.ws + z) + OFF_R2); c.Y = (const bf16_t*)((a.ws + z) + OFF_R2 + SZ_ROWS_BF);
    c.final_ = (l == 3 && which == 2); c.from_in = (which == 0) || (which == 1 && l == 0);
    c.gam = which == 1 ? a.in[z + 6] + l * 1024 : a.in[z + 8] + l * 1024; c.bet = which == 1 ? a.in[z + 7] + l * 1024 : a.in[z + 9] + l * 1024;
    c.l = l; c.which = which; c.lm = which == 0 ? 0 : (which == 1 ? l : l + 1); c.shi = which == 1 ? 3 : 0; c.sci = which == 1 ? 4 : 1; c.gi = which == 1 ? 2 : 5;
    c.outp = (a.out + z); c.xin = a.in[z + 0]; c.cin = a.in[z + 2];
    for (int row0 = r_lo + gw; row0 < r_hi; row0 += 2 * NGW) {
        const int row1 = row0 + NGW; const bool has1 = row1 < r_hi;
        f32x4 v0[4], v1[4]; u32x2 y0[4], y1[4];
        const float* s0 = ln_src(c, row0); const float* s1 = ln_src(c, has1 ? row1 : row0);
#pragma unroll
        for (int j = 0; j < 4; ++j) { v0[j] = *(const f32x4*)(s0 + 4 * lane + 256 * j); v1[j] = *(const f32x4*)(s1 + 4 * lane + 256 * j); }
        if (which != 0) {
#pragma unroll
            for (int j = 0; j < 4; ++j) { y0[j] = *(const u32x2*)(c.Y + (size_t)row0 * 1024 + 4 * lane + 256 * j); y1[j] = *(const u32x2*)(c.Y + (size_t)(has1 ? row1 : row0) * 1024 + 4 * lane + 256 * j); } }
        else {
#pragma unroll
            for (int j = 0; j < 4; ++j) { y0[j] = (u32x2){0u, 0u}; y1[j] = (u32x2){0u, 0u}; } }
        ln_finish(c, lane, row0, v0, y0);
        if (has1) ln_finish(c, lane, row1, v1, y1);
    }
}

__device__ __forceinline__ void phase_gmlp(const KArgs& a, const int z, const int tid, int jl, LAS unsigned char* lds, const int vb, const int nvb) {
    const int lane = tid & 63, wave = tid >> 6;
    bf16_t* Z = (bf16_t*)((a.ws + z) + OFF_Z);
    LAS bf16_t* VNT = (LAS bf16_t*)lds;
    const float* Wsp = a.in[z + 19] + (size_t)jl * 4 * 128 * 128; const float* Bsp = a.in[z + 20] + (size_t)jl * 4 * 128;
    for (int item = vb; item < 528 * 4; item += nvb) {
        const int ci = item >> 2, g = item & 3;
        const int row0 = ci < 512 ? ci * 128 : ML + (ci - 512) * 128;
        u32x4 wv[16];
#pragma unroll
        for (int rr = 0; rr < 16; ++rr) wv[rr] = *(const u32x4*)(Z + (size_t)(row0 + wave * 16 + rr) * 3072 + 1536 + 8 * lane);
        float s1[16], s2[16];
#pragma unroll
        for (int rr = 0; rr < 16; ++rr) { float x[8]; unpack8(wv[rr], x); float t1 = 0.f, t2 = 0.f;
#pragma unroll
            for (int e = 0; e < 8; ++e) { t1 += x[e]; t2 += x[e] * x[e]; }
            s1[rr] = t1; s2[rr] = t2; }
#pragma unroll
        for (int o = 1; o < 64; o <<= 1) {
#pragma unroll
            for (int rr = 0; rr < 16; ++rr) { s1[rr] += __shfl_xor(s1[rr], o); s2[rr] += __shfl_xor(s2[rr], o); } }
        if ((lane >> 4) == g) {
#pragma unroll
            for (int rr = 0; rr < 16; ++rr) { const int q = wave * 16 + rr; float x[8]; unpack8(wv[rr], x);
                const float mean = s1[rr] * (1.0f / 512.0f), var = fmaxf(s2[rr] * (1.0f / 512.0f) - mean * mean, 0.f), rstd = rsqrtf(var + 1e-6f);
#pragma unroll
                for (int e = 0; e < 8; e += 2) { const unsigned pk = cvt_pk_bf16((x[e] - mean) * rstd, (x[e + 1] - mean) * rstd);
                    VNT[(8 * (lane & 15) + e) * 136 + q] = (bf16_t)(pk & 0xffffu); VNT[(8 * (lane & 15) + e + 1) * 136 + q] = (bf16_t)(pk >> 16); } } }
        bf16x8 bfr[4];
        { const float* wp = Wsp + (size_t)(g * 128 + wave * 16 + (lane & 15)) * 128 + 8 * (lane >> 4);
#pragma unroll
          for (int ks = 0; ks < 4; ++ks) { const f32x4 w0 = *(const f32x4*)(wp + 32 * ks), w1 = *(const f32x4*)(wp + 32 * ks + 4);
              u32x4 p; p.x = cvt_pk_bf16(w0[0], w0[1]); p.y = cvt_pk_bf16(w0[2], w0[3]); p.z = cvt_pk_bf16(w1[0], w1[1]); p.w = cvt_pk_bf16(w1[2], w1[3]); bfr[ks] = __builtin_bit_cast(bf16x8, p); } }
        __syncthreads();
        const int p = wave * 16 + (lane & 15); const float bias = Bsp[g * 128 + p];
        bf16_t* urow = Z + (size_t)(row0 + p) * 3072 + 1024 + g * 128;
#pragma unroll
        for (int dt = 0; dt < 8; ++dt) {
            f32x4 acc = (f32x4){0.f, 0.f, 0.f, 0.f};
#pragma unroll
            for (int ks = 0; ks < 4; ++ks) { const bf16x8 af = *(const LAS bf16x8*)(VNT + (16 * dt + (lane & 15)) * 136 + 32 * ks + 8 * (lane >> 4));
                acc = __builtin_amdgcn_mfma_f32_16x16x32_bf16(af, bfr[ks], acc, 0, 0, 0); }
            bf16_t* up = urow + 16 * dt + 4 * (lane >> 4); const u32x2 uw = *(const u32x2*)up;
            u32x2 o; o.x = cvt_pk_bf16(bf_lo(uw.x) * (acc[0] + bias), bf_hi(uw.x) * (acc[1] + bias)); o.y = cvt_pk_bf16(bf_lo(uw.y) * (acc[2] + bias), bf_hi(uw.y) * (acc[3] + bias));
            *(u32x2*)up = o;
        }
        __syncthreads();
    }
}
__device__ __forceinline__ void phase_conv(const KArgs& a, const int z, const int tid, int jl, const int rg_lo, const int nrg, const int vb, const int nvb) {
    bf16_t* Z = (bf16_t*)((a.ws + z) + OFF_Z);
    bf16_t* XC = (bf16_t*)((unsigned char*)(a.out + z) + DO_XC);
    const float* cw = a.in[z + 14] + (size_t)jl * 4 * 1024; const float* cb = a.in[z + 15] + (size_t)jl * 1024;
    for (int idx = vb * NTHR + tid; idx < nrg * 128; idx += nvb * NTHR) {
        const int rg = rg_lo + (idx >> 7), c0 = (idx & 127) * 8, row0 = rg * 16;
        int t0, len; if (row0 < ML) { t0 = row0 & 8191; len = SEQ; } else { t0 = (row0 - ML) & 255; len = CTXL; }
        u32x4 xw[19];
#pragma unroll
        for (int i = 0; i < 19; ++i) { const int tt = t0 - 2 + i; xw[i] = (u32x4){0u, 0u, 0u, 0u};
            if (tt >= 0 && tt < len) xw[i] = *(const u32x4*)(Z + (size_t)(row0 - 2 + i) * 3072 + 2048 + c0); }
        float wk[4][8], bs[8];
#pragma unroll
        for (int k = 0; k < 4; ++k) { const f32x4 w0 = *(const f32x4*)(cw + k * 1024 + c0), w1 = *(const f32x4*)(cw + k * 1024 + c0 + 4);
            wk[k][0] = w0[0]; wk[k][1] = w0[1]; wk[k][2] = w0[2]; wk[k][3] = w0[3]; wk[k][4] = w1[0]; wk[k][5] = w1[1]; wk[k][6] = w1[2]; wk[k][7] = w1[3]; }
        { const f32x4 b0 = *(const f32x4*)(cb + c0), b1 = *(const f32x4*)(cb + c0 + 4); bs[0] = b0[0]; bs[1] = b0[1]; bs[2] = b0[2]; bs[3] = b0[3]; bs[4] = b1[0]; bs[5] = b1[1]; bs[6] = b1[2]; bs[7] = b1[3]; }
#pragma unroll
        for (int r = 0; r < 16; ++r) {
            float o[8];
#pragma unroll
            for (int e = 0; e < 8; ++e) o[e] = bs[e];
#pragma unroll
            for (int k = 0; k < 4; ++k) { const u32x4 w = xw[r + k];
                o[0] += bf_lo(w.x) * wk[k][0]; o[1] += bf_hi(w.x) * wk[k][1]; o[2] += bf_lo(w.y) * wk[k][2]; o[3] += bf_hi(w.y) * wk[k][3];
                o[4] += bf_lo(w.z) * wk[k][4]; o[5] += bf_hi(w.z) * wk[k][5]; o[6] += bf_lo(w.w) * wk[k][6]; o[7] += bf_hi(w.w) * wk[k][7]; }
            u32x4 ow; ow.x = cvt_pk_bf16(o[0], o[1]); ow.y = cvt_pk_bf16(o[2], o[3]); ow.z = cvt_pk_bf16(o[4], o[5]); ow.w = cvt_pk_bf16(o[6], o[7]);
            *(u32x4*)(XC + (size_t)(row0 + r) * 1024 + c0) = ow;
        }
    }
}

__device__ __forceinline__ int scan_row_p(int d, int b, int p) {
    if (p < 256) return ML + b * 256 + (d == 0 ? p : 255 - p);
    const int t = p - 256; return b * SEQ + (d == 0 ? t : 8191 - t);
}
template <int PASS, int DIR, int NB>
__device__ __forceinline__ void scan_body(const KArgs& a, const int z, const int tid) {
    const bf16_t* LA = (const bf16_t*)((a.ws + z) + OFF_R2); const bf16_t* BBp = (const bf16_t*)((a.ws + z) + OFF_R2 + SZ_ROWS_BF);
    bf16_t* Z = (bf16_t*)((a.ws + z) + OFF_Z);
    float* SUMM = (float*)((unsigned char*)(a.out + z) + DO_SUMM); const float* CAR = (const float*)((unsigned char*)(a.out + z) + DO_CARRY);
    const int sub = tid >> 7, ch = (tid & 127) * 8;
    for (int blk = blockIdx.x; blk < 512; blk += gridDim.x) {
        const int item = blk * 4 + sub, b = item >> 8, sc = item & 255, p0 = sc * 33;
        float h[8], P[8];
#pragma unroll
        for (int e = 0; e < 8; ++e) { h[e] = 0.f; P[e] = 0.f; }
        if (PASS == 2) { const f32x4 c0 = *(const f32x4*)(CAR + (size_t)item * 1024 + ch), c1 = *(const f32x4*)(CAR + (size_t)item * 1024 + ch + 4);
            h[0] = c0[0]; h[1] = c0[1]; h[2] = c0[2]; h[3] = c0[3]; h[4] = c1[0]; h[5] = c1[1]; h[6] = c1[2]; h[7] = c1[3]; }
        for (int i0 = 0; i0 < 33; i0 += NB) {
            u32x4 lw[NB], bw[NB], fw[NB], gw[NB]; int rows[NB];
#pragma unroll
            for (int i = 0; i < NB; ++i) { rows[i] = scan_row_p(DIR, b, p0 + i0 + i);
                lw[i] = *(const u32x4*)(LA + (size_t)rows[i] * 1024 + ch); bw[i] = *(const u32x4*)(BBp + (size_t)rows[i] * 1024 + ch);
                if (PASS == 2 && DIR == 1) { fw[i] = *(const u32x4*)(Z + (size_t)rows[i] * 3072 + 2048 + ch); gw[i] = *(const u32x4*)(Z + (size_t)rows[i] * 3072 + ch); } }
#pragma unroll
            for (int i = 0; i < NB; ++i) { float l[8], bb[8]; unpack8(lw[i], l); unpack8(bw[i], bb);
#pragma unroll
                for (int e = 0; e < 8; ++e) { h[e] = __builtin_amdgcn_exp2f(l[e] * LOG2E) * h[e] + bb[e]; if (PASS == 1) P[e] += l[e]; }
                if (PASS == 2 && DIR == 0) { u32x4 o; o.x = cvt_pk_bf16(h[0], h[1]); o.y = cvt_pk_bf16(h[2], h[3]); o.z = cvt_pk_bf16(h[4], h[5]); o.w = cvt_pk_bf16(h[6], h[7]);
                    *(u32x4*)(Z + (size_t)rows[i] * 3072 + 2048 + ch) = o; }
                if (PASS == 2 && DIR == 1) { float f[8], g[8]; unpack8(fw[i], f); unpack8(gw[i], g);
                    u32x4 o; o.x = cvt_pk_bf16(g[0] * (f[0] + h[0]), g[1] * (f[1] + h[1])); o.y = cvt_pk_bf16(g[2] * (f[2] + h[2]), g[3] * (f[3] + h[3]));
                    o.z = cvt_pk_bf16(g[4] * (f[4] + h[4]), g[5] * (f[5] + h[5])); o.w = cvt_pk_bf16(g[6] * (f[6] + h[6]), g[7] * (f[7] + h[7]));
                    *(u32x4*)(Z + (size_t)rows[i] * 3072 + ch) = o; }
            }
        }
        if (PASS == 1) { float* sp = SUMM + ((size_t)item * 1024 + ch) * 2;
#pragma unroll
            for (int e = 0; e < 8; e += 2) *(f32x4*)(sp + 2 * e) = (f32x4){P[e], h[e], P[e + 1], h[e + 1]}; }
    }
}
__device__ __forceinline__ void phase_scan(const KArgs& a, const int z, const int tid, int d, int pass) {
    if (pass == 1) { if (d == 0) scan_body<1, 0, 11>(a, z, tid); else scan_body<1, 1, 11>(a, z, tid); }
    else { if (d == 0) scan_body<2, 0, 11>(a, z, tid); else scan_body<2, 1, 3>(a, z, tid); }
}
__device__ __forceinline__ void phase_carry(const KArgs& a, const int z, const int tid, LAS unsigned char* lds) {
    const float* SUMM = (const float*)((unsigned char*)(a.out + z) + DO_SUMM); float* CAR = (float*)((unsigned char*)(a.out + z) + DO_CARRY);
    LAS float* segP = (LAS float*)lds; LAS float* segS = (LAS float*)(lds + 2048);
    const int seg = tid >> 6, cl = tid & 63;
    for (int blk = blockIdx.x; blk < 128; blk += gridDim.x) {
        const int b = blk >> 4, ch = (blk & 15) * 64 + cl; const size_t o0 = (size_t)(b * 256 + seg * 32) * 1024 + ch;
        f32x2 s[32];
#pragma unroll
        for (int k = 0; k < 32; ++k) s[k] = *(const f32x2*)(SUMM + (o0 + (size_t)k * 1024) * 2);
        float ps = 0.f, sa = 0.f;
#pragma unroll
        for (int k = 0; k < 32; ++k) { sa = __builtin_amdgcn_exp2f(s[k].x * LOG2E) * sa + s[k].y; ps += s[k].x; }
        segP[seg * 64 + cl] = ps; segS[seg * 64 + cl] = sa;
        __syncthreads();
        float c = 0.f;
        for (int j = 0; j < seg; ++j) c = __builtin_amdgcn_exp2f(segP[j * 64 + cl] * LOG2E) * c + segS[j * 64 + cl];
#pragma unroll
        for (int k = 0; k < 32; ++k) { CAR[o0 + (size_t)k * 1024] = c; c = __builtin_amdgcn_exp2f(s[k].x * LOG2E) * c + s[k].y; }
        __syncthreads();
    }
}

__device__ __forceinline__ void phase_qkpost(const KArgs& a, const int z, const int tid, int jl, const int r_lo, const int nrows, const int vb, const int nvb) {
    const bf16_t* Zq = (const bf16_t*)((a.ws + z) + OFF_Z + ZO_QKV); bf16_t* KK = (bf16_t*)((a.ws + z) + OFF_Z + ZO_KK); bf16_t* VV = (bf16_t*)((unsigned char*)(a.out + z) + DO_VV);
    const float* kn = a.in[z + 24] + jl * 64;
    for (int idx = vb * NTHR + tid; idx < 8 * nrows; idx += nvb * NTHR) {
        const int s8 = idx / nrows, row = r_lo + (idx - s8 * nrows), slot = 16 + s8;
        const bool lat = row < ML; const int t = lat ? (row & 8191) : ((row - ML) & 255), b = lat ? (row >> 13) : ((row - ML) >> 8);
        const int kvrow = lat ? 256 + t : t, type = slot >= 20, hh = slot & 1;
        const bf16_t* src = Zq + (size_t)row * 1536 + slot * 64;
        const size_t dsto = ((size_t)((type * 8 + b) * 2 + hh) * KVR + kvrow) * 64;
        u32x4 w[8];
#pragma unroll
        for (int c = 0; c < 8; ++c) w[c] = *(const u32x4*)(src + 8 * c);
        if (slot & 2) {
#pragma unroll
            for (int c = 0; c < 8; ++c) *(u32x4*)(VV + dsto + 8 * c) = w[c];
            continue; }
        float v[64];
#pragma unroll
        for (int c = 0; c < 8; ++c) { v[8 * c] = bf_lo(w[c].x); v[8 * c + 1] = bf_hi(w[c].x); v[8 * c + 2] = bf_lo(w[c].y); v[8 * c + 3] = bf_hi(w[c].y); v[8 * c + 4] = bf_lo(w[c].z); v[8 * c + 5] = bf_hi(w[c].z); v[8 * c + 6] = bf_lo(w[c].w); v[8 * c + 7] = bf_hi(w[c].w); }
        if (type == 0) { float ss = 0.f;
#pragma unroll
            for (int dd = 0; dd < 64; ++dd) ss += v[dd] * v[dd];
            const float r = rsqrtf(ss * (1.0f / 64.0f) + 1e-6f);
#pragma unroll
            for (int dd = 0; dd < 64; ++dd) v[dd] = v[dd] * r * kn[dd]; }
        if (lat) { const float pr = (float)(t >> 6), pc = (float)(t & 63);
#pragma unroll
            for (int f = 0; f < 16; ++f) { const float invf = exp2f(-(float)f * 0.8304820237218406f) * 0.15915494309189535f;
                { const float rev = pr * invf, cs = __builtin_amdgcn_cosf(rev), sn = __builtin_amdgcn_sinf(rev); const float x1 = v[f], x2 = v[16 + f]; v[f] = x1 * cs - x2 * sn; v[16 + f] = x2 * cs + x1 * sn; }
                { const float rev = pc * invf, cs = __builtin_amdgcn_cosf(rev), sn = __builtin_amdgcn_sinf(rev); const float x1 = v[32 + f], x2 = v[48 + f]; v[32 + f] = x1 * cs - x2 * sn; v[48 + f] = x2 * cs + x1 * sn; } } }
#pragma unroll
        for (int c = 0; c < 8; ++c) { u32x4 o; o.x = cvt_pk_bf16(v[8 * c], v[8 * c + 1]); o.y = cvt_pk_bf16(v[8 * c + 2], v[8 * c + 3]); o.z = cvt_pk_bf16(v[8 * c + 4], v[8 * c + 5]); o.w = cvt_pk_bf16(v[8 * c + 6], v[8 * c + 7]);
            *(u32x4*)(KK + dsto + 8 * c) = o; }
    }
}

namespace attn_body {
using bf16=__hip_bfloat16;
using bf16x8=__attribute__((ext_vector_type(8)))short;
using s16x4=__attribute__((ext_vector_type(4)))short;
using f32x16=__attribute__((ext_vector_type(16)))float;
using u32x4=__attribute__((ext_vector_type(4)))unsigned;
constexpr int D=64;
constexpr int NW=8,QBLK=32,QB=QBLK*NW,KVBLK=64;
constexpr int ATTN_UNIT_ROWS=QB;
__device__ __forceinline__ int crow(int r,int hi){return (r&3)+8*(r>>2)+4*hi;}
#define SBAR() __builtin_amdgcn_sched_barrier(0)
constexpr int NSLOT=3, SLOTB=8192;
constexpr int LDS_K=0, LDS_V=NSLOT*SLOTB, LDS_WS=2*NSLOT*SLOTB, LDS_OST=LDS_WS+NW*64*4, LDS_BYTES=LDS_OST+NW*4096;
constexpr float C2=0.125f*1.4426950408889634f;
__device__ __forceinline__ void glds16(const void*gsrc,unsigned lds_dst){unsigned keep;
  asm volatile("s_mov_b32 %0, m0\n\ts_mov_b32 m0, %2\n\ts_nop 0\n\tglobal_load_lds_dwordx4 %1, off\n\ts_mov_b32 m0, %0":"=&s"(keep):"v"(gsrc),"s"(lds_dst):"memory");}
__device__ __forceinline__ float max3f(float a,float b,float c){float r;asm("v_max3_f32 %0, %1, %2, %3":"=v"(r):"v"(a),"v"(b),"v"(c));return r;}
__device__ __forceinline__ float max2f(float a,float b){float r;asm("v_max_f32_e32 %0, %1, %2":"=v"(r):"v"(a),"v"(b));return r;}
__device__ __forceinline__ float fadd_s(float a,float b){float r;asm("v_add_f32_e32 %0, %1, %2":"=v"(r):"v"(a),"v"(b));return r;}
__device__ __forceinline__ float fsub_s(float a,float b){float r;asm("v_sub_f32_e32 %0, %1, %2":"=v"(r):"v"(a),"v"(b));return r;}
typedef float f32x2_t __attribute__((ext_vector_type(2))); typedef __bf16 bf16x2_t __attribute__((ext_vector_type(2)));
__device__ __forceinline__ unsigned cvtpk_s(float lo,float hi){f32x2_t v={lo,hi};bf16x2_t b=__builtin_convertvector(v,bf16x2_t);return __builtin_bit_cast(unsigned,b);}
#define WAIT_BAR(N) asm volatile("s_waitcnt vmcnt(" #N ") lgkmcnt(0)\n\ts_barrier":::"memory")

__device__ __forceinline__ void qkt(f32x16&p0,f32x16&p1,const char*Kslot,const bf16x8*qr,const f32x16&negm,int r32,int hi){
  const char*kb=Kslot+hi*1024+r32*16;
  #pragma unroll
  for(int d0=0;d0<4;++d0){
    const bf16x8 b0=*reinterpret_cast<const bf16x8*>(kb+d0*2048);
    const bf16x8 b1=*reinterpret_cast<const bf16x8*>(kb+d0*2048+512);
    if(d0==0){p0=__builtin_amdgcn_mfma_f32_32x32x16_bf16(b0,qr[0],negm,0,0,0);p1=__builtin_amdgcn_mfma_f32_32x32x16_bf16(b1,qr[0],negm,0,0,0);}
    else{p0=__builtin_amdgcn_mfma_f32_32x32x16_bf16(b0,qr[d0],p0,0,0,0);p1=__builtin_amdgcn_mfma_f32_32x32x16_bf16(b1,qr[d0],p1,0,0,0);}}
}
typedef __attribute__((address_space(3))) const char* lds_cptr;
typedef short v4i16_t __attribute__((ext_vector_type(4)));
__device__ __forceinline__ void kload8(bf16x8*kf,lds_cptr kp){
  kf[0]=*(const __attribute__((address_space(3))) bf16x8*)(kp);      kf[1]=*(const __attribute__((address_space(3))) bf16x8*)(kp+512);
  kf[2]=*(const __attribute__((address_space(3))) bf16x8*)(kp+2048); kf[3]=*(const __attribute__((address_space(3))) bf16x8*)(kp+2560);
  kf[4]=*(const __attribute__((address_space(3))) bf16x8*)(kp+4096); kf[5]=*(const __attribute__((address_space(3))) bf16x8*)(kp+4608);
  kf[6]=*(const __attribute__((address_space(3))) bf16x8*)(kp+6144); kf[7]=*(const __attribute__((address_space(3))) bf16x8*)(kp+6656);
}
__device__ __forceinline__ void kload2(bf16x8*kf,lds_cptr kp,int j){ kf[2*j]=*(const __attribute__((address_space(3))) bf16x8*)(kp+j*2048); kf[2*j+1]=*(const __attribute__((address_space(3))) bf16x8*)(kp+j*2048+512); }
__device__ __forceinline__ s16x4 vtr(lds_cptr p){ return __builtin_bit_cast(s16x4,__builtin_amdgcn_ds_read_tr16_b64_v4i16((__attribute__((address_space(3))) v4i16_t*)p)); }
__device__ __forceinline__ float rowmax(const f32x16&p0,const f32x16&p1){
  float a=max3f(p0[0],p0[1],p1[0]),b=max3f(p0[2],p0[3],p1[1]);a=max3f(a,p1[2],p1[3]);
  #pragma unroll
  for(int r=4;r<16;r+=4){a=max3f(a,p0[r],p0[r+1]);b=max3f(b,p0[r+2],p0[r+3]);a=max3f(a,p1[r],p1[r+1]);b=max3f(b,p1[r+2],p1[r+3]);}
  const float m=max2f(a,b);
  auto rr=__builtin_amdgcn_permlane32_swap(__float_as_uint(m),__float_as_uint(m),false,false);
  return max2f(__uint_as_float(rr[0]),__uint_as_float(rr[1]));
}
__device__ __forceinline__ void pv(f32x16*o,int vb,bf16x8 pa0,bf16x8 pa1,bf16x8 pa2,bf16x8 pa3){
  #pragma unroll
  for(int d0=0;d0<2;++d0){s16x4 lo[4],hi[4];
    #pragma unroll
    for(int ks=0;ks<4;++ks){
      asm volatile("ds_read_b64_tr_b16 %0,%1 offset:%c2":"=&v"(lo[ks]):"v"(vb),"i"(d0*4096+ks*1024):"memory");
      asm volatile("ds_read_b64_tr_b16 %0,%1 offset:%c2":"=&v"(hi[ks]):"v"(vb),"i"(d0*4096+ks*1024+512):"memory");}
    asm volatile("s_waitcnt lgkmcnt(0)":::"memory");SBAR();
    #define PK(k) (bf16x8){lo[k][0],lo[k][1],lo[k][2],lo[k][3],hi[k][0],hi[k][1],hi[k][2],hi[k][3]}
    o[d0]=__builtin_amdgcn_mfma_f32_32x32x16_bf16(pa0,PK(0),o[d0],0,0,0);
    o[d0]=__builtin_amdgcn_mfma_f32_32x32x16_bf16(pa1,PK(1),o[d0],0,0,0);
    o[d0]=__builtin_amdgcn_mfma_f32_32x32x16_bf16(pa2,PK(2),o[d0],0,0,0);
    o[d0]=__builtin_amdgcn_mfma_f32_32x32x16_bf16(pa3,PK(3),o[d0],0,0,0);
    #undef PK
  }
}

#ifndef ATTN_STORE16
#define ATTN_STORE16(p,v) (*(u32x4*)(p)=(v))
#endif
__device__ __forceinline__ void wmask(f32x16&p0,f32x16&p1,int t,int wid,int r32,int hi,int q0){
  const float NEG=-INFINITY; const int ks=q0-128+64*(t-4);
  if(ks<0||ks>=8192){
    #pragma unroll
    for(int r=0;r<16;++r){p0[r]=NEG;p1[r]=NEG;}
    return; }
  const int lo=64*(t-4)-128-(wid*32+31), hi_=64*(t-4)-128+63-wid*32;
  if(lo>=-128&&hi_<=128)return;
  const int base=64*(t-4)-128+4*hi-(wid*32+r32);
  #pragma unroll
  for(int r=0;r<16;++r){const int d0=base+(r&3)+8*(r>>2), d1=d0+32; if(d0>128||d0<-128)p0[r]=NEG; if(d1>128||d1<-128)p1[r]=NEG;}
}
template<int THRL,bool WIN> __device__ __forceinline__ void attn_unit(const bf16*Qb,int PQ,const bf16*__restrict__ Kh,int PK,const bf16*__restrict__ Vh,int PV,bf16*Ob,int PO,const int NT,char*shm,const int tid,const int q0,const float sink2,const float*qg,const int tpos0){
  const int lane=tid&63,r32=lane&31,hi=lane>>5; const int wid=__builtin_amdgcn_readfirstlane(tid>>6);
  const bf16*Qw=Qb+(long)(wid*QBLK)*PQ;
  const unsigned lds0=(unsigned)(uintptr_t)shm;
  float*wsf=(float*)(shm+LDS_WS)+wid*64;
  const bf16*ksrc=Kh+(long)lane*PK+wid*8;
  const bf16*vsrc=Vh+(long)(16*(wid&3)+(lane>>2))*PV+(wid>>2)*32+(lane&3)*8;
  const unsigned kdst=lds0+LDS_K+wid*1024, vdst=lds0+LDS_V+wid*1024;
  #define KOFF(t) ((WIN&&(t)>=4)?min(max(64*(t)+q0-128,0),8448-64):64*(t))
  #define DMA_K(t,slot) glds16(ksrc+(long)KOFF(t)*PK,(unsigned)__builtin_amdgcn_readfirstlane(kdst+(slot)))
  #define DMA_V(t,slot) glds16(vsrc+(long)KOFF(t)*PV,(unsigned)__builtin_amdgcn_readfirstlane(vdst+(slot)))
  const int vb0=(int)(lds0+LDS_V)+((lane>>4)&1)*32+(lane&3)*8+(4*hi+((lane&15)>>2))*64;
  const char*Kbase=shm+LDS_K; bf16x8 kf[8];
  const lds_cptr shm3=(lds_cptr)shm; const lds_cptr kp0=shm3+LDS_K+hi*1024+r32*16; const lds_cptr vp0=shm3+LDS_V+((lane>>4)&1)*32+(lane&3)*8+(4*hi+((lane&15)>>2))*64;
  DMA_K(0,0);DMA_V(0,0);DMA_K(1,SLOTB);
  bf16x8 qr[4];
  #pragma unroll
  for(int d0=0;d0<4;++d0)qr[d0]=*reinterpret_cast<const bf16x8*>(&Qw[(long)r32*PQ+d0*16+hi*8]);
  {
    float x[32];
    #pragma unroll
    for(int d0=0;d0<4;++d0){
      #pragma unroll
      for(int e=0;e<8;++e)x[8*d0+e]=__uint_as_float(((unsigned)(unsigned short)qr[d0][e])<<16);}
    if(qg){float ss=0.f;
      #pragma unroll
      for(int i=0;i<32;++i)ss+=x[i]*x[i];
      ss+=__shfl_xor(ss,32);
      const float rn=rsqrtf(ss*(1.0f/64.0f)+1e-6f);
      #pragma unroll
      for(int d0=0;d0<4;++d0){
        #pragma unroll
        for(int e=0;e<8;++e)x[8*d0+e]*=rn*qg[16*d0+8*hi+e];}}
    if(tpos0>=0){const int tq=tpos0+wid*QBLK+r32; const float pr=(float)(tq>>6),pc=(float)(tq&63);
      #pragma unroll
      for(int e=0;e<8;++e){const float invf=__builtin_amdgcn_exp2f(-(float)(8*hi+e)*0.8304820237218406f)*0.15915494309189535f;
        {const float rev=pr*invf,cs=__builtin_amdgcn_cosf(rev),sn=__builtin_amdgcn_sinf(rev);const float x1=x[e],x2=x[8+e];x[e]=x1*cs-x2*sn;x[8+e]=x2*cs+x1*sn;}
        {const float rev=pc*invf,cs=__builtin_amdgcn_cosf(rev),sn=__builtin_amdgcn_sinf(rev);const float x1=x[16+e],x2=x[24+e];x[16+e]=x1*cs-x2*sn;x[24+e]=x2*cs+x1*sn;}}}
    #pragma unroll
    for(int d0=0;d0<4;++d0){u32x4 w;w.x=cvtpk_s(x[8*d0]*C2,x[8*d0+1]*C2);w.y=cvtpk_s(x[8*d0+2]*C2,x[8*d0+3]*C2);w.z=cvtpk_s(x[8*d0+4]*C2,x[8*d0+5]*C2);w.w=cvtpk_s(x[8*d0+6]*C2,x[8*d0+7]*C2);qr[d0]=__builtin_bit_cast(bf16x8,w);}
  }
  float mhat=0.f,l_reg=0.f;f32x16 o[2];o[0]=f32x16{};o[1]=f32x16{};f32x16 negm=f32x16{}; if constexpr(!WIN){asm volatile("":"+v"(negm));}
  #define CMASK(P0,P1,t) do{ if(WIN&&(t)>=4) wmask(P0,P1,(t),wid,r32,hi,q0); }while(0)
  bool resc=false;
  #define START(P0,P1) do{ const float rm=rowmax(P0,P1); resc=false; \
    { const float dl=rm; mhat=fadd_s(mhat,dl); \
      _Pragma("unroll") for(int r=0;r<16;++r){P0[r]=fsub_s(P0[r],dl);P1[r]=fsub_s(P1[r],dl);} \
      if constexpr(!WIN){ _Pragma("unroll") for(int r=0;r<16;++r)negm[r]=-mhat; asm volatile("":"+v"(negm)); } } \
    _Pragma("unroll") for(int r=0;r<16;++r)P0[r]=__builtin_amdgcn_exp2f(P0[r]); }while(0)
  #define RESC() do{ if(resc){ asm volatile("s_waitcnt lgkmcnt(0)":::"memory"); \
      _Pragma("unroll") for(int d_=0;d_<2;++d_) _Pragma("unroll") for(int r=0;r<16;++r)o[d_][r]*=wsf[crow(r,hi)]; } }while(0)
  f32x16 pA0,pA1,pB0,pB1;
  int sl_prev=0,sl_cur=0,sl_next=SLOTB;
  #define ROT() do{sl_prev=sl_cur;sl_cur=sl_next;sl_next=(sl_next==(NSLOT-1)*SLOTB)?0:sl_next+SLOTB;}while(0)
  DMA_K(2,2*SLOTB);
  WAIT_BAR(3);
  qkt(pA0,pA1,Kbase,qr,(WIN?f32x16{}:negm),r32,hi);asm volatile("s_nop 15\n\ts_nop 7":"+v"(pA0),"+v"(pA1));CMASK(pA0,pA1,0);
  START(pA0,pA1);
  _Pragma("unroll") for(int r=0;r<16;++r)pA1[r]=__builtin_amdgcn_exp2f(pA1[r]);
  WAIT_BAR(0);
  DMA_K(3,0);DMA_V(1,SLOTB);
  ROT();
  kload8(kf,kp0+sl_cur);
  WAIT_BAR(2);
  s16x4 vlo[8],vhi[8]; u32x4 pw0,pw1,pw2,pw3;
  #define PKW(P,B) cvtpk_s(P[B],P[B+1])
  #define PAF(k) __builtin_bit_cast(bf16x8,pw##k)
  #define VFR(i) (bf16x8){vlo[i][0],vlo[i][1],vlo[i][2],vlo[i][3],vhi[i][0],vhi[i][1],vhi[i][2],vhi[i][3]}
  #define PIN(x) asm volatile("":"+v"(x))
  #define MX3(a,b,c) __builtin_fmaxf(__builtin_fmaxf((a),(b)),(c))
  #define GAPA(MF,A0,A1,A2,A3,W0,W1,PW) do{ MF; sacc+=A0; sacc+=A1; sacc+=A2; sacc+=A3; PIN(sacc); W0; W1; PIN(PW); SBAR(); }while(0)
  #define EX(v) __builtin_amdgcn_exp2f(v)
  #define GAPB(MF,X,B) do{ MF; X[B]=EX(X[B]); X[B+1]=EX(X[B+1]); X[B+2]=EX(X[B+2]); X[B+3]=EX(X[B+3]); PIN(X); SBAR(); }while(0)
  #define VRD(i) do{ vlo[i]=vtr(vp_+(((i)>>2)*4096+((i)&3)*1024)); vhi[i]=vtr(vp_+(((i)>>2)*4096+((i)&3)*1024+512)); }while(0)
  #define KRD(G,j) do{ if(G){ kload2(kf,kp0+sl_next,j); SBAR(); } }while(0)
  #define STEP(C0,C1,P0,P1,t,GK,GV,GL) do{ SBAR(); \
    const lds_cptr vp_=vp0+sl_prev; \
    VRD(0); SBAR(); float sacc=(P0[0]+P0[1]); \
    GAPA(C0=__builtin_amdgcn_mfma_f32_32x32x16_bf16(kf[0],qr[0],(WIN?f32x16{}:negm),0,0,0), P0[2],P0[3],P0[4],P0[5],     pw0[0]=PKW(P0,0), pw0[1]=PKW(P0,2), pw0); \
    VRD(4); SBAR(); GAPA(C1=__builtin_amdgcn_mfma_f32_32x32x16_bf16(kf[1],qr[0],(WIN?f32x16{}:negm),0,0,0), P0[6],P0[7],P0[8],P0[9],     pw0[2]=PKW(P0,4), pw0[3]=PKW(P0,6), pw0); \
    VRD(1); SBAR(); GAPA(C0=__builtin_amdgcn_mfma_f32_32x32x16_bf16(kf[2],qr[1],C0,0,0,0),   P0[10],P0[11],P0[12],P0[13], pw1[0]=PKW(P0,8), pw1[1]=PKW(P0,10), pw1); \
    VRD(5); SBAR(); GAPA(C1=__builtin_amdgcn_mfma_f32_32x32x16_bf16(kf[3],qr[1],C1,0,0,0),   P0[14],P0[15],P1[0],P1[1],   pw1[2]=PKW(P0,12),pw1[3]=PKW(P0,14), pw1); \
    VRD(2); SBAR(); GAPA(C0=__builtin_amdgcn_mfma_f32_32x32x16_bf16(kf[4],qr[2],C0,0,0,0),   P1[2],P1[3],P1[4],P1[5],     pw2[0]=PKW(P1,0), pw2[1]=PKW(P1,2), pw2); \
    VRD(6); SBAR(); GAPA(C1=__builtin_amdgcn_mfma_f32_32x32x16_bf16(kf[5],qr[2],C1,0,0,0),   P1[6],P1[7],P1[8],P1[9],     pw2[2]=PKW(P1,4), pw2[3]=PKW(P1,6), pw2); \
    VRD(3); SBAR(); GAPA(C0=__builtin_amdgcn_mfma_f32_32x32x16_bf16(kf[6],qr[3],C0,0,0,0),   P1[10],P1[11],P1[12],P1[13], pw3[0]=PKW(P1,8), pw3[1]=PKW(P1,10), pw3); \
    VRD(7); SBAR(); GAPA(C1=__builtin_amdgcn_mfma_f32_32x32x16_bf16(kf[7],qr[3],C1,0,0,0),   P1[14],P1[15],0.f,0.f,       pw3[2]=PKW(P1,12),pw3[3]=PKW(P1,14), pw3); \
    l_reg+=sacc; \
    if(GK){DMA_K((t)+3,sl_cur);} if(GV){DMA_V((t)+1,sl_next);} \
    if constexpr(WIN){ _Pragma("unroll") for(int r=0;r<16;++r){C0[r]-=mhat;C1[r]-=mhat;} } \
    CMASK(C0,C1,t); \
    { float a=MX3(C0[0],C0[1],C1[0]),b=MX3(C0[2],C0[3],C1[1]); a=MX3(a,C1[2],C1[3]); \
      _Pragma("unroll") for(int r=4;r<16;r+=4){a=MX3(a,C0[r],C0[r+1]);b=MX3(b,C0[r+2],C0[r+3]);a=MX3(a,C1[r],C1[r+1]);b=MX3(b,C1[r+2],C1[r+3]);} \
      float rm=__builtin_fmaxf(a,b); { auto rr=__builtin_amdgcn_permlane32_swap(__float_as_uint(rm),__float_as_uint(rm),false,false); rm=__builtin_fmaxf(__uint_as_float(rr[0]),__uint_as_float(rr[1])); } \
      resc=false; \
      if(__builtin_expect(__any(rm>(float)THRL),0)){ const float dl=__builtin_fmaxf(rm,0.f); mhat+=dl; \
        _Pragma("unroll") for(int r=0;r<16;++r){C0[r]-=dl;C1[r]-=dl;} \
        if constexpr(!WIN){ _Pragma("unroll") for(int r=0;r<16;++r)negm[r]=-mhat; asm volatile("":"+v"(negm)); } \
        const float f=__builtin_amdgcn_exp2f(-dl); l_reg*=f; if(hi==0)wsf[r32]=f; resc=true; } } \
    SBAR(); \
    GAPB(o[0]=__builtin_amdgcn_mfma_f32_32x32x16_bf16(PAF(0),VFR(0),o[0],0,0,0), C0,0); \
    GAPB(o[1]=__builtin_amdgcn_mfma_f32_32x32x16_bf16(PAF(0),VFR(4),o[1],0,0,0), C0,4); \
    KRD(GL,0); GAPB(o[0]=__builtin_amdgcn_mfma_f32_32x32x16_bf16(PAF(1),VFR(1),o[0],0,0,0), C0,8); \
    KRD(GL,1); GAPB(o[1]=__builtin_amdgcn_mfma_f32_32x32x16_bf16(PAF(1),VFR(5),o[1],0,0,0), C0,12); \
    KRD(GL,2); GAPB(o[0]=__builtin_amdgcn_mfma_f32_32x32x16_bf16(PAF(2),VFR(2),o[0],0,0,0), C1,0); \
    KRD(GL,3); GAPB(o[1]=__builtin_amdgcn_mfma_f32_32x32x16_bf16(PAF(2),VFR(6),o[1],0,0,0), C1,4); \
    GAPB(o[0]=__builtin_amdgcn_mfma_f32_32x32x16_bf16(PAF(3),VFR(3),o[0],0,0,0), C1,8); \
    GAPB(o[1]=__builtin_amdgcn_mfma_f32_32x32x16_bf16(PAF(3),VFR(7),o[1],0,0,0), C1,12); \
    }while(0)
  int t=1;
  #undef CMASK
  #define CMASK(P0,P1,t) do{ if(WIN&&(t)>=4) wmask(P0,P1,(t),wid,r32,hi,q0); }while(0)
  for(;t+5<NT;t+=2){
    STEP(pB0,pB1,pA0,pA1,t,true,true,true);     WAIT_BAR(2); RESC(); ROT();
    STEP(pA0,pA1,pB0,pB1,t+1,true,true,true);   WAIT_BAR(2); RESC(); ROT();
  }
  #undef CMASK
  #define CMASK(P0,P1,t) do{ if(WIN&&(t)>=4) wmask(P0,P1,(t),wid,r32,hi,q0); }while(0)
  #define ENDW(tt) do{ if((tt)+3<NT){WAIT_BAR(2);} else if((tt)+2<NT){WAIT_BAR(1);} else {WAIT_BAR(0);} }while(0)
  for(;t+1<NT;t+=2){
    STEP(pB0,pB1,pA0,pA1,t,(t+3<NT),(t+1<NT),(t+1<NT));       ENDW(t);   RESC(); ROT();
    STEP(pA0,pA1,pB0,pB1,t+1,(t+4<NT),(t+2<NT),(t+2<NT));     ENDW(t+1); RESC(); ROT();
  }
  STEP(pB0,pB1,pA0,pA1,NT-1,false,false,false); RESC();
  { float sacc=pB0[0]+pB0[1]; _Pragma("unroll") for(int r=2;r<16;++r)sacc+=pB0[r]; _Pragma("unroll") for(int r=0;r<16;++r)sacc+=pB1[r]; l_reg+=sacc;
    pw0=(u32x4){PKW(pB0,0),PKW(pB0,2),PKW(pB0,4),PKW(pB0,6)};pw1=(u32x4){PKW(pB0,8),PKW(pB0,10),PKW(pB0,12),PKW(pB0,14)};pw2=(u32x4){PKW(pB1,0),PKW(pB1,2),PKW(pB1,4),PKW(pB1,6)};pw3=(u32x4){PKW(pB1,8),PKW(pB1,10),PKW(pB1,12),PKW(pB1,14)};
    SBAR(); pv(o,vb0+sl_cur,PAF(0),PAF(1),PAF(2),PAF(3)); }
  #undef PKW
  #undef PAF
  #undef VFR
  #undef PIN
  #undef MX3
  #undef GAPA
  #undef GAPB
  #undef EX
  #undef VRD
  #undef KRD
  #undef STEP
  #undef ENDW
  {auto rr=__builtin_amdgcn_permlane32_swap(__float_as_uint(l_reg),__float_as_uint(l_reg),false,false);l_reg=__uint_as_float(rr[0])+__uint_as_float(rr[1]);}
  if(WIN)l_reg+=__builtin_amdgcn_exp2f(__uint_as_float(__builtin_amdgcn_readfirstlane(__float_as_uint(sink2)))-mhat);
  if(hi==0)wsf[32+r32]=l_reg;asm volatile("s_waitcnt lgkmcnt(0)":::"memory");
  float rli[16];
  #pragma unroll
  for(int r=0;r<16;++r)rli[r]=__builtin_amdgcn_rcpf(wsf[32+crow(r,hi)]);
  bf16*Ow=Ob+(long)(wid*QBLK)*PO;
  { bf16*stg=(bf16*)(shm+LDS_OST)+wid*2048;
    #pragma unroll
    for(int r=0;r<16;++r){const int orow=crow(r,hi);
      #pragma unroll
      for(int d0=0;d0<2;++d0)stg[orow*64+d0*32+r32]=__float2bfloat16(o[d0][r]*rli[r]);}
    asm volatile("s_waitcnt lgkmcnt(0)":::"memory");
    #pragma unroll
    for(int i=0;i<4;++i){const int row=i*8+(lane>>3),ch=lane&7; const u32x4 v=*(const u32x4*)(stg+row*64+ch*8); ATTN_STORE16(Ow+(long)row*PO+ch*8,v);} }
  asm volatile("s_waitcnt lgkmcnt(0)\n\ts_barrier":::"memory");
  #undef DMA_K
  #undef KOFF
  #undef DMA_V
  #undef CMASK
  #undef START
  #undef RESC
  #undef ROT
}
constexpr int ATTN_LDS_BYTES=LDS_BYTES;
#undef SBAR
#undef WAIT_BAR
}
__device__ __forceinline__ unsigned long long phase_attn(const KArgs& a, const int z, const int tid, int jl, bool with_ctx, char* lds_gen) {
    const int lane = tid & 63, wave = tid >> 6, l15 = lane & 15, lg = lane >> 4;
    const bf16_t* Zq = (const bf16_t*)((a.ws + z) + OFF_Z + ZO_QKV); const bf16_t* KK = (const bf16_t*)((a.ws + z) + OFF_Z + ZO_KK); const bf16_t* VT = (const bf16_t*)((a.ws + z) + OFF_Z + ZO_VT);
    bf16_t* O = (bf16_t*)((a.ws + z) + OFF_Z + ZO_O);
    const float* sinkp = a.in[z + 25] + jl * 8; const float* qn = a.in[z + 23] + jl * 64;
    const int gw = blockIdx.x * NWAVE + wave, NGW = gridDim.x * NWAVE;
    const int nitems = with_ctx ? 16384 + 512 : 16384;
    {
        const bf16_t* VV = (const bf16_t*)((unsigned char*)(a.out + z) + DO_VV);
        const int G = gridDim.x, bx = blockIdx.x, vcu = (G % 8 == 0) ? (bx % 8) * (G / 8) + bx / 8 : bx, per = (2048 + G - 1) / G;
        for (int i = 0; i < per; ++i) { const int u = vcu * per + i; if (u >= 2048) break;
            const int b = (u >> 8) & 7, qb = (u >> 3) & 31, h = u & 7, g = h >> 2;
            attn_body::attn_unit<8, false>((const attn_body::bf16*)(Zq + (size_t)(b * SEQ + qb * 256) * 1536 + h * 64), 1536,
                                    (const attn_body::bf16*)(KK + (size_t)(b * 2 + g) * KVR * 64), 64, (const attn_body::bf16*)(VV + (size_t)(b * 2 + g) * KVR * 64), 64,
                                    (attn_body::bf16*)(O + (size_t)(b * SEQ + qb * 256) * 1024 + h * 64), 1024, KVR / 64, lds_gen, tid, 0, 0.f, qn, qb * 256); }
        for (int i = 0; i < per; ++i) { const int u = vcu * per + i; if (u >= 2048) break;
            const int b = (u >> 8) & 7, qb = (u >> 3) & 31, h = u & 7, g = h >> 2;
            attn_body::attn_unit<8, true>((const attn_body::bf16*)(Zq + (size_t)(b * SEQ + qb * 256) * 1536 + 512 + h * 64), 1536,
                                    (const attn_body::bf16*)(KK + (size_t)((8 + b) * 2 + g) * KVR * 64), 64, (const attn_body::bf16*)(VV + (size_t)((8 + b) * 2 + g) * KVR * 64), 64,
                                    (attn_body::bf16*)(O + (size_t)(b * SEQ + qb * 256) * 1024 + 512 + h * 64), 1024, 12, lds_gen, tid, qb * 256, sinkp[h] * LOG2E, nullptr, qb * 256); }
        if (with_ctx) {
            for (int u = vcu; u < 128; u += G) { const int type = u >> 6, b = (u >> 3) & 7, h = u & 7, g = h >> 2;
                attn_body::attn_unit<8, true>((const attn_body::bf16*)(Zq + (size_t)(ML + b * CTXL) * 1536 + type * 512 + h * 64), 1536,
                                    (const attn_body::bf16*)(KK + (size_t)((type * 8 + b) * 2 + g) * KVR * 64), 64, (const attn_body::bf16*)(VV + (size_t)((type * 8 + b) * 2 + g) * KVR * 64), 64,
                                    (attn_body::bf16*)(O + (size_t)(ML + b * CTXL) * 1024 + type * 512 + h * 64), 1024, 4, lds_gen, tid, 0, type ? sinkp[h] * LOG2E : -1e30f, type ? nullptr : qn, -1); }
        }
    }
    return 0ull;
#if 0
    const unsigned long long t_simple0 = __builtin_amdgcn_s_memrealtime();
    for (int item = 8192 + gw; item < nitems; item += NGW) {
        int mode, bg, qtile;
        if (item < 8192) { mode = 0; bg = item >> 9; qtile = item & 511; }
        else if (item < 16384) { mode = 1; bg = (item - 8192) >> 9; qtile = item & 511; }
        else if (item < 16384 + 256) { mode = 2; bg = (item - 16384) >> 4; qtile = item & 15; }
        else { mode = 3; bg = (item - 16640) >> 4; qtile = item & 15; }
        const int b = bg >> 1, g = bg & 1, type = mode & 1;
        const int rowbase = (mode < 2) ? b * SEQ + 16 * qtile : ML + b * CTXL + 16 * qtile;
        const int qcol = type * 512 + g * 256;
        const bf16_t* Kb = KK + (size_t)((type * 8 + b) * 2 + g) * KVR * 64;
        const bf16_t* Vb = VT + (size_t)((type * 8 + b) * 2 + g) * 64 * KVR;
        const int nA = (mode == 0) ? 264 : 8;
        int lo = 0, nB = 0; const int q0 = 16 * qtile;
        if (mode == 1) { lo = q0 >= 128 ? ((q0 - 128) >> 5) : 0; int hi = ((q0 + 143) >> 5) + 1; if (hi > 256) hi = 256; nB = hi - lo; }
        const int ntot = nA + nB;
        bf16x8 qf[4][2];
        { const bf16_t* qp = Zq + (size_t)(rowbase + l15) * 1536 + qcol + 8 * lg;
#pragma unroll
          for (int qt = 0; qt < 4; ++qt)
#pragma unroll
              for (int ks = 0; ks < 2; ++ks) qf[qt][ks] = *(const bf16x8*)(qp + 64 * qt + 32 * ks); }
        f32x4 oacc[4][4]; float mrun[4], lsum[4];
#pragma unroll
        for (int qt = 0; qt < 4; ++qt) { mrun[qt] = -1e30f; lsum[qt] = 0.f;
#pragma unroll
            for (int dt = 0; dt < 4; ++dt) oacc[qt][dt] = (f32x4){0.f, 0.f, 0.f, 0.f}; }
        bf16x8 kf[2][2]; u32x2 vlo[4], vhi[4];
        const bf16_t* kp = Kb + (size_t)l15 * 64 + 8 * lg; const bf16_t* vp = Vb + (size_t)l15 * KVR + 4 * lg;
#define LOAD_KV(KF, VLO, VHI, kvrow0) do { \
        _Pragma("unroll") for (int kt = 0; kt < 2; ++kt) _Pragma("unroll") for (int ks = 0; ks < 2; ++ks) KF[kt][ks] = *(const bf16x8*)(kp + (size_t)((kvrow0) + 16 * kt) * 64 + 32 * ks); \
        _Pragma("unroll") for (int dt = 0; dt < 4; ++dt) { VLO[dt] = *(const u32x2*)(vp + (size_t)(16 * dt) * KVR + (kvrow0)); VHI[dt] = *(const u32x2*)(vp + (size_t)(16 * dt) * KVR + (kvrow0) + 16); } } while (0)
        LOAD_KV(kf, vlo, vhi, 0);
        for (int blk = 0; blk < ntot; ++blk) {
            const int nb_ = (blk + 1 < ntot) ? blk + 1 : blk;
            const int kvnext = nb_ < nA ? 32 * nb_ : 256 + 32 * (lo + nb_ - nA);
            bf16x8 kfn[2][2]; u32x2 vlon[4], vhin[4];
            LOAD_KV(kfn, vlon, vhin, kvnext);
            const bool masked = blk >= nA; const int kpos0 = 32 * (lo + blk - nA) + 4 * lg;
            bf16x8 vf[4];
#pragma unroll
            for (int dt = 0; dt < 4; ++dt) { u32x4 w; w.x = vlo[dt].x; w.y = vlo[dt].y; w.z = vhi[dt].x; w.w = vhi[dt].y; vf[dt] = __builtin_bit_cast(bf16x8, w); }
#pragma unroll
            for (int qt = 0; qt < 4; ++qt) {
                f32x4 s0 = (f32x4){0.f, 0.f, 0.f, 0.f}, s1 = (f32x4){0.f, 0.f, 0.f, 0.f};
                s0 = __builtin_amdgcn_mfma_f32_16x16x32_bf16(kf[0][0], qf[qt][0], s0, 0, 0, 0); s0 = __builtin_amdgcn_mfma_f32_16x16x32_bf16(kf[0][1], qf[qt][1], s0, 0, 0, 0);
                s1 = __builtin_amdgcn_mfma_f32_16x16x32_bf16(kf[1][0], qf[qt][0], s1, 0, 0, 0); s1 = __builtin_amdgcn_mfma_f32_16x16x32_bf16(kf[1][1], qf[qt][1], s1, 0, 0, 0);
                if (masked) { const int qpos = q0 + l15;
#pragma unroll
                    for (int r = 0; r < 4; ++r) { const int d0 = kpos0 + r - qpos, d1 = d0 + 16;
                        if (d0 > 128 || d0 < -128) s0[r] = -1e30f; if (d1 > 128 || d1 < -128) s1[r] = -1e30f; } }
                float mx = fmaxf(fmaxf(fmaxf(s0[0], s0[1]), fmaxf(s0[2], s0[3])), fmaxf(fmaxf(s1[0], s1[1]), fmaxf(s1[2], s1[3])));
                mx = fmaxf(mx, __shfl_xor(mx, 16)); mx = fmaxf(mx, __shfl_xor(mx, 32));
                if (__any(mx > mrun[qt])) {
                    const float mnew = fmaxf(mrun[qt], mx), al = __builtin_amdgcn_exp2f(mrun[qt] - mnew); mrun[qt] = mnew; lsum[qt] *= al;
#pragma unroll
                    for (int dt = 0; dt < 4; ++dt) oacc[qt][dt] = oacc[qt][dt] * al; }
                const float mnew = mrun[qt];
                float ps = 0.f;
#pragma unroll
                for (int r = 0; r < 4; ++r) { s0[r] = __builtin_amdgcn_exp2f(s0[r] - mnew); s1[r] = __builtin_amdgcn_exp2f(s1[r] - mnew); ps += s0[r] + s1[r]; }
                lsum[qt] += ps;
                u32x4 pw; pw.x = cvt_pk_bf16(s0[0], s0[1]); pw.y = cvt_pk_bf16(s0[2], s0[3]); pw.z = cvt_pk_bf16(s1[0], s1[1]); pw.w = cvt_pk_bf16(s1[2], s1[3]);
                const bf16x8 pf = __builtin_bit_cast(bf16x8, pw);
#pragma unroll
                for (int dt = 0; dt < 4; ++dt) oacc[qt][dt] = __builtin_amdgcn_mfma_f32_16x16x32_bf16(vf[dt], pf, oacc[qt][dt], 0, 0, 0);
            }
#pragma unroll
            for (int kt = 0; kt < 2; ++kt)
#pragma unroll
                for (int ks = 0; ks < 2; ++ks) kf[kt][ks] = kfn[kt][ks];
#pragma unroll
            for (int dt = 0; dt < 4; ++dt) { vlo[dt] = vlon[dt]; vhi[dt] = vhin[dt]; }
        }
#undef LOAD_KV
#pragma unroll
        for (int qt = 0; qt < 4; ++qt) { float lt = lsum[qt]; lt += __shfl_xor(lt, 16); lt += __shfl_xor(lt, 32);
            if (type == 1) lt += __builtin_amdgcn_exp2f(sinkp[4 * g + qt] * LOG2E - mrun[qt]);
            const float inv = 1.0f / lt;
            bf16_t* op = O + (size_t)(rowbase + l15) * 1024 + qcol + 64 * qt + 4 * lg;
#pragma unroll
            for (int dt = 0; dt < 4; ++dt) { u32x2 w; w.x = cvt_pk_bf16(oacc[qt][dt][0] * inv, oacc[qt][dt][1] * inv); w.y = cvt_pk_bf16(oacc[qt][dt][2] * inv, oacc[qt][dt][3] * inv);
                *(u32x2*)(op + 16 * dt) = w; } }
    }
    return __builtin_amdgcn_s_memrealtime() - t_simple0;
#endif
}

#define RLX_AGENT __ATOMIC_RELAXED, __HIP_MEMORY_SCOPE_AGENT
#define XB_TMO      128
#define XB_XCNT(j)  (256  + 64 * (j))
#define XB_XSUB(j)  (1280 + 64 * (j))
#define XB_XGEN(j)  (2304 + 64 * (j))
#define XB_TOP      3328
#define XB_TOPGEN   3392
#define XCD_BAR_WORDS 3456
#define XB_SPIN_CAP (1u << 18)

__device__ __forceinline__ unsigned xb_ld(unsigned* p)              { return __hip_atomic_load(p, __ATOMIC_RELAXED, __HIP_MEMORY_SCOPE_AGENT); }
__device__ __forceinline__ unsigned xb_add(unsigned* p, unsigned v) { return __hip_atomic_fetch_add(p, v, __ATOMIC_RELAXED, __HIP_MEMORY_SCOPE_AGENT); }
__device__ __forceinline__ unsigned xb_xcc_id() { return (unsigned)__builtin_amdgcn_s_getreg((3 << 11) | 20) & 0xFu; }
#define XB_SPIN(cond, bar) do { unsigned _sp = 0; while (cond) { __builtin_amdgcn_s_sleep(1); \
    if ((++_sp & 255u) == 0u) { if (xb_ld(&(bar)[XB_TMO])) break; if (_sp > XB_SPIN_CAP) { atomicAdd(&(bar)[XB_TMO], 1u); break; } } } } while (0)

struct XcdBarrier {
    unsigned* bar; unsigned x;
    volatile LAS unsigned* st;
};

__device__ __forceinline__ XcdBarrier xcd_barrier_post(unsigned* bar, volatile LAS unsigned* st) {
    XcdBarrier b; b.bar = bar; b.x = xb_xcc_id(); b.st = st;
    if (threadIdx.x == 0) (void)xb_add(&bar[XB_XCNT(b.x)], 1u);
    return b;
}
__device__ __forceinline__ void xcd_barrier_complete(unsigned* bar, unsigned x, unsigned& nloc, unsigned& nx) {
    const unsigned G = gridDim.x * gridDim.y * gridDim.z;
    unsigned sum, cnt, mine, sp = 0u;
    for (;;) {
        sum = 0u; cnt = 0u; mine = 0u;
#pragma unroll
        for (unsigned j = 0; j < 16; ++j) { const unsigned c = xb_ld(&bar[XB_XCNT(j)]); sum += c; cnt += (c > 0u) ? 1u : 0u; mine = (j == x) ? c : mine; }
        if (sum == G) break;
        __builtin_amdgcn_s_sleep(1);
        if ((++sp & 255u) == 0u) { if (xb_ld(&bar[XB_TMO])) break; if (sp > XB_SPIN_CAP) { atomicAdd(&bar[XB_TMO], 1u); break; } }
    }
    nloc = mine > 0u ? mine : 1u; nx = cnt > 0u ? cnt : 1u;
}

__device__ __forceinline__ void xcd_barrier(const XcdBarrier& b) {
    asm volatile("s_waitcnt vmcnt(0)" ::: "memory");
    __syncthreads();
    if (threadIdx.x == 0) {
        unsigned* bar = b.bar;
        __builtin_amdgcn_s_waitcnt(0);
        unsigned nloc = b.st[0], nx = b.st[1];
        if (nloc == 0u) { xcd_barrier_complete(bar, b.x, nloc, nx); b.st[0] = nloc; b.st[1] = nx; }
        const unsigned old = xb_add(&bar[XB_XSUB(b.x)], 1u);
        const unsigned gen = old / nloc;
        if (old + 1u == (gen + 1u) * nloc) {
            __builtin_amdgcn_fence(__ATOMIC_RELEASE, "agent");
            asm volatile("s_waitcnt vmcnt(0)" ::: "memory");
            const unsigned og = xb_add(&bar[XB_TOP], 1u);
            const unsigned tg = og / nx;
            if (og + 1u == (tg + 1u) * nx) xb_add(&bar[XB_TOPGEN], 1u);
            else XB_SPIN(xb_ld(&bar[XB_TOPGEN]) == tg, bar);
            __builtin_amdgcn_fence(__ATOMIC_ACQUIRE, "agent");
            xb_add(&bar[XB_XGEN(b.x)], 1u);
            asm volatile("s_waitcnt vmcnt(0)" ::: "memory");
        } else {
            XB_SPIN(xb_ld(&bar[XB_XGEN(b.x)]) == gen, bar);
            __builtin_amdgcn_fence(__ATOMIC_ACQUIRE, "agent");
            asm volatile("s_waitcnt vmcnt(0)" ::: "memory");
        }
    }
    __syncthreads();
}

__global__ void __launch_bounds__(NTHR, 2) trunk_fwd(KArgs a) {
    extern __shared__ __attribute__((aligned(16))) unsigned char lds_raw[];
    LAS unsigned char* lds = (LAS unsigned char*)lds_raw;
    cg::grid_group grid = cg::this_grid();
    if (threadIdx.x < 16) ((LAS unsigned*)(lds + 131072))[threadIdx.x] = 0u;
    __syncthreads();
    const XcdBarrier xbar = xcd_barrier_post((unsigned*)(a.ws + OFF_BAR), (volatile LAS unsigned*)(lds + 131072 + 32));
#ifdef PROBE_KIND
    unsigned long long t_acc = 0;
#endif
    for (int si = a.step_lo; si < a.step_hi; ++si) {
        int tid = threadIdx.x; asm volatile("" : "+v"(tid));
        int z = 0; asm volatile("" : "+s"(z));
        unsigned char* ws = a.ws + z; unsigned char* WB = ws + OFF_W;
        const int st = a.steps[si], kind = st & 0xff, l = (st >> 8) & 0xf, arg = (st >> 12) & 0xf, jl = l >> 1;
        const int Mrows = (l == 3) ? ML : MALL;
#ifdef PROBE_KIND
        const unsigned long long t_0 = __builtin_amdgcn_s_memrealtime();
#endif
#ifdef ONLY
        if (kind != ONLY) continue;
#endif
        switch (kind) {
        case K_PROLOGUE: phase_prologue(a, z, tid, lds); break;
        case K_MOD0: phase_ln(a, z, tid, 0, 0, 0, MALL, blockIdx.x, gridDim.x); break;
        case K_LN: { const int which = arg & 3; const bool ctx_only = (arg >> 2) & 1;
            phase_ln(a, z, tid, l, which, ctx_only ? ML : 0, (l == 3) ? ML : MALL, blockIdx.x, gridDim.x); break; }
        case K_GEMM_EVIN: {
            const bool latonly = (arg >> 2) & 1, tail = (arg >> 3) & 1;
            pg8::Gemm g{(const bf16_t*)(ws + OFF_R2), (const bf16_t*)(WB + W_EV_IN) + (size_t)jl * 3072 * 1024, MALL, 3072, 1024, 1024, 0};
            EpiStore E{(bf16_t*)(ws + OFF_Z), 3072, 8};
            int M_ = MALL, G_ = gridDim.x; bool do_gemm = true;
            if (latonly) M_ = ML;
            if (tail) { g.A += (size_t)ML * 1024; E.O += (size_t)ML * 3072; M_ = MC; G_ = 96; do_gemm = blockIdx.x < 96; }
            g.M = M_;
            if (do_gemm) { pg8::StaticOrder S; S.init(M_, 3072, G_, blockIdx.x); pg8::gemm_phase<EpiStore, true>(tid, lds, g, S, E); }
            else phase_conv(a, z, tid, jl, 0, ML / 16, blockIdx.x - 96, gridDim.x - 96);
            break; }
        case K_GEMM_PLAIN: {
            const int pk = arg & 3; const bool latonly = (arg >> 2) & 1, tail = (arg >> 3) & 1;
            pg8::Gemm g; EpiStore E; int M_, N_;
            if (pk == PL_EVOUT) { g = pg8::Gemm{(const bf16_t*)(ws + OFF_Z), (const bf16_t*)(WB + W_EV_OUT) + (size_t)jl * 1024 * 1536, MALL, 1024, 1536, 3072, 0}; M_ = MALL; N_ = 1024; E = EpiStore{(bf16_t*)(ws + OFF_R2 + SZ_ROWS_BF), 1024, 0}; }
            else if (pk == PL_ODIN) { g = pg8::Gemm{(const bf16_t*)(ws + OFF_R2), (const bf16_t*)(WB + W_OD_IN) + (size_t)jl * 1536 * 1024, MALL, 1536, 1024, 1024, 0}; M_ = MALL; N_ = 1536; E = EpiStore{(bf16_t*)(ws + OFF_Z + ZO_QKV), 1536, 0}; }
            else if (pk == PL_ODOUT) { g = pg8::Gemm{(const bf16_t*)(ws + OFF_Z + ZO_O), (const bf16_t*)(WB + W_OD_OUT) + (size_t)jl * 1024 * 1024, Mrows, 1024, 1024, 1024, 0}; M_ = Mrows; N_ = 1024; E = EpiStore{(bf16_t*)(ws + OFF_R2 + SZ_ROWS_BF), 1024, 0}; }
            else { g = pg8::Gemm{(const bf16_t*)(ws + OFF_Z), (const bf16_t*)(WB + W_FFN_OUT) + (size_t)l * 1024 * 2816, Mrows, 1024, 2816, 2816, 0}; M_ = Mrows; N_ = 1024; E = EpiStore{(bf16_t*)(ws + OFF_R2 + SZ_ROWS_BF), 1024, 0}; }
            int G_ = gridDim.x; bool do_gemm = true;
            if (latonly) M_ = ML;
            const int tg = 8 * (N_ / 256);
            if (tail) { g.A += (size_t)ML * g.lda; E.O += (size_t)ML * E.ldc; M_ = MC; G_ = tg; do_gemm = blockIdx.x < tg; }
            g.M = M_;
            if (do_gemm) { pg8::StaticOrder S; S.init(M_, N_, G_, blockIdx.x); pg8::gemm_phase<EpiStore, true>(tid, lds, g, S, E); }
            else if (pk == PL_ODIN) phase_qkpost(a, z, tid, jl, 0, ML, blockIdx.x - tg, gridDim.x - tg);
            else phase_ln(a, z, tid, l, pk == PL_FFNOUT ? 2 : 1, 0, ML, blockIdx.x - tg, gridDim.x - tg);
            break; }
        case K_GEMM_SWIGLU: {
            pg8::Gemm g{(const bf16_t*)(ws + OFF_R2), (const bf16_t*)(WB + W_FFN_IN) + (size_t)l * 5632 * 1024, Mrows, 5632, 1024, 1024, 0};
            pg8::StaticOrder S; S.init(Mrows, 5632, gridDim.x, blockIdx.x);
            EpiSwiglu E{(bf16_t*)(ws + OFF_Z), 2816};
            pg8::gemm_phase<EpiSwiglu, true>(tid, lds, g, S, E); break; }
        case K_GEMM_GATE: {
            const int d = arg;
            pg8::Gemm g{(const bf16_t*)((unsigned char*)(a.out + z) + DO_XC), (const bf16_t*)(WB + W_GATE) + (size_t)jl * (2 * 8 * 256 * 128) + (size_t)d * 8 * 256 * 128, MALL, 2048, 128, 1024, 256};
            pg8::StaticOrder S; S.init(MALL, 2048, gridDim.x, blockIdx.x);
            EpiGate E{(bf16_t*)(ws + OFF_R2), (bf16_t*)(ws + OFF_R2 + SZ_ROWS_BF), (const bf16_t*)((unsigned char*)(a.out + z) + DO_XC),
                      a.in[z + 17] + (size_t)((jl * 2 + d) * 2 + 0) * 1024, a.in[z + 17] + (size_t)((jl * 2 + d) * 2 + 1) * 1024, (const float*)(ws + OFF_SPL) + (size_t)(jl * 2 + d) * 1024};
            pg8::gemm_phase<EpiGate, true>(tid, lds, g, S, E); break; }
        case K_CONV_GMLP: if (arg & 4) phase_conv(a, z, tid, jl, ML / 16, MC / 16, blockIdx.x, gridDim.x); else phase_conv(a, z, tid, jl, 0, MALL / 16, blockIdx.x, gridDim.x); break;
        case K_SCAN1: phase_scan(a, z, tid, arg, 1); break;
        case K_CARRY:
            phase_carry(a, z, tid, lds);
            if (arg == 0) phase_gmlp(a, z, tid, jl, lds, blockIdx.x, gridDim.x);
            break;
        case K_SCAN2: phase_scan(a, z, tid, arg, 2); break;
        case K_QKPOST: if (arg & 4) phase_qkpost(a, z, tid, jl, ML, MC, blockIdx.x, gridDim.x); else phase_qkpost(a, z, tid, jl, 0, MALL, blockIdx.x, gridDim.x); break;
        case K_ATTN: { const unsigned long long ts_ = phase_attn(a, z, tid, jl, l != 3, (char*)lds_raw);
#ifdef PROBE_ATTN_SIMPLE
            t_acc += ts_;
#else
            (void)ts_;
#endif
            break; }
        case K_DUMP: {
            const float* H = (const float*)(ws + OFF_H); const bf16_t* A_ = (const bf16_t*)(ws + OFF_R2); const bf16_t* Y_ = (const bf16_t*)(ws + OFF_R2 + SZ_ROWS_BF); const bf16_t* Z_ = (const bf16_t*)(ws + OFF_Z);
            for (size_t i = (size_t)blockIdx.x * NTHR + tid; i < (size_t)ML * 1024; i += (size_t)gridDim.x * NTHR) { const size_t row = i >> 10, c = i & 1023;
                (a.out + z)[i] = H[i] + bf_lo(A_[i]) + bf_lo(Y_[i]) + bf_lo(Z_[row * 3072 + c]) + bf_lo(Z_[row * 3072 + 1024 + c]) + bf_lo(Z_[row * 3072 + 2048 + c]); }
            break; }
        default: break;
        }
        if (si + 1 < a.step_hi) { if (si == a.step_lo) grid.sync(); else xcd_barrier(xbar); }
#ifdef PROBE_KIND
        if (kind == PROBE_KIND) t_acc += __builtin_amdgcn_s_memrealtime() - t_0;
#endif
    }
#ifdef PROBE_KIND
    { const unsigned long long t_s = __builtin_amdgcn_s_memrealtime(); while (__builtin_amdgcn_s_memrealtime() - t_s < t_acc) __builtin_amdgcn_s_sleep(8); }
#endif
}

extern "C" void kernel_launch(void* const* d_in, const int* in_sizes, int n_in, void* d_out, int out_size, void* d_ws, size_t ws_size, hipStream_t stream) {
    static int grid = 0;
    if (grid == 0) {
        if (n_in != 26 || out_size != ML * 1024 || ws_size < WS_NEED) { fprintf(stderr, "kernel_launch: unexpected problem (n_in %d out %d ws %zu need %zu)\n", n_in, out_size, ws_size, (size_t)WS_NEED); grid = -1; return; }
        int dev = 0, cus = 0, per_cu = 0;
        (void)hipGetDevice(&dev); (void)hipDeviceGetAttribute(&cus, hipDeviceAttributeMultiprocessorCount, dev);
        if (hipFuncSetAttribute((const void*)trunk_fwd, hipFuncAttributeMaxDynamicSharedMemorySize, LDS_BYTES) != hipSuccess) fprintf(stderr, "kernel_launch: hipFuncSetAttribute failed\n");
        if (hipOccupancyMaxActiveBlocksPerMultiprocessor(&per_cu, (const void*)trunk_fwd, NTHR, LDS_BYTES) != hipSuccess || per_cu < 1) { fprintf(stderr, "kernel_launch: occupancy query says %d\n", per_cu); per_cu = 1; }
        (void)hipGetLastError();
        if (per_cu > 1) per_cu = 1;
        grid = cus * per_cu;
    }
    if (grid < 0) return;
    KArgs a{};
    for (int i = 0; i < 26; ++i) a.in[i] = (const float*)d_in[i];
    a.out = (float*)d_out; a.ws = (unsigned char*)d_ws;
    int n = 0;
#ifndef PROBE_DUP
#define PROBE_DUP 0
#endif
#define STEP(kind, l, arg) do { a.steps[n++] = (kind) | ((l) << 8) | ((arg) << 12); if ((PROBE_DUP >> (kind)) & 1) a.steps[n++] = (kind) | ((l) << 8) | ((arg) << 12); } while (0)
    STEP(K_PROLOGUE, 0, 0); STEP(K_MOD0, 0, 0);
    const bool split = grid >= 192;
    for (int l = 0; l < 4; ++l) {
        const bool sp = split && l != 3;
        if ((l & 1) == 0) {
            if (split) { STEP(K_GEMM_EVIN, l, 4); STEP(K_GEMM_EVIN, l, 8); STEP(K_CONV_GMLP, l, 4); } else { STEP(K_GEMM_EVIN, l, 0); STEP(K_CONV_GMLP, l, 0); }
            for (int d = 0; d < 2; ++d) { STEP(K_GEMM_GATE, l, d); STEP(K_SCAN1, l, d); STEP(K_CARRY, l, d); STEP(K_SCAN2, l, d); }
            if (sp) { STEP(K_GEMM_PLAIN, l, PL_EVOUT | 4); STEP(K_GEMM_PLAIN, l, PL_EVOUT | 8); STEP(K_LN, l, 1 | 4); } else { STEP(K_GEMM_PLAIN, l, PL_EVOUT); STEP(K_LN, l, 1); }
        } else {
            if (split) { STEP(K_GEMM_PLAIN, l, PL_ODIN | 4); STEP(K_GEMM_PLAIN, l, PL_ODIN | 8); STEP(K_QKPOST, l, 4); } else { STEP(K_GEMM_PLAIN, l, PL_ODIN); STEP(K_QKPOST, l, 0); }
            STEP(K_ATTN, l, 0);
            if (sp) { STEP(K_GEMM_PLAIN, l, PL_ODOUT | 4); STEP(K_GEMM_PLAIN, l, PL_ODOUT | 8); STEP(K_LN, l, 1 | 4); } else { STEP(K_GEMM_PLAIN, l, PL_ODOUT); STEP(K_LN, l, 1); }
        }
        STEP(K_GEMM_SWIGLU, l, 0);
        if (sp) { STEP(K_GEMM_PLAIN, l, PL_FFNOUT | 4); STEP(K_GEMM_PLAIN, l, PL_FFNOUT | 8); STEP(K_LN, l, 2 | 4); } else { STEP(K_GEMM_PLAIN, l, PL_FFNOUT); STEP(K_LN, l, 2); }
    }
#undef STEP
#ifdef TRUNC
    n = TRUNC; a.steps[n++] = K_DUMP;
#endif
    a.step_lo = 0; a.step_hi = n;
    (void)hipMemsetAsync((unsigned char*)d_ws + OFF_BAR, 0, 16384, stream);
    void* args[] = {&a};
#ifndef FORCE_MULTI
#define FORCE_MULTI 0
#endif
    hipError_t e = FORCE_MULTI ? hipErrorUnknown : hipLaunchCooperativeKernel((const void*)trunk_fwd, dim3(grid), dim3(NTHR), args, LDS_BYTES, stream);
    if (e != hipSuccess) {
        if (!FORCE_MULTI) fprintf(stderr, "kernel_launch: cooperative launch failed: %s (grid %d); falling back to one launch per step\n", hipGetErrorString(e), grid);
        (void)hipGetLastError();
        for (int s = 0; s < n; ++s) { a.step_lo = s; a.step_hi = s + 1; hipLaunchKernelGGL(trunk_fwd, dim3(grid), dim3(NTHR), LDS_BYTES, stream, a); }
    }
}
```

```cpp
#include <hip/hip_runtime.h>
#include <hip/hip_cooperative_groups.h>
#include <cstdio>
#include <cstdint>
#include <hip/hip_bf16.h>
#include <cmath>
namespace cg = cooperative_groups;

#define LAS __attribute__((address_space(3)))
typedef unsigned short bf16_t;
typedef short bf16x8 __attribute__((ext_vector_type(8)));
typedef float f32x4 __attribute__((ext_vector_type(4)));
typedef float f32x2 __attribute__((ext_vector_type(2)));
typedef unsigned u32x4 __attribute__((ext_vector_type(4)));
typedef unsigned u32x2 __attribute__((ext_vector_type(2)));

constexpr int DM = 1024, NB = 8, SEQ = 8192, CTXL = 256, ML = NB * SEQ, MC = NB * CTXL, MALL = ML + MC, FH = 2816, KVR = SEQ + CTXL;
constexpr int NTHR = 512, NWAVE = 8;
constexpr int LDS_BYTES = 131072 + 2048;
constexpr float ALPHA = 1.681792830507429f, LOG2E = 1.4426950408889634f;
constexpr float QSCALE = 0.125f * 1.4426950408889634f;

constexpr size_t SZ_ROWS_BF = (size_t)MALL * 1024 * 2;
constexpr size_t OFF_H = 0;
constexpr size_t OFF_W = OFF_H + (size_t)MALL * 1024 * 4;
constexpr size_t W_FFN_IN = 0;
constexpr size_t W_FFN_OUT = W_FFN_IN + 4ull * 5632 * 1024 * 2;
constexpr size_t W_EV_IN = W_FFN_OUT + 4ull * 1024 * 2816 * 2;
constexpr size_t W_EV_OUT = W_EV_IN + 2ull * 3072 * 1024 * 2;
constexpr size_t W_GATE = W_EV_OUT + 2ull * 1024 * 1536 * 2;
constexpr size_t W_OD_IN = W_GATE + 2ull * 2 * 8 * 256 * 128 * 2;
constexpr size_t W_OD_OUT = W_OD_IN + 2ull * 1536 * 1024 * 2;
constexpr size_t W_END = W_OD_OUT + 2ull * 1024 * 1024 * 2;
constexpr size_t OFF_MOD = OFF_W + W_END;
constexpr size_t OFF_Z = OFF_MOD + 4ull * 9 * 6144 * 4;
constexpr size_t OFF_R2 = OFF_Z + (size_t)MALL * 3072 * 2;
constexpr size_t OFF_SPL = OFF_R2 + 2 * SZ_ROWS_BF;
constexpr size_t OFF_BAR = OFF_SPL + 16384;
constexpr size_t WS_NEED = OFF_BAR + 16384;
constexpr size_t ZO_QKV = 0;
constexpr size_t ZO_O = (size_t)MALL * 1536 * 2;
constexpr size_t ZO_KK = ZO_O + SZ_ROWS_BF;
constexpr size_t ZO_VT = ZO_KK + 2ull * 8 * 2 * KVR * 64 * 2;
constexpr size_t DO_VV = 0;
constexpr size_t DO_XC = 0;
constexpr size_t DO_SUMM = SZ_ROWS_BF;
constexpr size_t DO_CARRY = DO_SUMM + 8ull * 264 * 1024 * 8;

struct KArgs {
    const float* in[26];
    float* out; unsigned char* ws;
    int step_lo, step_hi;
    int steps[96];
};
enum { K_PROLOGUE = 0, K_MOD0, K_GEMM_EVIN, K_CONV_GMLP, K_GEMM_GATE, K_SCAN1, K_CARRY, K_SCAN2, K_GEMM_PLAIN, K_LN, K_GEMM_SWIGLU, K_QKPOST, K_ATTN, K_DUMP };
enum { PL_EVOUT = 0, PL_ODIN, PL_ODOUT, PL_FFNOUT };

typedef __bf16 bf16x2_t __attribute__((ext_vector_type(2)));
__device__ __forceinline__ unsigned cvt_pk_bf16(float lo, float hi) { f32x2 v = {lo, hi}; bf16x2_t b = __builtin_convertvector(v, bf16x2_t); return __builtin_bit_cast(unsigned, b); }
__device__ __forceinline__ float bf_lo(unsigned w) { return __uint_as_float(w << 16); }
__device__ __forceinline__ float bf_hi(unsigned w) { return __uint_as_float(w & 0xffff0000u); }
__device__ __forceinline__ float fast_sigmoid(float x) { return __builtin_amdgcn_rcpf(1.0f + __builtin_amdgcn_exp2f(-x * LOG2E)); }
__device__ __forceinline__ float silu_f(float x) { return x * fast_sigmoid(x); }
__device__ __forceinline__ float gelu_tanh(float x) { const float u = x + 0.044715f * x * x * x; return x * __builtin_amdgcn_rcpf(1.0f + __builtin_amdgcn_exp2f(-2.0f * 0.7978845608028654f * LOG2E * u)); }
__device__ __forceinline__ void unpack8(const u32x4 w, float (&x)[8]) { x[0] = bf_lo(w.x); x[1] = bf_hi(w.x); x[2] = bf_lo(w.y); x[3] = bf_hi(w.y); x[4] = bf_lo(w.z); x[5] = bf_hi(w.z); x[6] = bf_lo(w.w); x[7] = bf_hi(w.w); }
__device__ __forceinline__ float wave_sum(float v) {
#pragma unroll
    for (int o = 1; o < 64; o <<= 1) v += __shfl_xor(v, o);
    return v;
}

namespace pg8 {
constexpr int BM = 256, BK = 64, HALF = 128, HTB = HALF * BK * 2, STAGE_BYTES = 8 * HTB, NXCD = 8, WGM = 4;
__host__ __device__ __forceinline__ int lds_byte(int r, int c) { const int st = (r >> 4) * 2 + (c >> 5), rr = r & 15, cc = c & 31, ob = rr * 64 + cc * 2; return st * 1024 + (ob ^ (((ob >> 9) & 1) << 5)); }
__host__ __device__ __forceinline__ void stage_rc(int b, int& R, int& C) { const int st = b / 1024, sb = b % 1024, swz = sb ^ (((sb >> 9) & 1) << 5); R = (st >> 1) * 16 + swz / 64; C = (st & 1) * 32 + (swz % 64) / 2; }
__host__ __device__ __forceinline__ int perm32(int rho) { const int n = rho >> 4, i = rho & 15; return 8 * (i >> 2) + 4 * n + (i & 3); }
struct Unit { int pm, pn; };
struct Gemm { const bf16_t* A; const bf16_t* Bt; int M, N, K, lda, a_pn_off; };
struct StaticOrder {
    int nM, nN, nwg, G, c;
    __device__ void init(int M, int N, int G_, int c_) { nM = M / BM; nN = N / BM; nwg = nM * nN; G = G_; c = c_; }
    __device__ bool next(int i, Unit& u) const {
        const long L = (long)i * G + c; if (L >= nwg) return false;
        int wgid = (int)L; { const int q = nwg / NXCD, r = nwg % NXCD, xcd = wgid % NXCD, off = wgid / NXCD; wgid = (xcd < r ? xcd * (q + 1) : r * (q + 1) + (xcd - r) * q) + off; }
        const int nig = WGM * nN, gid = wgid / nig, fm = gid * WGM, gsz = (nM - fm) < WGM ? (nM - fm) : WGM;
        u.pm = fm + ((wgid % nig) % gsz); u.pn = (wgid % nig) / gsz; return true;
    }
};
template <class Epi, bool ALIGN_EPI>
__device__ __forceinline__ void gemm_phase(int tid, LAS unsigned char* lds, const Gemm g, const StaticOrder& S, const Epi& E) {
    const int wid = __builtin_amdgcn_readfirstlane(tid >> 6), lane = tid & 63, wr = wid >> 2, wc = wid & 3, fr = lane & 15, fq = lane >> 4;
    const int K = g.K, nt = K / BK;
    unsigned voffA[2], voffB[2];
#pragma unroll
    for (int i = 0; i < 2; ++i) { int R, C; stage_rc(tid * 16 + i * 8192, R, C); const int Rb = Epi::PERM ? ((R & ~31) + perm32(R & 31)) : R;
        voffA[i] = (unsigned)(R * g.lda + C) * 2u; voffB[i] = (unsigned)(Rb * K + C) * 2u; }
    const size_t kstep = (size_t)(BK * 2);
    const size_t hstepA = (size_t)HALF * g.lda * 2, hstepB = (size_t)HALF * K * 2;
    const size_t tstepA = 2 * hstepA, tstepB = 2 * hstepB;
    const unsigned ldsw = (unsigned)wid * 1024u;
    const int aoff = lds_byte(wr * 64 + fr, fq * 8), boff = lds_byte(wc * 32 + fr, fq * 8);
#define PG8_SA(b, h) (((b) * 2 + (h)) * HTB)
#define PG8_SB(b, h) ((4 + (b) * 2 + (h)) * HTB)
#define PG8_STAGE(bufoff, gbase, voff) do { _Pragma("unroll") for (int _i = 0; _i < 2; ++_i) \
        __builtin_amdgcn_global_load_lds((const unsigned*)((const char*)(gbase) + (voff)[_i]), (LAS unsigned*)(lds + (bufoff) + ldsw + _i * 8192), 16, 0, 0); } while (0)
#define PG8_LDA(dst, b, h) do { _Pragma("unroll") for (int m = 0; m < 4; ++m) _Pragma("unroll") for (int k = 0; k < 2; ++k) dst[m][k] = *(const LAS bf16x8*)(lds + PG8_SA(b, h) + aoff + m * 2048 + k * 1024); } while (0)
#define PG8_LDB(dst, b, h) do { _Pragma("unroll") for (int n = 0; n < 2; ++n) _Pragma("unroll") for (int k = 0; k < 2; ++k) dst[n][k] = *(const LAS bf16x8*)(lds + PG8_SB(b, h) + boff + n * 2048 + k * 1024); } while (0)
#define PG8_MMA(ai, bj, At, Bt) do { __builtin_amdgcn_s_setprio(1); _Pragma("unroll") for (int m = 0; m < 4; ++m) _Pragma("unroll") for (int n = 0; n < 2; ++n) _Pragma("unroll") for (int k = 0; k < 2; ++k) \
        acc[ai][bj][m][n] = __builtin_amdgcn_mfma_f32_16x16x32_bf16(Bt[n][k], At[m][k], acc[ai][bj][m][n], 0, 0, 0); __builtin_amdgcn_s_setprio(0); } while (0)
#define PG8_WAIT_V(n) asm volatile("s_waitcnt vmcnt(" #n ")" ::: "memory")
#define PG8_WAIT_L(n) asm volatile("s_waitcnt lgkmcnt(" #n ")" ::: "memory")
#define PG8_BAR __builtin_amdgcn_s_barrier()
#define PG8_SCHED __builtin_amdgcn_sched_barrier(0)
    Unit cur, nxt; int ui = 0;
    if (!S.next(0, cur)) return;
    f32x4 acc[2][2][4][2];
#pragma unroll
    for (int a = 0; a < 2; ++a)
#pragma unroll
        for (int b = 0; b < 2; ++b)
#pragma unroll
            for (int m = 0; m < 4; ++m)
#pragma unroll
                for (int n = 0; n < 2; ++n) acc[a][b][m][n] = (f32x4){0.f, 0.f, 0.f, 0.f};
    bf16x8 At[4][2], B0[2][2], B1[2][2];
    const char* cA = (const char*)g.A + (size_t)cur.pm * tstepA + (size_t)cur.pn * (size_t)g.a_pn_off; const char* cB = (const char*)g.Bt + (size_t)cur.pn * tstepB;
    PG8_STAGE(PG8_SB(0, 0), cB, voffB); PG8_STAGE(PG8_SB(0, 1), cB + hstepB, voffB); PG8_STAGE(PG8_SA(0, 0), cA, voffA); PG8_STAGE(PG8_SA(0, 1), cA + hstepA, voffA);
    if (wr == 1) PG8_BAR;
    PG8_WAIT_V(2); PG8_BAR;
    PG8_STAGE(PG8_SB(1, 0), cB + kstep, voffB); PG8_STAGE(PG8_SA(1, 0), cA + kstep, voffA); PG8_STAGE(PG8_SB(1, 1), cB + hstepB + kstep, voffB);
    PG8_WAIT_V(6); PG8_BAR;
    for (;;) {
        const bool has_next = S.next(ui + 1, nxt);
        const char* nA = has_next ? (const char*)g.A + (size_t)nxt.pm * tstepA + (size_t)nxt.pn * (size_t)g.a_pn_off : cA; const char* nB = has_next ? (const char*)g.Bt + (size_t)nxt.pn * tstepB : cB;
        for (int t = 0; t < nt; t += 2) {
            const bool last = (t == nt - 2);
            const char* a1 = cA + (size_t)(t + 1) * kstep;
            const char* a2 = last ? nA : cA + (size_t)(t + 2) * kstep; const char* b2 = last ? nB : cB + (size_t)(t + 2) * kstep;
            const char* a3 = a2 + kstep; const char* b3 = b2 + kstep;
            PG8_LDB(B0, 0, 0); PG8_LDB(B1, 0, 1); PG8_SCHED; PG8_LDA(At, 0, 0); PG8_STAGE(PG8_SA(1, 1), a1 + hstepA, voffA);
            PG8_WAIT_V(8); PG8_WAIT_L(0); PG8_BAR; PG8_MMA(0, 0, At, B0); PG8_MMA(0, 1, At, B1); PG8_BAR; PG8_SCHED;
            PG8_LDA(At, 0, 1); PG8_STAGE(PG8_SB(0, 0), b2, voffB); PG8_STAGE(PG8_SB(0, 1), b2 + hstepB, voffB); PG8_STAGE(PG8_SA(0, 0), a2, voffA);
            PG8_WAIT_V(8); PG8_WAIT_L(0); PG8_BAR; PG8_MMA(1, 0, At, B0); PG8_MMA(1, 1, At, B1); PG8_BAR; PG8_SCHED;
            PG8_LDB(B0, 1, 0); PG8_LDB(B1, 1, 1); PG8_SCHED; PG8_LDA(At, 1, 0); PG8_STAGE(PG8_SA(0, 1), a2 + hstepA, voffA);
            PG8_WAIT_V(8); PG8_WAIT_L(0); PG8_BAR; PG8_MMA(0, 0, At, B0); PG8_MMA(0, 1, At, B1); PG8_BAR; PG8_SCHED;
            PG8_LDA(At, 1, 1); PG8_STAGE(PG8_SB(1, 0), b3, voffB); PG8_STAGE(PG8_SB(1, 1), b3 + hstepB, voffB); PG8_STAGE(PG8_SA(1, 0), a3, voffA);
            PG8_WAIT_V(8); PG8_WAIT_L(0); PG8_BAR; PG8_MMA(1, 0, At, B0); PG8_MMA(1, 1, At, B1); PG8_BAR; PG8_SCHED;
        }
        if constexpr (ALIGN_EPI) { if (wr == 0) PG8_BAR; }
        E(acc, cur, wr, wc, fr, fq);
        if (!has_next) break;
#pragma unroll
        for (int a = 0; a < 2; ++a)
#pragma unroll
            for (int b = 0; b < 2; ++b)
#pragma unroll
                for (int m = 0; m < 4; ++m)
#pragma unroll
                    for (int n = 0; n < 2; ++n) acc[a][b][m][n] = (f32x4){0.f, 0.f, 0.f, 0.f};
        cur = nxt; cA = nA; cB = nB; ++ui;
        if constexpr (ALIGN_EPI) { if (wr == 1) PG8_BAR; }
    }
    PG8_WAIT_V(0);
    if constexpr (!ALIGN_EPI) { if (wr == 0) PG8_BAR; }
    PG8_BAR;
#undef PG8_SA
#undef PG8_SB
#undef PG8_STAGE
#undef PG8_LDA
#undef PG8_LDB
#undef PG8_MMA
#undef PG8_WAIT_V
#undef PG8_WAIT_L
#undef PG8_BAR
#undef PG8_SCHED
}
}

struct EpiStore {
    static constexpr bool PERM = true;
    bf16_t* O; int ldc; int gelu_tiles;
    __device__ __forceinline__ void operator()(const f32x4 (&acc)[2][2][4][2], const pg8::Unit& u, int wr, int wc, int fr, int fq) const {
        const int row0 = u.pm * 256 + wr * 64 + fr, col0 = u.pn * 256 + wc * 32 + 8 * fq; const bool act = u.pn < gelu_tiles;
#pragma unroll
        for (int ai = 0; ai < 2; ++ai)
#pragma unroll
            for (int m = 0; m < 4; ++m) { bf16_t* rowp = O + (size_t)(row0 + ai * 128 + m * 16) * ldc + col0;
#pragma unroll
                for (int bj = 0; bj < 2; ++bj) { f32x4 v0 = acc[ai][bj][m][0], v1 = acc[ai][bj][m][1];
                    if (act) {
#pragma unroll
                        for (int e = 0; e < 4; ++e) { v0[e] = gelu_tanh(v0[e]); v1[e] = gelu_tanh(v1[e]); } }
                    u32x4 w; w.x = cvt_pk_bf16(v0[0], v0[1]); w.y = cvt_pk_bf16(v0[2], v0[3]); w.z = cvt_pk_bf16(v1[0], v1[1]); w.w = cvt_pk_bf16(v1[2], v1[3]);
                    *(u32x4*)(rowp + bj * 128) = w; } }
    }
};
struct EpiSwiglu {
    static constexpr bool PERM = true;
    bf16_t* O; int ldc;
    __device__ __forceinline__ void operator()(const f32x4 (&acc)[2][2][4][2], const pg8::Unit& u, int wr, int wc, int fr, int fq) const {
        const int row0 = u.pm * 256 + wr * 64 + fr, col0 = u.pn * 128 + wc * 32 + 8 * fq;
#pragma unroll
        for (int ai = 0; ai < 2; ++ai)
#pragma unroll
            for (int m = 0; m < 4; ++m) { bf16_t* rowp = O + (size_t)(row0 + ai * 128 + m * 16) * ldc + col0;
                f32x4 v0, v1;
#pragma unroll
                for (int e = 0; e < 4; ++e) { v0[e] = silu_f(acc[ai][0][m][0][e]) * acc[ai][1][m][0][e]; v1[e] = silu_f(acc[ai][0][m][1][e]) * acc[ai][1][m][1][e]; }
                u32x4 w; w.x = cvt_pk_bf16(v0[0], v0[1]); w.y = cvt_pk_bf16(v0[2], v0[3]); w.z = cvt_pk_bf16(v1[0], v1[1]); w.w = cvt_pk_bf16(v1[2], v1[3]);
                __builtin_nontemporal_store(w, (u32x4*)rowp); }
    }
};
struct EpiGate {
    static constexpr bool PERM = true;
    bf16_t* LA; bf16_t* BBo; const bf16_t* XC; const float* gb_r; const float* gb_i; const float* spl;
    __device__ __forceinline__ void operator()(const f32x4 (&acc)[2][2][4][2], const pg8::Unit& u, int wr, int wc, int fr, int fq) const {
        const int row0 = u.pm * 256 + wr * 64 + fr, ch0 = u.pn * 128 + wc * 32 + 8 * fq;
#pragma unroll
        for (int ai = 0; ai < 2; ++ai)
#pragma unroll
            for (int m = 0; m < 4; ++m) { const size_t off = (size_t)(row0 + ai * 128 + m * 16) * 1024 + ch0;
                const u32x4 xw = *(const u32x4*)(XC + off);
                u32x4 w1, w2;
#pragma unroll
                for (int n = 0; n < 2; ++n) {
                    const f32x4 br = *(const f32x4*)(gb_r + ch0 + 4 * n), bi = *(const f32x4*)(gb_i + ch0 + 4 * n), sp = *(const f32x4*)(spl + ch0 + 4 * n);
                    const unsigned xa = n == 0 ? xw.x : xw.z, xb = n == 0 ? xw.y : xw.w;
                    const float xv[4] = {bf_lo(xa), bf_hi(xa), bf_lo(xb), bf_hi(xb)};
                    float la[4], bb[4];
#pragma unroll
                    for (int e = 0; e < 4; ++e) { const float gr = acc[ai][0][m][n][e] + br[e], gi = acc[ai][1][m][n][e] + bi[e];
                        const float l_ = sp[e] * fast_sigmoid(gr); la[e] = l_;
                        const float om = fmaxf(0.0f, 1.0f - __builtin_amdgcn_exp2f(2.0f * LOG2E * l_)); bb[e] = __builtin_amdgcn_sqrtf(om) * fast_sigmoid(gi) * xv[e]; }
                    if (n == 0) { w1.x = cvt_pk_bf16(la[0], la[1]); w1.y = cvt_pk_bf16(la[2], la[3]); w2.x = cvt_pk_bf16(bb[0], bb[1]); w2.y = cvt_pk_bf16(bb[2], bb[3]); }
                    else { w1.z = cvt_pk_bf16(la[0], la[1]); w1.w = cvt_pk_bf16(la[2], la[3]); w2.z = cvt_pk_bf16(bb[0], bb[1]); w2.w = cvt_pk_bf16(bb[2], bb[3]); }
                }
                *(u32x4*)(LA + off) = w1; *(u32x4*)(BBo + off) = w2; }
    }
};

__device__ __forceinline__ int colmap(int id, int n) {
    if (id == 1) { const int t = n >> 8, w = n & 255; return w < 128 ? t * 128 + w : FH + t * 128 + (w - 128); }
    if (id == 2) return n < 1024 ? n : (n < 2048 ? n + 1024 : n - 1024);
    return n;
}
__device__ __forceinline__ void tr_item(const float* W, int ldsrc, int K, bf16_t* WT, int n0, int k0, int mapid, LAS float* scr, int lane) {
    const int sc = colmap(mapid, n0 + (lane & 31));
#pragma unroll 8
    for (int i = 0; i < 32; ++i) { const int kk = 2 * i + (lane >> 5); scr[kk * 33 + (lane & 31)] = W[(size_t)(k0 + kk) * ldsrc + sc]; }
    asm volatile("s_waitcnt lgkmcnt(0)" ::: "memory");
    const int c = lane & 7;
#pragma unroll
    for (int j = 0; j < 4; ++j) { const int n = (lane >> 3) + 8 * j; const LAS float* s = scr + (8 * c) * 33 + n;
        u32x4 o; o.x = cvt_pk_bf16(s[0 * 33], s[1 * 33]); o.y = cvt_pk_bf16(s[2 * 33], s[3 * 33]); o.z = cvt_pk_bf16(s[4 * 33], s[5 * 33]); o.w = cvt_pk_bf16(s[6 * 33], s[7 * 33]);
        *(u32x4*)(WT + (size_t)(n0 + n) * K + k0 + 8 * c) = o; }
    asm volatile("s_waitcnt lgkmcnt(0)" ::: "memory");
}
__device__ __forceinline__ void phase_prologue(const KArgs& a, const int z, const int tid, LAS unsigned char* lds) {
    const int lane = tid & 63, wave = tid >> 6;
    LAS float* sv = (LAS float*)(lds + 73728);
    LAS float* part = (LAS float*)(lds + 110592);
    float* MOD = (float*)((a.ws + z) + OFF_MOD);
    for (int i = tid; i < 9 * 1024; i += NTHR) { const int s = i >> 10, k = i & 1023; const float v = s < 8 ? a.in[z + 1][s * 1024 + k] : a.in[z + 3][k]; sv[i] = v / (1.0f + __expf(-v)); }
    __syncthreads();
    for (int item = blockIdx.x; item < 768; item += gridDim.x) {
        const int l = item / 192, n0 = (item % 192) * 32, ks = tid >> 5, cl = tid & 31;
        const float* w = a.in[z + 4] + (size_t)l * 1024 * 6144 + n0 + cl;
        float acc[9];
#pragma unroll
        for (int s = 0; s < 9; ++s) acc[s] = 0.f;
        const int k0 = ks * 64;
        for (int kb = 0; kb < 64; kb += 16) { float wv[16];
#pragma unroll
            for (int k = 0; k < 16; ++k) wv[k] = w[(size_t)(k0 + kb + k) * 6144];
#pragma unroll
            for (int k = 0; k < 16; ++k)
#pragma unroll
                for (int s = 0; s < 9; ++s) acc[s] += sv[s * 1024 + k0 + kb + k] * wv[k]; }
#pragma unroll
        for (int s = 0; s < 9; ++s) part[(ks * 9 + s) * 32 + cl] = acc[s];
        __syncthreads();
        for (int idx = tid; idx < 288; idx += NTHR) { const int s = idx >> 5, n = idx & 31; float r = a.in[z + 5][l * 6144 + n0 + n];
#pragma unroll
            for (int w16 = 0; w16 < 16; ++w16) r += part[(w16 * 9 + s) * 32 + n];
            MOD[(size_t)(l * 9 + s) * 6144 + n0 + n] = r; }
        __syncthreads();
    }
    for (int i = blockIdx.x * NTHR + tid; i < 4096; i += gridDim.x * NTHR) ((float*)((a.ws + z) + OFF_SPL))[i] = -8.0f * log1pf(__expf(-a.in[z + 18][i]));
    LAS float* scr = (LAS float*)(lds + wave * 8448);
    unsigned char* WB = (a.ws + z) + OFF_W;
    const int gw = blockIdx.x * NWAVE + wave, NGW = gridDim.x * NWAVE;
    for (int it = gw; it < 24576; it += NGW) {
        int r = it;
        if (r < 11264) { const int l = r / 2816, q = r % 2816, kb = q / 176, nb = q % 176;
            tr_item(a.in[z + 10] + (size_t)l * 1024 * 5632, 5632, 1024, (bf16_t*)(WB + W_FFN_IN) + (size_t)l * 5632 * 1024, nb * 32, kb * 64, 1, scr, lane); continue; }
        r -= 11264;
        if (r < 5632) { const int l = r / 1408, q = r % 1408, kb = q / 32, nb = q % 32;
            tr_item(a.in[z + 11] + (size_t)l * 2816 * 1024, 1024, 2816, (bf16_t*)(WB + W_FFN_OUT) + (size_t)l * 1024 * 2816, nb * 32, kb * 64, 0, scr, lane); continue; }
        r -= 5632;
        if (r < 3072) { const int j = r / 1536, q = r % 1536, kb = q / 96, nb = q % 96;
            tr_item(a.in[z + 12] + (size_t)j * 1024 * 3072, 3072, 1024, (bf16_t*)(WB + W_EV_IN) + (size_t)j * 3072 * 1024, nb * 32, kb * 64, 2, scr, lane); continue; }
        r -= 3072;
        if (r < 1536) { const int j = r / 768, q = r % 768, kb = q / 32, nb = q % 32;
            tr_item(a.in[z + 13] + (size_t)j * 1536 * 1024, 1024, 1536, (bf16_t*)(WB + W_EV_OUT) + (size_t)j * 1024 * 1536, nb * 32, kb * 64, 0, scr, lane); continue; }
        r -= 1536;
        if (r < 512) { const int blk = r >> 3, q = r & 7, kb = q >> 2, nb = q & 3; const int h = blk & 7, k = (blk >> 3) & 1, d = (blk >> 4) & 1, j = blk >> 5;
            tr_item(a.in[z + 16] + (size_t)blk * 16384, 128, 128, (bf16_t*)(WB + W_GATE) + (size_t)j * (2 * 8 * 256 * 128) + (size_t)((d * 8 + h) * 256 + k * 128) * 128, nb * 32, kb * 64, 0, scr, lane); continue; }
        r -= 512;
        if (r < 1536) { const int j = r / 768, q = r % 768, kb = q / 48, nb = q % 48;
            tr_item(a.in[z + 21] + (size_t)j * 1024 * 1536, 1536, 1024, (bf16_t*)(WB + W_OD_IN) + (size_t)j * 1536 * 1024, nb * 32, kb * 64, 0, scr, lane); continue; }
        r -= 1536;
        { const int j = r / 512, q = r % 512, kb = q / 32, nb = q % 32;
            tr_item(a.in[z + 22] + (size_t)j * 1024 * 1024, 1024, 1024, (bf16_t*)(WB + W_OD_OUT) + (size_t)j * 1024 * 1024, nb * 32, kb * 64, 0, scr, lane); }
    }
}

struct LnCtx { float* H; const float* MOD; bf16_t* A; const bf16_t* Y; const float* gam; const float* bet; float* outp; int l, which, lm, shi, sci, gi; bool final_, from_in; const float* xin; const float* cin; };
__device__ __forceinline__ const float* ln_src(const LnCtx& c, int row) { return c.from_in ? (row < ML ? c.xin + (size_t)row * 1024 : c.cin + (size_t)(row - ML) * 1024) : c.H + (size_t)row * 1024; }
__device__ __forceinline__ void ln_finish(const LnCtx& c, int lane, int row, f32x4 (&v)[4], const u32x2 (&yw)[4]) {
    const int ms = row < ML ? (row >> 13) : 8;
    if (c.which != 0) {
        const float* gp = c.MOD + (size_t)(c.l * 9 + ms) * 6144 + c.gi * 1024; float s = 0.f;
#pragma unroll
        for (int j = 0; j < 4; ++j) { const f32x4 g = *(const f32x4*)(gp + 4 * lane + 256 * j);
            v[j][0] = ALPHA * v[j][0] + g[0] * bf_lo(yw[j].x); v[j][1] = ALPHA * v[j][1] + g[1] * bf_hi(yw[j].x); v[j][2] = ALPHA * v[j][2] + g[2] * bf_lo(yw[j].y); v[j][3] = ALPHA * v[j][3] + g[3] * bf_hi(yw[j].y);
            s += (v[j][0] + v[j][1]) + (v[j][2] + v[j][3]); }
        const float mean = wave_sum(s) * (1.0f / 1024.0f); float s2 = 0.f;
#pragma unroll
        for (int j = 0; j < 4; ++j) { v[j] = v[j] - mean; s2 += (v[j][0] * v[j][0] + v[j][1] * v[j][1]) + (v[j][2] * v[j][2] + v[j][3] * v[j][3]); }
        const float rstd = rsqrtf(wave_sum(s2) * (1.0f / 1024.0f) + 1e-6f);
        float* dst = c.final_ ? c.outp + (size_t)row * 1024 : c.H + (size_t)row * 1024;
#pragma unroll
        for (int j = 0; j < 4; ++j) { const f32x4 gm = *(const f32x4*)(c.gam + 4 * lane + 256 * j), bt = *(const f32x4*)(c.bet + 4 * lane + 256 * j);
            v[j] = v[j] * rstd * gm + bt; __builtin_nontemporal_store(v[j], (f32x4*)(dst + 4 * lane + 256 * j)); }
    }
    if (!c.final_) {
        const float* shp = c.MOD + (size_t)(c.lm * 9 + ms) * 6144 + c.shi * 1024; const float* scp = c.MOD + (size_t)(c.lm * 9 + ms) * 6144 + c.sci * 1024;
#pragma unroll
        for (int j = 0; j < 4; ++j) { const f32x4 sh = *(const f32x4*)(shp + 4 * lane + 256 * j), sc = *(const f32x4*)(scp + 4 * lane + 256 * j);
            const f32x4 o = v[j] * (sc + 1.0f) + sh; u32x2 w; w.x = cvt_pk_bf16(o[0], o[1]); w.y = cvt_pk_bf16(o[2], o[3]);
            *(u32x2*)(c.A + (size_t)row * 1024 + 4 * lane + 256 * j) = w; }
    }
}
__device__ __forceinline__ void phase_ln(const KArgs& a, const int z, const int tid, int l, int which, const int r_lo, const int r_hi, const int vb, const int nvb) {
    const int lane = tid & 63, wave = tid >> 6;
    const int gw = vb * NWAVE + wave, NGW = nvb * NWAVE;
    LnCtx c;
    c.H = (float*)((a.ws + z) + OFF_H); c.MOD = (const float*)((a.ws + z) + OFF_MOD);
    c.A = (bf16_t*)((a.ws + z) + OFF_R2); c.Y = (const bf16_t*)((a.ws + z) + OFF_R2 + SZ_ROWS_BF);
    c.final_ = (l == 3 && which == 2); c.from_in = (which == 0) || (which == 1 && l == 0);
    c.gam = which == 1 ? a.in[z + 6] + l * 1024 : a.in[z + 8] + l * 1024; c.bet = which == 1 ? a.in[z + 7] + l * 1024 : a.in[z + 9] + l * 1024;
    c.l = l; c.which = which; c.lm = which == 0 ? 0 : (which == 1 ? l : l + 1); c.shi = which == 1 ? 3 : 0; c.sci = which == 1 ? 4 : 1; c.gi = which == 1 ? 2 : 5;
    c.outp = (a.out + z); c.xin = a.in[z + 0]; c.cin = a.in[z + 2];
    for (int row0 = r_lo + gw; row0 < r_hi; row0 += 2 * NGW) {
        const int row1 = row0 + NGW; const bool has1 = row1 < r_hi;
        f32x4 v0[4], v1[4]; u32x2 y0[4], y1[4];
        const float* s0 = ln_src(c, row0); const float* s1 = ln_src(c, has1 ? row1 : row0);
#pragma unroll
        for (int j = 0; j < 4; ++j) { v0[j] = __builtin_nontemporal_load((const f32x4*)(s0 + 4 * lane + 256 * j)); v1[j] = __builtin_nontemporal_load((const f32x4*)(s1 + 4 * lane + 256 * j)); }
        if (which != 0) {
#pragma unroll
            for (int j = 0; j < 4; ++j) { y0[j] = __builtin_nontemporal_load((const u32x2*)(c.Y + (size_t)row0 * 1024 + 4 * lane + 256 * j)); y1[j] = __builtin_nontemporal_load((const u32x2*)(c.Y + (size_t)(has1 ? row1 : row0) * 1024 + 4 * lane + 256 * j)); } }
        else {
#pragma unroll
            for (int j = 0; j < 4; ++j) { y0[j] = (u32x2){0u, 0u}; y1[j] = (u32x2){0u, 0u}; } }
        ln_finish(c, lane, row0, v0, y0);
        if (has1) ln_finish(c, lane, row1, v1, y1);
    }
}

__device__ __forceinline__ void phase_gmlp(const KArgs& a, const int z, const int tid, int jl, LAS unsigned char* lds, const int vb, const int nvb) {
    const int lane = tid & 63, wave = tid >> 6;
    bf16_t* Z = (bf16_t*)((a.ws + z) + OFF_Z);
    LAS bf16_t* VNT = (LAS bf16_t*)lds;
    const float* Wsp = a.in[z + 19] + (size_t)jl * 4 * 128 * 128; const float* Bsp = a.in[z + 20] + (size_t)jl * 4 * 128;
    for (int item = vb; item < 528 * 4; item += nvb) {
        const int ci = item >> 2, g = item & 3;
        const int row0 = ci < 512 ? ci * 128 : ML + (ci - 512) * 128;
        u32x4 wv[16];
#pragma unroll
        for (int rr = 0; rr < 16; ++rr) wv[rr] = *(const u32x4*)(Z + (size_t)(row0 + wave * 16 + rr) * 3072 + 1536 + 8 * lane);
        float s1[16], s2[16];
#pragma unroll
        for (int rr = 0; rr < 16; ++rr) { float x[8]; unpack8(wv[rr], x); float t1 = 0.f, t2 = 0.f;
#pragma unroll
            for (int e = 0; e < 8; ++e) { t1 += x[e]; t2 += x[e] * x[e]; }
            s1[rr] = t1; s2[rr] = t2; }
#pragma unroll
        for (int o = 1; o < 64; o <<= 1) {
#pragma unroll
            for (int rr = 0; rr < 16; ++rr) { s1[rr] += __shfl_xor(s1[rr], o); s2[rr] += __shfl_xor(s2[rr], o); } }
        if ((lane >> 4) == g) {
#pragma unroll
            for (int rr = 0; rr < 16; ++rr) { const int q = wave * 16 + rr; float x[8]; unpack8(wv[rr], x);
                const float mean = s1[rr] * (1.0f / 512.0f), var = fmaxf(s2[rr] * (1.0f / 512.0f) - mean * mean, 0.f), rstd = rsqrtf(var + 1e-6f);
#pragma unroll
                for (int e = 0; e < 8; e += 2) { const unsigned pk = cvt_pk_bf16((x[e] - mean) * rstd, (x[e + 1] - mean) * rstd);
                    VNT[(8 * (lane & 15) + e) * 136 + q] = (bf16_t)(pk & 0xffffu); VNT[(8 * (lane & 15) + e + 1) * 136 + q] = (bf16_t)(pk >> 16); } } }
        bf16x8 bfr[4];
        { const float* wp = Wsp + (size_t)(g * 128 + wave * 16 + (lane & 15)) * 128 + 8 * (lane >> 4);
#pragma unroll
          for (int ks = 0; ks < 4; ++ks) { const f32x4 w0 = *(const f32x4*)(wp + 32 * ks), w1 = *(const f32x4*)(wp + 32 * ks + 4);
              u32x4 p; p.x = cvt_pk_bf16(w0[0], w0[1]); p.y = cvt_pk_bf16(w0[2], w0[3]); p.z = cvt_pk_bf16(w1[0], w1[1]); p.w = cvt_pk_bf16(w1[2], w1[3]); bfr[ks] = __builtin_bit_cast(bf16x8, p); } }
        __syncthreads();
        const int p = wave * 16 + (lane & 15); const float bias = Bsp[g * 128 + p];
        bf16_t* urow = Z + (size_t)(row0 + p) * 3072 + 1024 + g * 128;
#pragma unroll
        for (int dt = 0; dt < 8; ++dt) {
            f32x4 acc = (f32x4){0.f, 0.f, 0.f, 0.f};
#pragma unroll
            for (int ks = 0; ks < 4; ++ks) { const bf16x8 af = *(const LAS bf16x8*)(VNT + (16 * dt + (lane & 15)) * 136 + 32 * ks + 8 * (lane >> 4));
                acc = __builtin_amdgcn_mfma_f32_16x16x32_bf16(af, bfr[ks], acc, 0, 0, 0); }
            bf16_t* up = urow + 16 * dt + 4 * (lane >> 4); const u32x2 uw = *(const u32x2*)up;
            u32x2 o; o.x = cvt_pk_bf16(bf_lo(uw.x) * (acc[0] + bias), bf_hi(uw.x) * (acc[1] + bias)); o.y = cvt_pk_bf16(bf_lo(uw.y) * (acc[2] + bias), bf_hi(uw.y) * (acc[3] + bias));
            *(u32x2*)up = o;
        }
        __syncthreads();
    }
}
__device__ __forceinline__ void phase_conv(const KArgs& a, const int z, const int tid, int jl, const int rg_lo, const int nrg, const int vb, const int nvb) {
    bf16_t* Z = (bf16_t*)((a.ws + z) + OFF_Z);
    bf16_t* XC = (bf16_t*)((unsigned char*)(a.out + z) + DO_XC);
    const float* cw = a.in[z + 14] + (size_t)jl * 4 * 1024; const float* cb = a.in[z + 15] + (size_t)jl * 1024;
    for (int idx = vb * NTHR + tid; idx < nrg * 128; idx += nvb * NTHR) {
        const int rg = rg_lo + (idx >> 7), c0 = (idx & 127) * 8, row0 = rg * 16;
        int t0, len; if (row0 < ML) { t0 = row0 & 8191; len = SEQ; } else { t0 = (row0 - ML) & 255; len = CTXL; }
        u32x4 xw[19];
#pragma unroll
        for (int i = 0; i < 19; ++i) { const int tt = t0 - 2 + i; xw[i] = (u32x4){0u, 0u, 0u, 0u};
            if (tt >= 0 && tt < len) xw[i] = *(const u32x4*)(Z + (size_t)(row0 - 2 + i) * 3072 + 2048 + c0); }
        float wk[4][8], bs[8];
#pragma unroll
        for (int k = 0; k < 4; ++k) { const f32x4 w0 = *(const f32x4*)(cw + k * 1024 + c0), w1 = *(const f32x4*)(cw + k * 1024 + c0 + 4);
            wk[k][0] = w0[0]; wk[k][1] = w0[1]; wk[k][2] = w0[2]; wk[k][3] = w0[3]; wk[k][4] = w1[0]; wk[k][5] = w1[1]; wk[k][6] = w1[2]; wk[k][7] = w1[3]; }
        { const f32x4 b0 = *(const f32x4*)(cb + c0), b1 = *(const f32x4*)(cb + c0 + 4); bs[0] = b0[0]; bs[1] = b0[1]; bs[2] = b0[2]; bs[3] = b0[3]; bs[4] = b1[0]; bs[5] = b1[1]; bs[6] = b1[2]; bs[7] = b1[3]; }
#pragma unroll
        for (int r = 0; r < 16; ++r) {
            float o[8];
#pragma unroll
            for (int e = 0; e < 8; ++e) o[e] = bs[e];
#pragma unroll
            for (int k = 0; k < 4; ++k) { const u32x4 w = xw[r + k];
                o[0] += bf_lo(w.x) * wk[k][0]; o[1] += bf_hi(w.x) * wk[k][1]; o[2] += bf_lo(w.y) * wk[k][2]; o[3] += bf_hi(w.y) * wk[k][3];
                o[4] += bf_lo(w.z) * wk[k][4]; o[5] += bf_hi(w.z) * wk[k][5]; o[6] += bf_lo(w.w) * wk[k][6]; o[7] += bf_hi(w.w) * wk[k][7]; }
            u32x4 ow; ow.x = cvt_pk_bf16(o[0], o[1]); ow.y = cvt_pk_bf16(o[2], o[3]); ow.z = cvt_pk_bf16(o[4], o[5]); ow.w = cvt_pk_bf16(o[6], o[7]);
            *(u32x4*)(XC + (size_t)(row0 + r) * 1024 + c0) = ow;
        }
    }
}

__device__ __forceinline__ int scan_row_p(int d, int b, int p) {
    if (p < 256) return ML + b * 256 + (d == 0 ? p : 255 - p);
    const int t = p - 256; return b * SEQ + (d == 0 ? t : 8191 - t);
}
template <int PASS, int DIR, int NB>
__device__ __forceinline__ void scan_body(const KArgs& a, const int z, const int tid) {
    const bf16_t* LA = (const bf16_t*)((a.ws + z) + OFF_R2); const bf16_t* BBp = (const bf16_t*)((a.ws + z) + OFF_R2 + SZ_ROWS_BF);
    bf16_t* Z = (bf16_t*)((a.ws + z) + OFF_Z);
    float* SUMM = (float*)((unsigned char*)(a.out + z) + DO_SUMM); const float* CAR = (const float*)((unsigned char*)(a.out + z) + DO_CARRY);
    const int sub = tid >> 7, ch = (tid & 127) * 8;
    for (int blk = blockIdx.x; blk < 512; blk += gridDim.x) {
        const int item = blk * 4 + sub, b = item >> 8, sc = item & 255, p0 = sc * 33;
        float h[8], P[8];
#pragma unroll
        for (int e = 0; e < 8; ++e) { h[e] = 0.f; P[e] = 0.f; }
        if (PASS == 2) { const f32x4 c0 = *(const f32x4*)(CAR + (size_t)item * 1024 + ch), c1 = *(const f32x4*)(CAR + (size_t)item * 1024 + ch + 4);
            h[0] = c0[0]; h[1] = c0[1]; h[2] = c0[2]; h[3] = c0[3]; h[4] = c1[0]; h[5] = c1[1]; h[6] = c1[2]; h[7] = c1[3]; }
        for (int i0 = 0; i0 < 33; i0 += NB) {
            u32x4 lw[NB], bw[NB], fw[NB], gw[NB]; int rows[NB];
#pragma unroll
            for (int i = 0; i < NB; ++i) { rows[i] = scan_row_p(DIR, b, p0 + i0 + i);
                if (PASS == 2) { lw[i] = __builtin_nontemporal_load((const u32x4*)(LA + (size_t)rows[i] * 1024 + ch)); bw[i] = __builtin_nontemporal_load((const u32x4*)(BBp + (size_t)rows[i] * 1024 + ch)); }
                else { lw[i] = *(const u32x4*)(LA + (size_t)rows[i] * 1024 + ch); bw[i] = *(const u32x4*)(BBp + (size_t)rows[i] * 1024 + ch); }
                if (PASS == 2 && DIR == 1) { fw[i] = *(const u32x4*)(Z + (size_t)rows[i] * 3072 + 2048 + ch); gw[i] = *(const u32x4*)(Z + (size_t)rows[i] * 3072 + ch); } }
#pragma unroll
            for (int i = 0; i < NB; ++i) { float l[8], bb[8]; unpack8(lw[i], l); unpack8(bw[i], bb);
#pragma unroll
                for (int e = 0; e < 8; ++e) { h[e] = __builtin_amdgcn_exp2f(l[e] * LOG2E) * h[e] + bb[e]; if (PASS == 1) P[e] += l[e]; }
                if (PASS == 2 && DIR == 0) { u32x4 o; o.x = cvt_pk_bf16(h[0], h[1]); o.y = cvt_pk_bf16(h[2], h[3]); o.z = cvt_pk_bf16(h[4], h[5]); o.w = cvt_pk_bf16(h[6], h[7]);
                    *(u32x4*)(Z + (size_t)rows[i] * 3072 + 2048 + ch) = o; }
                if (PASS == 2 && DIR == 1) { float f[8], g[8]; unpack8(fw[i], f); unpack8(gw[i], g);
                    u32x4 o; o.x = cvt_pk_bf16(g[0] * (f[0] + h[0]), g[1] * (f[1] + h[1])); o.y = cvt_pk_bf16(g[2] * (f[2] + h[2]), g[3] * (f[3] + h[3]));
                    o.z = cvt_pk_bf16(g[4] * (f[4] + h[4]), g[5] * (f[5] + h[5])); o.w = cvt_pk_bf16(g[6] * (f[6] + h[6]), g[7] * (f[7] + h[7]));
                    *(u32x4*)(Z + (size_t)rows[i] * 3072 + ch) = o; }
            }
        }
        if (PASS == 1) { float* sp = SUMM + ((size_t)item * 1024 + ch) * 2;
#pragma unroll
            for (int e = 0; e < 8; e += 2) *(f32x4*)(sp + 2 * e) = (f32x4){P[e], h[e], P[e + 1], h[e + 1]}; }
    }
}
__device__ __forceinline__ void phase_scan(const KArgs& a, const int z, const int tid, int d, int pass) {
    if (pass == 1) { if (d == 0) scan_body<1, 0, 11>(a, z, tid); else scan_body<1, 1, 11>(a, z, tid); }
    else { if (d == 0) scan_body<2, 0, 11>(a, z, tid); else scan_body<2, 1, 3>(a, z, tid); }
}
__device__ __forceinline__ void phase_carry(const KArgs& a, const int z, const int tid, LAS unsigned char* lds) {
    const float* SUMM = (const float*)((unsigned char*)(a.out + z) + DO_SUMM); float* CAR = (float*)((unsigned char*)(a.out + z) + DO_CARRY);
    LAS float* segP = (LAS float*)lds; LAS float* segS = (LAS float*)(lds + 2048);
    const int seg = tid >> 6, cl = tid & 63;
    for (int blk = blockIdx.x; blk < 128; blk += gridDim.x) {
        const int b = blk >> 4, ch = (blk & 15) * 64 + cl; const size_t o0 = (size_t)(b * 256 + seg * 32) * 1024 + ch;
        f32x2 s[32];
#pragma unroll
        for (int k = 0; k < 32; ++k) s[k] = *(const f32x2*)(SUMM + (o0 + (size_t)k * 1024) * 2);
        float ps = 0.f, sa = 0.f;
#pragma unroll
        for (int k = 0; k < 32; ++k) { sa = __builtin_amdgcn_exp2f(s[k].x * LOG2E) * sa + s[k].y; ps += s[k].x; }
        segP[seg * 64 + cl] = ps; segS[seg * 64 + cl] = sa;
        __syncthreads();
        float c = 0.f;
        for (int j = 0; j < seg; ++j) c = __builtin_amdgcn_exp2f(segP[j * 64 + cl] * LOG2E) * c + segS[j * 64 + cl];
#pragma unroll
        for (int k = 0; k < 32; ++k) { CAR[o0 + (size_t)k * 1024] = c; c = __builtin_amdgcn_exp2f(s[k].x * LOG2E) * c + s[k].y; }
        __syncthreads();
    }
}

__device__ __forceinline__ void phase_qkpost(const KArgs& a, const int z, const int tid, int jl, const int r_lo, const int nrows, const int vb, const int nvb) {
    const bf16_t* Zq = (const bf16_t*)((a.ws + z) + OFF_Z + ZO_QKV); bf16_t* KK = (bf16_t*)((a.ws + z) + OFF_Z + ZO_KK); bf16_t* VV = (bf16_t*)((unsigned char*)(a.out + z) + DO_VV);
    const float* kn = a.in[z + 24] + jl * 64;
    for (int idx = vb * NTHR + tid; idx < 8 * nrows; idx += nvb * NTHR) {
        const int s8 = idx / nrows, row = r_lo + (idx - s8 * nrows), slot = 16 + s8;
        const bool lat = row < ML; const int t = lat ? (row & 8191) : ((row - ML) & 255), b = lat ? (row >> 13) : ((row - ML) >> 8);
        const int kvrow = lat ? 256 + t : t, type = slot >= 20, hh = slot & 1;
        const bf16_t* src = Zq + (size_t)row * 1536 + slot * 64;
        const size_t dsto = ((size_t)((type * 8 + b) * 2 + hh) * KVR + kvrow) * 64;
        u32x4 w[8];
#pragma unroll
        for (int c = 0; c < 8; ++c) w[c] = *(const u32x4*)(src + 8 * c);
        if (slot & 2) {
#pragma unroll
            for (int c = 0; c < 8; ++c) *(u32x4*)(VV + dsto + 8 * c) = w[c];
            continue; }
        float v[64];
#pragma unroll
        for (int c = 0; c < 8; ++c) { v[8 * c] = bf_lo(w[c].x); v[8 * c + 1] = bf_hi(w[c].x); v[8 * c + 2] = bf_lo(w[c].y); v[8 * c + 3] = bf_hi(w[c].y); v[8 * c + 4] = bf_lo(w[c].z); v[8 * c + 5] = bf_hi(w[c].z); v[8 * c + 6] = bf_lo(w[c].w); v[8 * c + 7] = bf_hi(w[c].w); }
        if (type == 0) { float ss = 0.f;
#pragma unroll
            for (int dd = 0; dd < 64; ++dd) ss += v[dd] * v[dd];
            const float r = rsqrtf(ss * (1.0f / 64.0f) + 1e-6f);
#pragma unroll
            for (int dd = 0; dd < 64; ++dd) v[dd] = v[dd] * r * kn[dd]; }
        if (lat) { const float pr = (float)(t >> 6), pc = (float)(t & 63);
#pragma unroll
            for (int f = 0; f < 16; ++f) { const float invf = exp2f(-(float)f * 0.8304820237218406f) * 0.15915494309189535f;
                { const float rev = pr * invf, cs = __builtin_amdgcn_cosf(rev), sn = __builtin_amdgcn_sinf(rev); const float x1 = v[f], x2 = v[16 + f]; v[f] = x1 * cs - x2 * sn; v[16 + f] = x2 * cs + x1 * sn; }
                { const float rev = pc * invf, cs = __builtin_amdgcn_cosf(rev), sn = __builtin_amdgcn_sinf(rev); const float x1 = v[32 + f], x2 = v[48 + f]; v[32 + f] = x1 * cs - x2 * sn; v[48 + f] = x2 * cs + x1 * sn; } } }
#pragma unroll
        for (int c = 0; c < 8; ++c) { u32x4 o; o.x = cvt_pk_bf16(v[8 * c], v[8 * c + 1]); o.y = cvt_pk_bf16(v[8 * c + 2], v[8 * c + 3]); o.z = cvt_pk_bf16(v[8 * c + 4], v[8 * c + 5]); o.w = cvt_pk_bf16(v[8 * c + 6], v[8 * c + 7]);
            *(u32x4*)(KK + dsto + 8 * c) = o; }
    }
}

namespace attn_body {
using bf16=__hip_bfloat16;
using bf16x8=__attribute__((ext_vector_type(8)))short;
using s16x4=__attribute__((ext_vector_type(4)))short;
using f32x16=__attribute__((ext_vector_type(16)))float;
using u32x4=__attribute__((ext_vector_type(4)))unsigned;
constexpr int D=64;
constexpr int NW=8,QBLK=32,QB=QBLK*NW,KVBLK=64;
constexpr int ATTN_UNIT_ROWS=QB;
__device__ __forceinline__ int crow(int r,int hi){return (r&3)+8*(r>>2)+4*hi;}
#define SBAR() __builtin_amdgcn_sched_barrier(0)
constexpr int NSLOT=3, SLOTB=8192;
constexpr int LDS_K=0, LDS_V=NSLOT*SLOTB, LDS_WS=2*NSLOT*SLOTB, LDS_OST=LDS_WS+NW*64*4, LDS_BYTES=LDS_OST+NW*4096;
constexpr float C2=0.125f*1.4426950408889634f;
__device__ __forceinline__ void glds16(const void*gsrc,unsigned lds_dst){unsigned keep;
  asm volatile("s_mov_b32 %0, m0\n\ts_mov_b32 m0, %2\n\ts_nop 0\n\tglobal_load_lds_dwordx4 %1, off\n\ts_mov_b32 m0, %0":"=&s"(keep):"v"(gsrc),"s"(lds_dst):"memory");}
__device__ __forceinline__ float max3f(float a,float b,float c){float r;asm("v_max3_f32 %0, %1, %2, %3":"=v"(r):"v"(a),"v"(b),"v"(c));return r;}
__device__ __forceinline__ float max2f(float a,float b){float r;asm("v_max_f32_e32 %0, %1, %2":"=v"(r):"v"(a),"v"(b));return r;}
__device__ __forceinline__ float fadd_s(float a,float b){float r;asm("v_add_f32_e32 %0, %1, %2":"=v"(r):"v"(a),"v"(b));return r;}
__device__ __forceinline__ float fsub_s(float a,float b){float r;asm("v_sub_f32_e32 %0, %1, %2":"=v"(r):"v"(a),"v"(b));return r;}
typedef float f32x2_t __attribute__((ext_vector_type(2))); typedef __bf16 bf16x2_t __attribute__((ext_vector_type(2)));
__device__ __forceinline__ unsigned cvtpk_s(float lo,float hi){f32x2_t v={lo,hi};bf16x2_t b=__builtin_convertvector(v,bf16x2_t);return __builtin_bit_cast(unsigned,b);}
#define WAIT_BAR(N) asm volatile("s_waitcnt vmcnt(" #N ") lgkmcnt(0)\n\ts_barrier":::"memory")

__device__ __forceinline__ void qkt(f32x16&p0,f32x16&p1,const char*Kslot,const bf16x8*qr,const f32x16&negm,int r32,int hi){
  const char*kb=Kslot+hi*1024+r32*16;
  #pragma unroll
  for(int d0=0;d0<4;++d0){
    const bf16x8 b0=*reinterpret_cast<const bf16x8*>(kb+d0*2048);
    const bf16x8 b1=*reinterpret_cast<const bf16x8*>(kb+d0*2048+512);
    if(d0==0){p0=__builtin_amdgcn_mfma_f32_32x32x16_bf16(b0,qr[0],negm,0,0,0);p1=__builtin_amdgcn_mfma_f32_32x32x16_bf16(b1,qr[0],negm,0,0,0);}
    else{p0=__builtin_amdgcn_mfma_f32_32x32x16_bf16(b0,qr[d0],p0,0,0,0);p1=__builtin_amdgcn_mfma_f32_32x32x16_bf16(b1,qr[d0],p1,0,0,0);}}
}
typedef __attribute__((address_space(3))) const char* lds_cptr;
typedef short v4i16_t __attribute__((ext_vector_type(4)));
__device__ __forceinline__ void kload8(bf16x8*kf,lds_cptr kp){
  kf[0]=*(const __attribute__((address_space(3))) bf16x8*)(kp);      kf[1]=*(const __attribute__((address_space(3))) bf16x8*)(kp+512);
  kf[2]=*(const __attribute__((address_space(3))) bf16x8*)(kp+2048); kf[3]=*(const __attribute__((address_space(3))) bf16x8*)(kp+2560);
  kf[4]=*(const __attribute__((address_space(3))) bf16x8*)(kp+4096); kf[5]=*(const __attribute__((address_space(3))) bf16x8*)(kp+4608);
  kf[6]=*(const __attribute__((address_space(3))) bf16x8*)(kp+6144); kf[7]=*(const __attribute__((address_space(3))) bf16x8*)(kp+6656);
}
__device__ __forceinline__ void kload2(bf16x8*kf,lds_cptr kp,int j){ kf[2*j]=*(const __attribute__((address_space(3))) bf16x8*)(kp+j*2048); kf[2*j+1]=*(const __attribute__((address_space(3))) bf16x8*)(kp+j*2048+512); }
__device__ __forceinline__ s16x4 vtr(lds_cptr p){ return __builtin_bit_cast(s16x4,__builtin_amdgcn_ds_read_tr16_b64_v4i16((__attribute__((address_space(3))) v4i16_t*)p)); }
__device__ __forceinline__ float rowmax(const f32x16&p0,const f32x16&p1){
  float a=max3f(p0[0],p0[1],p1[0]),b=max3f(p0[2],p0[3],p1[1]);a=max3f(a,p1[2],p1[3]);
  #pragma unroll
  for(int r=4;r<16;r+=4){a=max3f(a,p0[r],p0[r+1]);b=max3f(b,p0[r+2],p0[r+3]);a=max3f(a,p1[r],p1[r+1]);b=max3f(b,p1[r+2],p1[r+3]);}
  const float m=max2f(a,b);
  auto rr=__builtin_amdgcn_permlane32_swap(__float_as_uint(m),__float_as_uint(m),false,false);
  return max2f(__uint_as_float(rr[0]),__uint_as_float(rr[1]));
}
__device__ __forceinline__ void pv(f32x16*o,int vb,bf16x8 pa0,bf16x8 pa1,bf16x8 pa2,bf16x8 pa3){
  #pragma unroll
  for(int d0=0;d0<2;++d0){s16x4 lo[4],hi[4];
    #pragma unroll
    for(int ks=0;ks<4;++ks){
      asm volatile("ds_read_b64_tr_b16 %0,%1 offset:%c2":"=&v"(lo[ks]):"v"(vb),"i"(d0*4096+ks*1024):"memory");
      asm volatile("ds_read_b64_tr_b16 %0,%1 offset:%c2":"=&v"(hi[ks]):"v"(vb),"i"(d0*4096+ks*1024+512):"memory");}
    asm volatile("s_waitcnt lgkmcnt(0)":::"memory");SBAR();
    #define PK(k) (bf16x8){lo[k][0],lo[k][1],lo[k][2],lo[k][3],hi[k][0],hi[k][1],hi[k][2],hi[k][3]}
    o[d0]=__builtin_amdgcn_mfma_f32_32x32x16_bf16(pa0,PK(0),o[d0],0,0,0);
    o[d0]=__builtin_amdgcn_mfma_f32_32x32x16_bf16(pa1,PK(1),o[d0],0,0,0);
    o[d0]=__builtin_amdgcn_mfma_f32_32x32x16_bf16(pa2,PK(2),o[d0],0,0,0);
    o[d0]=__builtin_amdgcn_mfma_f32_32x32x16_bf16(pa3,PK(3),o[d0],0,0,0);
    #undef PK
  }
}

#ifndef ATTN_STORE16
#define ATTN_STORE16(p,v) (*(u32x4*)(p)=(v))
#endif
__device__ __forceinline__ void wmask(f32x16&p0,f32x16&p1,int t,int wid,int r32,int hi,int q0){
  const float NEG=-INFINITY; const int ks=q0-128+64*(t-4);
  if(ks<0||ks>=8192){
    #pragma unroll
    for(int r=0;r<16;++r){p0[r]=NEG;p1[r]=NEG;}
    return; }
  const int lo=64*(t-4)-128-(wid*32+31), hi_=64*(t-4)-128+63-wid*32;
  if(lo>=-128&&hi_<=128)return;
  const int base=64*(t-4)-128+4*hi-(wid*32+r32);
  #pragma unroll
  for(int r=0;r<16;++r){const int d0=base+(r&3)+8*(r>>2), d1=d0+32; if(d0>128||d0<-128)p0[r]=NEG; if(d1>128||d1<-128)p1[r]=NEG;}
}
template<int THRL,bool WIN> __device__ __forceinline__ void attn_unit(const bf16*Qb,int PQ,const bf16*__restrict__ Kh,int PK,const bf16*__restrict__ Vh,int PV,bf16*Ob,int PO,const int NT,char*shm,const int tid,const int q0,const float sink2,const float*qg,const int tpos0){
  const int lane=tid&63,r32=lane&31,hi=lane>>5; const int wid=__builtin_amdgcn_readfirstlane(tid>>6);
  const bf16*Qw=Qb+(long)(wid*QBLK)*PQ;
  const unsigned lds0=(unsigned)(uintptr_t)shm;
  float*wsf=(float*)(shm+LDS_WS)+wid*64;
  const bf16*ksrc=Kh+(long)lane*PK+wid*8;
  const bf16*vsrc=Vh+(long)(16*(wid&3)+(lane>>2))*PV+(wid>>2)*32+(lane&3)*8;
  const unsigned kdst=lds0+LDS_K+wid*1024, vdst=lds0+LDS_V+wid*1024;
  #define KOFF(t) ((WIN&&(t)>=4)?min(max(64*(t)+q0-128,0),8448-64):64*(t))
  #define DMA_K(t,slot) glds16(ksrc+(long)KOFF(t)*PK,(unsigned)__builtin_amdgcn_readfirstlane(kdst+(slot)))
  #define DMA_V(t,slot) glds16(vsrc+(long)KOFF(t)*PV,(unsigned)__builtin_amdgcn_readfirstlane(vdst+(slot)))
  const int vb0=(int)(lds0+LDS_V)+((lane>>4)&1)*32+(lane&3)*8+(4*hi+((lane&15)>>2))*64;
  const char*Kbase=shm+LDS_K; bf16x8 kf[8];
  const lds_cptr shm3=(lds_cptr)shm; const lds_cptr kp0=shm3+LDS_K+hi*1024+r32*16; const lds_cptr vp0=shm3+LDS_V+((lane>>4)&1)*32+(lane&3)*8+(4*hi+((lane&15)>>2))*64;
  DMA_K(0,0);DMA_V(0,0);DMA_K(1,SLOTB);
  bf16x8 qr[4];
  #pragma unroll
  for(int d0=0;d0<4;++d0)qr[d0]=*reinterpret_cast<const bf16x8*>(&Qw[(long)r32*PQ+d0*16+hi*8]);
  {
    float x[32];
    #pragma unroll
    for(int d0=0;d0<4;++d0){
      #pragma unroll
      for(int e=0;e<8;++e)x[8*d0+e]=__uint_as_float(((unsigned)(unsigned short)qr[d0][e])<<16);}
    if(qg){float ss=0.f;
      #pragma unroll
      for(int i=0;i<32;++i)ss+=x[i]*x[i];
      ss+=__shfl_xor(ss,32);
      const float rn=rsqrtf(ss*(1.0f/64.0f)+1e-6f);
      #pragma unroll
      for(int d0=0;d0<4;++d0){
        #pragma unroll
        for(int e=0;e<8;++e)x[8*d0+e]*=rn*qg[16*d0+8*hi+e];}}
    if(tpos0>=0){const int tq=tpos0+wid*QBLK+r32; const float pr=(float)(tq>>6),pc=(float)(tq&63);
      #pragma unroll
      for(int e=0;e<8;++e){const float invf=__builtin_amdgcn_exp2f(-(float)(8*hi+e)*0.8304820237218406f)*0.15915494309189535f;
        {const float rev=pr*invf,cs=__builtin_amdgcn_cosf(rev),sn=__builtin_amdgcn_sinf(rev);const float x1=x[e],x2=x[8+e];x[e]=x1*cs-x2*sn;x[8+e]=x2*cs+x1*sn;}
        {const float rev=pc*invf,cs=__builtin_amdgcn_cosf(rev),sn=__builtin_amdgcn_sinf(rev);const float x1=x[16+e],x2=x[24+e];x[16+e]=x1*cs-x2*sn;x[24+e]=x2*cs+x1*sn;}}}
    #pragma unroll
    for(int d0=0;d0<4;++d0){u32x4 w;w.x=cvtpk_s(x[8*d0]*C2,x[8*d0+1]*C2);w.y=cvtpk_s(x[8*d0+2]*C2,x[8*d0+3]*C2);w.z=cvtpk_s(x[8*d0+4]*C2,x[8*d0+5]*C2);w.w=cvtpk_s(x[8*d0+6]*C2,x[8*d0+7]*C2);qr[d0]=__builtin_bit_cast(bf16x8,w);}
  }
  float mhat=0.f,l_reg=0.f;f32x16 o[2];o[0]=f32x16{};o[1]=f32x16{};f32x16 negm=f32x16{}; if constexpr(!WIN){asm volatile("":"+v"(negm));}
  #define CMASK(P0,P1,t) do{ if(WIN&&(t)>=4) wmask(P0,P1,(t),wid,r32,hi,q0); }while(0)
  bool resc=false;
  #define START(P0,P1) do{ const float rm=rowmax(P0,P1); resc=false; \
    { const float dl=rm; mhat=fadd_s(mhat,dl); \
      _Pragma("unroll") for(int r=0;r<16;++r){P0[r]=fsub_s(P0[r],dl);P1[r]=fsub_s(P1[r],dl);} \
      if constexpr(!WIN){ _Pragma("unroll") for(int r=0;r<16;++r)negm[r]=-mhat; asm volatile("":"+v"(negm)); } } \
    _Pragma("unroll") for(int r=0;r<16;++r)P0[r]=__builtin_amdgcn_exp2f(P0[r]); }while(0)
  #define RESC() do{ if(resc){ asm volatile("s_waitcnt lgkmcnt(0)":::"memory"); \
      _Pragma("unroll") for(int d_=0;d_<2;++d_) _Pragma("unroll") for(int r=0;r<16;++r)o[d_][r]*=wsf[crow(r,hi)]; } }while(0)
  f32x16 pA0,pA1,pB0,pB1;
  int sl_prev=0,sl_cur=0,sl_next=SLOTB;
  #define ROT() do{sl_prev=sl_cur;sl_cur=sl_next;sl_next=(sl_next==(NSLOT-1)*SLOTB)?0:sl_next+SLOTB;}while(0)
  DMA_K(2,2*SLOTB);
  WAIT_BAR(3);
  qkt(pA0,pA1,Kbase,qr,(WIN?f32x16{}:negm),r32,hi);asm volatile("s_nop 15\n\ts_nop 7":"+v"(pA0),"+v"(pA1));CMASK(pA0,pA1,0);
  START(pA0,pA1);
  _Pragma("unroll") for(int r=0;r<16;++r)pA1[r]=__builtin_amdgcn_exp2f(pA1[r]);
  WAIT_BAR(0);
  DMA_K(3,0);DMA_V(1,SLOTB);
  ROT();
  kload8(kf,kp0+sl_cur);
  WAIT_BAR(2);
  s16x4 vlo[8],vhi[8]; u32x4 pw0,pw1,pw2,pw3;
  #define PKW(P,B) cvtpk_s(P[B],P[B+1])
  #define PAF(k) __builtin_bit_cast(bf16x8,pw##k)
  #define VFR(i) (bf16x8){vlo[i][0],vlo[i][1],vlo[i][2],vlo[i][3],vhi[i][0],vhi[i][1],vhi[i][2],vhi[i][3]}
  #define PIN(x) asm volatile("":"+v"(x))
  #define MX3(a,b,c) __builtin_fmaxf(__builtin_fmaxf((a),(b)),(c))
  #define GAPA(MF,A0,A1,A2,A3,W0,W1,PW) do{ MF; sacc+=A0; sacc+=A1; sacc+=A2; sacc+=A3; PIN(sacc); W0; W1; PIN(PW); SBAR(); }while(0)
  #define EX(v) __builtin_amdgcn_exp2f(v)
  #define GAPB(MF,X,B) do{ MF; X[B]=EX(X[B]); X[B+1]=EX(X[B+1]); X[B+2]=EX(X[B+2]); X[B+3]=EX(X[B+3]); PIN(X); SBAR(); }while(0)
  #define VRD(i) do{ vlo[i]=vtr(vp_+(((i)>>2)*4096+((i)&3)*1024)); vhi[i]=vtr(vp_+(((i)>>2)*4096+((i)&3)*1024+512)); }while(0)
  #define KRD(G,j) do{ if(G){ kload2(kf,kp0+sl_next,j); SBAR(); } }while(0)
  #define STEP(C0,C1,P0,P1,t,GK,GV,GL) do{ SBAR(); \
    const lds_cptr vp_=vp0+sl_prev; \
    VRD(0); SBAR(); float sacc=(P0[0]+P0[1]); \
    GAPA(C0=__builtin_amdgcn_mfma_f32_32x32x16_bf16(kf[0],qr[0],(WIN?f32x16{}:negm),0,0,0), P0[2],P0[3],P0[4],P0[5],     pw0[0]=PKW(P0,0), pw0[1]=PKW(P0,2), pw0); \
    VRD(4); SBAR(); GAPA(C1=__builtin_amdgcn_mfma_f32_32x32x16_bf16(kf[1],qr[0],(WIN?f32x16{}:negm),0,0,0), P0[6],P0[7],P0[8],P0[9],     pw0[2]=PKW(P0,4), pw0[3]=PKW(P0,6), pw0); \
    VRD(1); SBAR(); GAPA(C0=__builtin_amdgcn_mfma_f32_32x32x16_bf16(kf[2],qr[1],C0,0,0,0),   P0[10],P0[11],P0[12],P0[13], pw1[0]=PKW(P0,8), pw1[1]=PKW(P0,10), pw1); \
    VRD(5); SBAR(); GAPA(C1=__builtin_amdgcn_mfma_f32_32x32x16_bf16(kf[3],qr[1],C1,0,0,0),   P0[14],P0[15],P1[0],P1[1],   pw1[2]=PKW(P0,12),pw1[3]=PKW(P0,14), pw1); \
    VRD(2); SBAR(); GAPA(C0=__builtin_amdgcn_mfma_f32_32x32x16_bf16(kf[4],qr[2],C0,0,0,0),   P1[2],P1[3],P1[4],P1[5],     pw2[0]=PKW(P1,0), pw2[1]=PKW(P1,2), pw2); \
    VRD(6); SBAR(); GAPA(C1=__builtin_amdgcn_mfma_f32_32x32x16_bf16(kf[5],qr[2],C1,0,0,0),   P1[6],P1[7],P1[8],P1[9],     pw2[2]=PKW(P1,4), pw2[3]=PKW(P1,6), pw2); \
    VRD(3); SBAR(); GAPA(C0=__builtin_amdgcn_mfma_f32_32x32x16_bf16(kf[6],qr[3],C0,0,0,0),   P1[10],P1[11],P1[12],P1[13], pw3[0]=PKW(P1,8), pw3[1]=PKW(P1,10), pw3); \
    VRD(7); SBAR(); GAPA(C1=__builtin_amdgcn_mfma_f32_32x32x16_bf16(kf[7],qr[3],C1,0,0,0),   P1[14],P1[15],0.f,0.f,       pw3[2]=PKW(P1,12),pw3[3]=PKW(P1,14), pw3); \
    l_reg+=sacc; \
    if(GK){DMA_K((t)+3,sl_cur);} if(GV){DMA_V((t)+1,sl_next);} \
    if constexpr(WIN){ _Pragma("unroll") for(int r=0;r<16;++r){C0[r]-=mhat;C1[r]-=mhat;} } \
    CMASK(C0,C1,t); \
    { float a=MX3(C0[0],C0[1],C1[0]),b=MX3(C0[2],C0[3],C1[1]); a=MX3(a,C1[2],C1[3]); \
      _Pragma("unroll") for(int r=4;r<16;r+=4){a=MX3(a,C0[r],C0[r+1]);b=MX3(b,C0[r+2],C0[r+3]);a=MX3(a,C1[r],C1[r+1]);b=MX3(b,C1[r+2],C1[r+3]);} \
      float rm=__builtin_fmaxf(a,b); { auto rr=__builtin_amdgcn_permlane32_swap(__float_as_uint(rm),__float_as_uint(rm),false,false); rm=__builtin_fmaxf(__uint_as_float(rr[0]),__uint_as_float(rr[1])); } \
      resc=false; \
      if(__builtin_expect(__any(rm>(float)THRL),0)){ const float dl=__builtin_fmaxf(rm,0.f); mhat+=dl; \
        _Pragma("unroll") for(int r=0;r<16;++r){C0[r]-=dl;C1[r]-=dl;} \
        if constexpr(!WIN){ _Pragma("unroll") for(int r=0;r<16;++r)negm[r]=-mhat; asm volatile("":"+v"(negm)); } \
        const float f=__builtin_amdgcn_exp2f(-dl); l_reg*=f; if(hi==0)wsf[r32]=f; resc=true; } } \
    SBAR(); \
    GAPB(o[0]=__builtin_amdgcn_mfma_f32_32x32x16_bf16(PAF(0),VFR(0),o[0],0,0,0), C0,0); \
    GAPB(o[1]=__builtin_amdgcn_mfma_f32_32x32x16_bf16(PAF(0),VFR(4),o[1],0,0,0), C0,4); \
    KRD(GL,0); GAPB(o[0]=__builtin_amdgcn_mfma_f32_32x32x16_bf16(PAF(1),VFR(1),o[0],0,0,0), C0,8); \
    KRD(GL,1); GAPB(o[1]=__builtin_amdgcn_mfma_f32_32x32x16_bf16(PAF(1),VFR(5),o[1],0,0,0), C0,12); \
    KRD(GL,2); GAPB(o[0]=__builtin_amdgcn_mfma_f32_32x32x16_bf16(PAF(2),VFR(2),o[0],0,0,0), C1,0); \
    KRD(GL,3); GAPB(o[1]=__builtin_amdgcn_mfma_f32_32x32x16_bf16(PAF(2),VFR(6),o[1],0,0,0), C1,4); \
    GAPB(o[0]=__builtin_amdgcn_mfma_f32_32x32x16_bf16(PAF(3),VFR(3),o[0],0,0,0), C1,8); \
    GAPB(o[1]=__builtin_amdgcn_mfma_f32_32x32x16_bf16(PAF(3),VFR(7),o[1],0,0,0), C1,12); \
    }while(0)
  int t=1;
  #undef CMASK
  #define CMASK(P0,P1,t) do{ if(WIN&&(t)>=4) wmask(P0,P1,(t),wid,r32,hi,q0); }while(0)
  for(;t+5<NT;t+=2){
    STEP(pB0,pB1,pA0,pA1,t,true,true,true);     WAIT_BAR(2); RESC(); ROT();
    STEP(pA0,pA1,pB0,pB1,t+1,true,true,true);   WAIT_BAR(2); RESC(); ROT();
  }
  #undef CMASK
  #define CMASK(P0,P1,t) do{ if(WIN&&(t)>=4) wmask(P0,P1,(t),wid,r32,hi,q0); }while(0)
  #define ENDW(tt) do{ if((tt)+3<NT){WAIT_BAR(2);} else if((tt)+2<NT){WAIT_BAR(1);} else {WAIT_BAR(0);} }while(0)
  for(;t+1<NT;t+=2){
    STEP(pB0,pB1,pA0,pA1,t,(t+3<NT),(t+1<NT),(t+1<NT));       ENDW(t);   RESC(); ROT();
    STEP(pA0,pA1,pB0,pB1,t+1,(t+4<NT),(t+2<NT),(t+2<NT));     ENDW(t+1); RESC(); ROT();
  }
  STEP(pB0,pB1,pA0,pA1,NT-1,false,false,false); RESC();
  { float sacc=pB0[0]+pB0[1]; _Pragma("unroll") for(int r=2;r<16;++r)sacc+=pB0[r]; _Pragma("unroll") for(int r=0;r<16;++r)sacc+=pB1[r]; l_reg+=sacc;
    pw0=(u32x4){PKW(pB0,0),PKW(pB0,2),PKW(pB0,4),PKW(pB0,6)};pw1=(u32x4){PKW(pB0,8),PKW(pB0,10),PKW(pB0,12),PKW(pB0,14)};pw2=(u32x4){PKW(pB1,0),PKW(pB1,2),PKW(pB1,4),PKW(pB1,6)};pw3=(u32x4){PKW(pB1,8),PKW(pB1,10),PKW(pB1,12),PKW(pB1,14)};
    SBAR(); pv(o,vb0+sl_cur,PAF(0),PAF(1),PAF(2),PAF(3)); }
  #undef PKW
  #undef PAF
  #undef VFR
  #undef PIN
  #undef MX3
  #undef GAPA
  #undef GAPB
  #undef EX
  #undef VRD
  #undef KRD
  #undef STEP
  #undef ENDW
  {auto rr=__builtin_amdgcn_permlane32_swap(__float_as_uint(l_reg),__float_as_uint(l_reg),false,false);l_reg=__uint_as_float(rr[0])+__uint_as_float(rr[1]);}
  if(WIN)l_reg+=__builtin_amdgcn_exp2f(__uint_as_float(__builtin_amdgcn_readfirstlane(__float_as_uint(sink2)))-mhat);
  if(hi==0)wsf[32+r32]=l_reg;asm volatile("s_waitcnt lgkmcnt(0)":::"memory");
  float rli[16];
  #pragma unroll
  for(int r=0;r<16;++r)rli[r]=__builtin_amdgcn_rcpf(wsf[32+crow(r,hi)]);
  bf16*Ow=Ob+(long)(wid*QBLK)*PO;
  { bf16*stg=(bf16*)(shm+LDS_OST)+wid*2048;
    #pragma unroll
    for(int r=0;r<16;++r){const int orow=crow(r,hi);
      #pragma unroll
      for(int d0=0;d0<2;++d0)stg[orow*64+d0*32+r32]=__float2bfloat16(o[d0][r]*rli[r]);}
    asm volatile("s_waitcnt lgkmcnt(0)":::"memory");
    #pragma unroll
    for(int i=0;i<4;++i){const int row=i*8+(lane>>3),ch=lane&7; const u32x4 v=*(const u32x4*)(stg+row*64+ch*8); ATTN_STORE16(Ow+(long)row*PO+ch*8,v);} }
  asm volatile("s_waitcnt lgkmcnt(0)\n\ts_barrier":::"memory");
  #undef DMA_K
  #undef KOFF
  #undef DMA_V
  #undef CMASK
  #undef START
  #undef RESC
  #undef ROT
}
constexpr int ATTN_LDS_BYTES=LDS_BYTES;
#undef SBAR
#undef WAIT_BAR
}
__device__ __forceinline__ unsigned long long phase_attn(const KArgs& a, const int z, const int tid, int jl, bool with_ctx, char* lds_gen) {
    const int lane = tid & 63, wave = tid >> 6, l15 = lane & 15, lg = lane >> 4;
    const bf16_t* Zq = (const bf16_t*)((a.ws + z) + OFF_Z + ZO_QKV); const bf16_t* KK = (const bf16_t*)((a.ws + z) + OFF_Z + ZO_KK); const bf16_t* VT = (const bf16_t*)((a.ws + z) + OFF_Z + ZO_VT);
    bf16_t* O = (bf16_t*)((a.ws + z) + OFF_Z + ZO_O);
    const float* sinkp = a.in[z + 25] + jl * 8; const float* qn = a.in[z + 23] + jl * 64;
    const int gw = blockIdx.x * NWAVE + wave, NGW = gridDim.x * NWAVE;
    const int nitems = with_ctx ? 16384 + 512 : 16384;
    {
        const bf16_t* VV = (const bf16_t*)((unsigned char*)(a.out + z) + DO_VV);
        const int G = gridDim.x, bx = blockIdx.x, vcu = (G % 8 == 0) ? (bx % 8) * (G / 8) + bx / 8 : bx, per = (2048 + G - 1) / G;
        for (int i = 0; i < per; ++i) { const int u = vcu * per + i; if (u >= 2048) break;
            const int b = (u >> 8) & 7, qb = (u >> 3) & 31, h = u & 7, g = h >> 2;
            attn_body::attn_unit<8, false>((const attn_body::bf16*)(Zq + (size_t)(b * SEQ + qb * 256) * 1536 + h * 64), 1536,
                                    (const attn_body::bf16*)(KK + (size_t)(b * 2 + g) * KVR * 64), 64, (const attn_body::bf16*)(VV + (size_t)(b * 2 + g) * KVR * 64), 64,
                                    (attn_body::bf16*)(O + (size_t)(b * SEQ + qb * 256) * 1024 + h * 64), 1024, KVR / 64, lds_gen, tid, 0, 0.f, qn, qb * 256); }
        for (int i = 0; i < per; ++i) { const int u = vcu * per + i; if (u >= 2048) break;
            const int b = (u >> 8) & 7, qb = (u >> 3) & 31, h = u & 7, g = h >> 2;
            attn_body::attn_unit<8, true>((const attn_body::bf16*)(Zq + (size_t)(b * SEQ + qb * 256) * 1536 + 512 + h * 64), 1536,
                                    (const attn_body::bf16*)(KK + (size_t)((8 + b) * 2 + g) * KVR * 64), 64, (const attn_body::bf16*)(VV + (size_t)((8 + b) * 2 + g) * KVR * 64), 64,
                                    (attn_body::bf16*)(O + (size_t)(b * SEQ + qb * 256) * 1024 + 512 + h * 64), 1024, 12, lds_gen, tid, qb * 256, sinkp[h] * LOG2E, nullptr, qb * 256); }
        if (with_ctx) {
            for (int u = vcu; u < 128; u += G) { const int type = u >> 6, b = (u >> 3) & 7, h = u & 7, g = h >> 2;
                attn_body::attn_unit<8, true>((const attn_body::bf16*)(Zq + (size_t)(ML + b * CTXL) * 1536 + type * 512 + h * 64), 1536,
                                    (const attn_body::bf16*)(KK + (size_t)((type * 8 + b) * 2 + g) * KVR * 64), 64, (const attn_body::bf16*)(VV + (size_t)((type * 8 + b) * 2 + g) * KVR * 64), 64,
                                    (attn_body::bf16*)(O + (size_t)(ML + b * CTXL) * 1024 + type * 512 + h * 64), 1024, 4, lds_gen, tid, 0, type ? sinkp[h] * LOG2E : -1e30f, type ? nullptr : qn, -1); }
        }
    }
    return 0ull;
#if 0
    const unsigned long long t_simple0 = __builtin_amdgcn_s_memrealtime();
    for (int item = 8192 + gw; item < nitems; item += NGW) {
        int mode, bg, qtile;
        if (item < 8192) { mode = 0; bg = item >> 9; qtile = item & 511; }
        else if (item < 16384) { mode = 1; bg = (item - 8192) >> 9; qtile = item & 511; }
        else if (item < 16384 + 256) { mode = 2; bg = (item - 16384) >> 4; qtile = item & 15; }
        else { mode = 3; bg = (item - 16640) >> 4; qtile = item & 15; }
        const int b = bg >> 1, g = bg & 1, type = mode & 1;
        const int rowbase = (mode < 2) ? b * SEQ + 16 * qtile : ML + b * CTXL + 16 * qtile;
        const int qcol = type * 512 + g * 256;
        const bf16_t* Kb = KK + (size_t)((type * 8 + b) * 2 + g) * KVR * 64;
        const bf16_t* Vb = VT + (size_t)((type * 8 + b) * 2 + g) * 64 * KVR;
        const int nA = (mode == 0) ? 264 : 8;
        int lo = 0, nB = 0; const int q0 = 16 * qtile;
        if (mode == 1) { lo = q0 >= 128 ? ((q0 - 128) >> 5) : 0; int hi = ((q0 + 143) >> 5) + 1; if (hi > 256) hi = 256; nB = hi - lo; }
        const int ntot = nA + nB;
        bf16x8 qf[4][2];
        { const bf16_t* qp = Zq + (size_t)(rowbase + l15) * 1536 + qcol + 8 * lg;
#pragma unroll
          for (int qt = 0; qt < 4; ++qt)
#pragma unroll
              for (int ks = 0; ks < 2; ++ks) qf[qt][ks] = *(const bf16x8*)(qp + 64 * qt + 32 * ks); }
        f32x4 oacc[4][4]; float mrun[4], lsum[4];
#pragma unroll
        for (int qt = 0; qt < 4; ++qt) { mrun[qt] = -1e30f; lsum[qt] = 0.f;
#pragma unroll
            for (int dt = 0; dt < 4; ++dt) oacc[qt][dt] = (f32x4){0.f, 0.f, 0.f, 0.f}; }
        bf16x8 kf[2][2]; u32x2 vlo[4], vhi[4];
        const bf16_t* kp = Kb + (size_t)l15 * 64 + 8 * lg; const bf16_t* vp = Vb + (size_t)l15 * KVR + 4 * lg;
#define LOAD_KV(KF, VLO, VHI, kvrow0) do { \
        _Pragma("unroll") for (int kt = 0; kt < 2; ++kt) _Pragma("unroll") for (int ks = 0; ks < 2; ++ks) KF[kt][ks] = *(const bf16x8*)(kp + (size_t)((kvrow0) + 16 * kt) * 64 + 32 * ks); \
        _Pragma("unroll") for (int dt = 0; dt < 4; ++dt) { VLO[dt] = *(const u32x2*)(vp + (size_t)(16 * dt) * KVR + (kvrow0)); VHI[dt] = *(const u32x2*)(vp + (size_t)(16 * dt) * KVR + (kvrow0) + 16); } } while (0)
        LOAD_KV(kf, vlo, vhi, 0);
        for (int blk = 0; blk < ntot; ++blk) {
            const int nb_ = (blk + 1 < ntot) ? blk + 1 : blk;
            const int kvnext = nb_ < nA ? 32 * nb_ : 256 + 32 * (lo + nb_ - nA);
            bf16x8 kfn[2][2]; u32x2 vlon[4], vhin[4];
            LOAD_KV(kfn, vlon, vhin, kvnext);
            const bool masked = blk >= nA; const int kpos0 = 32 * (lo + blk - nA) + 4 * lg;
            bf16x8 vf[4];
#pragma unroll
            for (int dt = 0; dt < 4; ++dt) { u32x4 w; w.x = vlo[dt].x; w.y = vlo[dt].y; w.z = vhi[dt].x; w.w = vhi[dt].y; vf[dt] = __builtin_bit_cast(bf16x8, w); }
#pragma unroll
            for (int qt = 0; qt < 4; ++qt) {
                f32x4 s0 = (f32x4){0.f, 0.f, 0.f, 0.f}, s1 = (f32x4){0.f, 0.f, 0.f, 0.f};
                s0 = __builtin_amdgcn_mfma_f32_16x16x32_bf16(kf[0][0], qf[qt][0], s0, 0, 0, 0); s0 = __builtin_amdgcn_mfma_f32_16x16x32_bf16(kf[0][1], qf[qt][1], s0, 0, 0, 0);
                s1 = __builtin_amdgcn_mfma_f32_16x16x32_bf16(kf[1][0], qf[qt][0], s1, 0, 0, 0); s1 = __builtin_amdgcn_mfma_f32_16x16x32_bf16(kf[1][1], qf[qt][1], s1, 0, 0, 0);
                if (masked) { const int qpos = q0 + l15;
#pragma unroll
                    for (int r = 0; r < 4; ++r) { const int d0 = kpos0 + r - qpos, d1 = d0 + 16;
                        if (d0 > 128 || d0 < -128) s0[r] = -1e30f; if (d1 > 128 || d1 < -128) s1[r] = -1e30f; } }
                float mx = fmaxf(fmaxf(fmaxf(s0[0], s0[1]), fmaxf(s0[2], s0[3])), fmaxf(fmaxf(s1[0], s1[1]), fmaxf(s1[2], s1[3])));
                mx = fmaxf(mx, __shfl_xor(mx, 16)); mx = fmaxf(mx, __shfl_xor(mx, 32));
                if (__any(mx > mrun[qt])) {
                    const float mnew = fmaxf(mrun[qt], mx), al = __builtin_amdgcn_exp2f(mrun[qt] - mnew); mrun[qt] = mnew; lsum[qt] *= al;
#pragma unroll
                    for (int dt = 0; dt < 4; ++dt) oacc[qt][dt] = oacc[qt][dt] * al; }
                const float mnew = mrun[qt];
                float ps = 0.f;
#pragma unroll
                for (int r = 0; r < 4; ++r) { s0[r] = __builtin_amdgcn_exp2f(s0[r] - mnew); s1[r] = __builtin_amdgcn_exp2f(s1[r] - mnew); ps += s0[r] + s1[r]; }
                lsum[qt] += ps;
                u32x4 pw; pw.x = cvt_pk_bf16(s0[0], s0[1]); pw.y = cvt_pk_bf16(s0[2], s0[3]); pw.z = cvt_pk_bf16(s1[0], s1[1]); pw.w = cvt_pk_bf16(s1[2], s1[3]);
                const bf16x8 pf = __builtin_bit_cast(bf16x8, pw);
#pragma unroll
                for (int dt = 0; dt < 4; ++dt) oacc[qt][dt] = __builtin_amdgcn_mfma_f32_16x16x32_bf16(vf[dt], pf, oacc[qt][dt], 0, 0, 0);
            }
#pragma unroll
            for (int kt = 0; kt < 2; ++kt)
#pragma unroll
                for (int ks = 0; ks < 2; ++ks) kf[kt][ks] = kfn[kt][ks];
#pragma unroll
            for (int dt = 0; dt < 4; ++dt) { vlo[dt] = vlon[dt]; vhi[dt] = vhin[dt]; }
        }
#undef LOAD_KV
#pragma unroll
        for (int qt = 0; qt < 4; ++qt) { float lt = lsum[qt]; lt += __shfl_xor(lt, 16); lt += __shfl_xor(lt, 32);
            if (type == 1) lt += __builtin_amdgcn_exp2f(sinkp[4 * g + qt] * LOG2E - mrun[qt]);
            const float inv = 1.0f / lt;
            bf16_t* op = O + (size_t)(rowbase + l15) * 1024 + qcol + 64 * qt + 4 * lg;
#pragma unroll
            for (int dt = 0; dt < 4; ++dt) { u32x2 w; w.x = cvt_pk_bf16(oacc[qt][dt][0] * inv, oacc[qt][dt][1] * inv); w.y = cvt_pk_bf16(oacc[qt][dt][2] * inv, oacc[qt][dt][3] * inv);
                *(u32x2*)(op + 16 * dt) = w; } }
    }
    return __builtin_amdgcn_s_memrealtime() - t_simple0;
#endif
}

#define RLX_AGENT __ATOMIC_RELAXED, __HIP_MEMORY_SCOPE_AGENT
#define XB_TMO      128
#define XB_XCNT(j)  (256  + 64 * (j))
#define XB_XSUB(j)  (1280 + 64 * (j))
#define XB_XGEN(j)  (2304 + 64 * (j))
#define XB_TOP      3328
#define XB_TOPGEN   3392
#define XCD_BAR_WORDS 3456
#define XB_SPIN_CAP (1u << 18)

__device__ __forceinline__ unsigned xb_ld(unsigned* p)              { return __hip_atomic_load(p, __ATOMIC_RELAXED, __HIP_MEMORY_SCOPE_AGENT); }
__device__ __forceinline__ unsigned xb_add(unsigned* p, unsigned v) { return __hip_atomic_fetch_add(p, v, __ATOMIC_RELAXED, __HIP_MEMORY_SCOPE_AGENT); }
__device__ __forceinline__ unsigned xb_xcc_id() { return (unsigned)__builtin_amdgcn_s_getreg((3 << 11) | 20) & 0xFu; }
#define XB_SPIN(cond, bar) do { unsigned _sp = 0; while (cond) { __builtin_amdgcn_s_sleep(1); \
    if ((++_sp & 255u) == 0u) { if (xb_ld(&(bar)[XB_TMO])) break; if (_sp > XB_SPIN_CAP) { atomicAdd(&(bar)[XB_TMO], 1u); break; } } } } while (0)

struct XcdBarrier {
    unsigned* bar; unsigned x;
    volatile LAS unsigned* st;
};

__device__ __forceinline__ XcdBarrier xcd_barrier_post(unsigned* bar, volatile LAS unsigned* st) {
    XcdBarrier b; b.bar = bar; b.x = xb_xcc_id(); b.st = st;
    if (threadIdx.x == 0) (void)xb_add(&bar[XB_XCNT(b.x)], 1u);
    return b;
}
__device__ __forceinline__ void xcd_barrier_complete(unsigned* bar, unsigned x, unsigned& nloc, unsigned& nx) {
    const unsigned G = gridDim.x * gridDim.y * gridDim.z;
    unsigned sum, cnt, mine, sp = 0u;
    for (;;) {
        sum = 0u; cnt = 0u; mine = 0u;
#pragma unroll
        for (unsigned j = 0; j < 16; ++j) { const unsigned c = xb_ld(&bar[XB_XCNT(j)]); sum += c; cnt += (c > 0u) ? 1u : 0u; mine = (j == x) ? c : mine; }
        if (sum == G) break;
        __builtin_amdgcn_s_sleep(1);
        if ((++sp & 255u) == 0u) { if (xb_ld(&bar[XB_TMO])) break; if (sp > XB_SPIN_CAP) { atomicAdd(&bar[XB_TMO], 1u); break; } }
    }
    nloc = mine > 0u ? mine : 1u; nx = cnt > 0u ? cnt : 1u;
}

__device__ __forceinline__ void xcd_barrier(const XcdBarrier& b) {
    asm volatile("s_waitcnt vmcnt(0)" ::: "memory");
    __syncthreads();
    if (threadIdx.x == 0) {
        unsigned* bar = b.bar;
        __builtin_amdgcn_s_waitcnt(0);
        unsigned nloc = b.st[0], nx = b.st[1];
        if (nloc == 0u) { xcd_barrier_complete(bar, b.x, nloc, nx); b.st[0] = nloc; b.st[1] = nx; }
        const unsigned old = xb_add(&bar[XB_XSUB(b.x)], 1u);
        const unsigned gen = old / nloc;
        if (old + 1u == (gen + 1u) * nloc) {
            __builtin_amdgcn_fence(__ATOMIC_RELEASE, "agent");
            asm volatile("s_waitcnt vmcnt(0)" ::: "memory");
            const unsigned og = xb_add(&bar[XB_TOP], 1u);
            const unsigned tg = og / nx;
            if (og + 1u == (tg + 1u) * nx) xb_add(&bar[XB_TOPGEN], 1u);
            else XB_SPIN(xb_ld(&bar[XB_TOPGEN]) == tg, bar);
            __builtin_amdgcn_fence(__ATOMIC_ACQUIRE, "agent");
            xb_add(&bar[XB_XGEN(b.x)], 1u);
            asm volatile("s_waitcnt vmcnt(0)" ::: "memory");
        } else {
            XB_SPIN(xb_ld(&bar[XB_XGEN(b.x)]) == gen, bar);
            __builtin_amdgcn_fence(__ATOMIC_ACQUIRE, "agent");
            asm volatile("s_waitcnt vmcnt(0)" ::: "memory");
        }
    }
    __syncthreads();
}

__global__ void __launch_bounds__(NTHR, 2) trunk_fwd(KArgs a) {
    extern __shared__ __attribute__((aligned(16))) unsigned char lds_raw[];
    LAS unsigned char* lds = (LAS unsigned char*)lds_raw;
    cg::grid_group grid = cg::this_grid();
    if (threadIdx.x < 16) ((LAS unsigned*)(lds + 131072))[threadIdx.x] = 0u;
    __syncthreads();
    const XcdBarrier xbar = xcd_barrier_post((unsigned*)(a.ws + OFF_BAR), (volatile LAS unsigned*)(lds + 131072 + 32));
#ifdef PROBE_KIND
    unsigned long long t_acc = 0;
#endif
    for (int si = a.step_lo; si < a.step_hi; ++si) {
        int tid = threadIdx.x; asm volatile("" : "+v"(tid));
        int z = 0; asm volatile("" : "+s"(z));
        unsigned char* ws = a.ws + z; unsigned char* WB = ws + OFF_W;
        const int st = a.steps[si], kind = st & 0xff, l = (st >> 8) & 0xf, arg = (st >> 12) & 0xf, jl = l >> 1;
        const int Mrows = (l == 3) ? ML : MALL;
#ifdef PROBE_KIND
        const unsigned long long t_0 = __builtin_amdgcn_s_memrealtime();
#endif
#ifdef ONLY
        if (kind != ONLY) continue;
#endif
        switch (kind) {
        case K_PROLOGUE: phase_prologue(a, z, tid, lds); break;
        case K_MOD0: phase_ln(a, z, tid, 0, 0, 0, MALL, blockIdx.x, gridDim.x); break;
        case K_LN: { const int which = arg & 3; const bool ctx_only = (arg >> 2) & 1;
            phase_ln(a, z, tid, l, which, ctx_only ? ML : 0, (l == 3) ? ML : MALL, blockIdx.x, gridDim.x); break; }
        case K_GEMM_EVIN: {
            const bool latonly = (arg >> 2) & 1, tail = (arg >> 3) & 1;
            pg8::Gemm g{(const bf16_t*)(ws + OFF_R2), (const bf16_t*)(WB + W_EV_IN) + (size_t)jl * 3072 * 1024, MALL, 3072, 1024, 1024, 0};
            EpiStore E{(bf16_t*)(ws + OFF_Z), 3072, 8};
            int M_ = MALL, G_ = gridDim.x; bool do_gemm = true;
            if (latonly) M_ = ML;
            if (tail) { g.A += (size_t)ML * 1024; E.O += (size_t)ML * 3072; M_ = MC; G_ = 96; do_gemm = blockIdx.x < 96; }
            g.M = M_;
            if (do_gemm) { pg8::StaticOrder S; S.init(M_, 3072, G_, blockIdx.x); pg8::gemm_phase<EpiStore, true>(tid, lds, g, S, E); }
            else phase_conv(a, z, tid, jl, 0, ML / 16, blockIdx.x - 96, gridDim.x - 96);
            break; }
        case K_GEMM_PLAIN: {
            const int pk = arg & 3; const bool latonly = (arg >> 2) & 1, tail = (arg >> 3) & 1;
            pg8::Gemm g; EpiStore E; int M_, N_;
            if (pk == PL_EVOUT) { g = pg8::Gemm{(const bf16_t*)(ws + OFF_Z), (const bf16_t*)(WB + W_EV_OUT) + (size_t)jl * 1024 * 1536, MALL, 1024, 1536, 3072, 0}; M_ = MALL; N_ = 1024; E = EpiStore{(bf16_t*)(ws + OFF_R2 + SZ_ROWS_BF), 1024, 0}; }
            else if (pk == PL_ODIN) { g = pg8::Gemm{(const bf16_t*)(ws + OFF_R2), (const bf16_t*)(WB + W_OD_IN) + (size_t)jl * 1536 * 1024, MALL, 1536, 1024, 1024, 0}; M_ = MALL; N_ = 1536; E = EpiStore{(bf16_t*)(ws + OFF_Z + ZO_QKV), 1536, 0}; }
            else if (pk == PL_ODOUT) { g = pg8::Gemm{(const bf16_t*)(ws + OFF_Z + ZO_O), (const bf16_t*)(WB + W_OD_OUT) + (size_t)jl * 1024 * 1024, Mrows, 1024, 1024, 1024, 0}; M_ = Mrows; N_ = 1024; E = EpiStore{(bf16_t*)(ws + OFF_R2 + SZ_ROWS_BF), 1024, 0}; }
            else { g = pg8::Gemm{(const bf16_t*)(ws + OFF_Z), (const bf16_t*)(WB + W_FFN_OUT) + (size_t)l * 1024 * 2816, Mrows, 1024, 2816, 2816, 0}; M_ = Mrows; N_ = 1024; E = EpiStore{(bf16_t*)(ws + OFF_R2 + SZ_ROWS_BF), 1024, 0}; }
            int G_ = gridDim.x; bool do_gemm = true;
            if (latonly) M_ = ML;
            const int tg = 8 * (N_ / 256);
            if (tail) { g.A += (size_t)ML * g.lda; E.O += (size_t)ML * E.ldc; M_ = MC; G_ = tg; do_gemm = blockIdx.x < tg; }
            g.M = M_;
            if (do_gemm) { pg8::StaticOrder S; S.init(M_, N_, G_, blockIdx.x); pg8::gemm_phase<EpiStore, true>(tid, lds, g, S, E); }
            else if (pk == PL_ODIN) phase_qkpost(a, z, tid, jl, 0, ML, blockIdx.x - tg, gridDim.x - tg);
            else phase_ln(a, z, tid, l, pk == PL_FFNOUT ? 2 : 1, 0, ML, blockIdx.x - tg, gridDim.x - tg);
            break; }
        case K_GEMM_SWIGLU: {
            pg8::Gemm g{(const bf16_t*)(ws + OFF_R2), (const bf16_t*)(WB + W_FFN_IN) + (size_t)l * 5632 * 1024, Mrows, 5632, 1024, 1024, 0};
            pg8::StaticOrder S; S.init(Mrows, 5632, gridDim.x, blockIdx.x);
            EpiSwiglu E{(bf16_t*)(ws + OFF_Z), 2816};
            pg8::gemm_phase<EpiSwiglu, true>(tid, lds, g, S, E); break; }
        case K_GEMM_GATE: {
            const int d = arg;
            pg8::Gemm g{(const bf16_t*)((unsigned char*)(a.out + z) + DO_XC), (const bf16_t*)(WB + W_GATE) + (size_t)jl * (2 * 8 * 256 * 128) + (size_t)d * 8 * 256 * 128, MALL, 2048, 128, 1024, 256};
            pg8::StaticOrder S; S.init(MALL, 2048, gridDim.x, blockIdx.x);
            EpiGate E{(bf16_t*)(ws + OFF_R2), (bf16_t*)(ws + OFF_R2 + SZ_ROWS_BF), (const bf16_t*)((unsigned char*)(a.out + z) + DO_XC),
                      a.in[z + 17] + (size_t)((jl * 2 + d) * 2 + 0) * 1024, a.in[z + 17] + (size_t)((jl * 2 + d) * 2 + 1) * 1024, (const float*)(ws + OFF_SPL) + (size_t)(jl * 2 + d) * 1024};
            pg8::gemm_phase<EpiGate, true>(tid, lds, g, S, E); break; }
        case K_CONV_GMLP: if (arg & 4) phase_conv(a, z, tid, jl, ML / 16, MC / 16, blockIdx.x, gridDim.x); else phase_conv(a, z, tid, jl, 0, MALL / 16, blockIdx.x, gridDim.x); break;
        case K_SCAN1: phase_scan(a, z, tid, arg, 1); break;
        case K_CARRY:
            phase_carry(a, z, tid, lds);
            if (arg == 0) phase_gmlp(a, z, tid, jl, lds, blockIdx.x, gridDim.x);
            break;
        case K_SCAN2: phase_scan(a, z, tid, arg, 2); break;
        case K_QKPOST: if (arg & 4) phase_qkpost(a, z, tid, jl, ML, MC, blockIdx.x, gridDim.x); else phase_qkpost(a, z, tid, jl, 0, MALL, blockIdx.x, gridDim.x); break;
        case K_ATTN: { const unsigned long long ts_ = phase_attn(a, z, tid, jl, l != 3, (char*)lds_raw);
#ifdef PROBE_ATTN_SIMPLE
            t_acc += ts_;
#else
            (void)ts_;
#endif
            break; }
        case K_DUMP: {
            const float* H = (const float*)(ws + OFF_H); const bf16_t* A_ = (const bf16_t*)(ws + OFF_R2); const bf16_t* Y_ = (const bf16_t*)(ws + OFF_R2 + SZ_ROWS_BF); const bf16_t* Z_ = (const bf16_t*)(ws + OFF_Z);
            for (size_t i = (size_t)blockIdx.x * NTHR + tid; i < (size_t)ML * 1024; i += (size_t)gridDim.x * NTHR) { const size_t row = i >> 10, c = i & 1023;
                (a.out + z)[i] = H[i] + bf_lo(A_[i]) + bf_lo(Y_[i]) + bf_lo(Z_[row * 3072 + c]) + bf_lo(Z_[row * 3072 + 1024 + c]) + bf_lo(Z_[row * 3072 + 2048 + c]); }
            break; }
        default: break;
        }
        if (si + 1 < a.step_hi) { if (si == a.step_lo) grid.sync(); else xcd_barrier(xbar); }
#ifdef PROBE_KIND
        if (kind == PROBE_KIND) t_acc += __builtin_amdgcn_s_memrealtime() - t_0;
#endif
    }
#ifdef PROBE_KIND
    { const unsigned long long t_s = __builtin_amdgcn_s_memrealtime(); while (__builtin_amdgcn_s_memrealtime() - t_s < t_acc) __builtin_amdgcn_s_sleep(8); }
#endif
}

extern "C" void kernel_launch(void* const* d_in, const int* in_sizes, int n_in, void* d_out, int out_size, void* d_ws, size_t ws_size, hipStream_t stream) {
    static int grid = 0;
    if (grid == 0) {
        if (n_in != 26 || out_size != ML * 1024 || ws_size < WS_NEED) { fprintf(stderr, "kernel_launch: unexpected problem (n_in %d out %d ws %zu need %zu)\n", n_in, out_size, ws_size, (size_t)WS_NEED); grid = -1; return; }
        int dev = 0, cus = 0, per_cu = 0;
        (void)hipGetDevice(&dev); (void)hipDeviceGetAttribute(&cus, hipDeviceAttributeMultiprocessorCount, dev);
        if (hipFuncSetAttribute((const void*)trunk_fwd, hipFuncAttributeMaxDynamicSharedMemorySize, LDS_BYTES) != hipSuccess) fprintf(stderr, "kernel_launch: hipFuncSetAttribute failed\n");
        if (hipOccupancyMaxActiveBlocksPerMultiprocessor(&per_cu, (const void*)trunk_fwd, NTHR, LDS_BYTES) != hipSuccess || per_cu < 1) { fprintf(stderr, "kernel_launch: occupancy query says %d\n", per_cu); per_cu = 1; }
        (void)hipGetLastError();
        if (per_cu > 1) per_cu = 1;
        grid = cus * per_cu;
    }
    if (grid < 0) return;
    KArgs a{};
    for (int i = 0; i < 26; ++i) a.in[i] = (const float*)d_in[i];
    a.out = (float*)d_out; a.ws = (unsigned char*)d_ws;
    int n = 0;
#ifndef PROBE_DUP
#define PROBE_DUP 0
#endif
#define STEP(kind, l, arg) do { a.steps[n++] = (kind) | ((l) << 8) | ((arg) << 12); if ((PROBE_DUP >> (kind)) & 1) a.steps[n++] = (kind) | ((l) << 8) | ((arg) << 12); } while (0)
    STEP(K_PROLOGUE, 0, 0); STEP(K_MOD0, 0, 0);
    const bool split = grid >= 192;
    for (int l = 0; l < 4; ++l) {
        const bool sp = split && l != 3;
        if ((l & 1) == 0) {
            if (split) { STEP(K_GEMM_EVIN, l, 4); STEP(K_GEMM_EVIN, l, 8); STEP(K_CONV_GMLP, l, 4); } else { STEP(K_GEMM_EVIN, l, 0); STEP(K_CONV_GMLP, l, 0); }
            for (int d = 0; d < 2; ++d) { STEP(K_GEMM_GATE, l, d); STEP(K_SCAN1, l, d); STEP(K_CARRY, l, d); STEP(K_SCAN2, l, d); }
            if (sp) { STEP(K_GEMM_PLAIN, l, PL_EVOUT | 4); STEP(K_GEMM_PLAIN, l, PL_EVOUT | 8); STEP(K_LN, l, 1 | 4); } else { STEP(K_GEMM_PLAIN, l, PL_EVOUT); STEP(K_LN, l, 1); }
        } else {
            if (split) { STEP(K_GEMM_PLAIN, l, PL_ODIN | 4); STEP(K_GEMM_PLAIN, l, PL_ODIN | 8); STEP(K_QKPOST, l, 4); } else { STEP(K_GEMM_PLAIN, l, PL_ODIN); STEP(K_QKPOST, l, 0); }
            STEP(K_ATTN, l, 0);
            if (sp) { STEP(K_GEMM_PLAIN, l, PL_ODOUT | 4); STEP(K_GEMM_PLAIN, l, PL_ODOUT | 8); STEP(K_LN, l, 1 | 4); } else { STEP(K_GEMM_PLAIN, l, PL_ODOUT); STEP(K_LN, l, 1); }
        }
        STEP(K_GEMM_SWIGLU, l, 0);
        if (sp) { STEP(K_GEMM_PLAIN, l, PL_FFNOUT | 4); STEP(K_GEMM_PLAIN, l, PL_FFNOUT | 8); STEP(K_LN, l, 2 | 4); } else { STEP(K_GEMM_PLAIN, l, PL_FFNOUT); STEP(K_LN, l, 2); }
    }
#undef STEP
#ifdef TRUNC
    n = TRUNC; a.steps[n++] = K_DUMP;
#endif
    a.step_lo = 0; a.step_hi = n;
    (void)hipMemsetAsync((unsigned char*)d_ws + OFF_BAR, 0, 16384, stream);
    void* args[] = {&a};
#ifndef FORCE_MULTI
#define FORCE_MULTI 0
#endif
    hipError_t e = FORCE_MULTI ? hipErrorUnknown : hipLaunchCooperativeKernel((const void*)trunk_fwd, dim3(grid), dim3(NTHR), args, LDS_BYTES, stream);
    if (e != hipSuccess) {
        if (!FORCE_MULTI) fprintf(stderr, "kernel_launch: cooperative launch failed: %s (grid %d); falling back to one launch per step\n", hipGetErrorString(e), grid);
        (void)hipGetLastError();
        for (int s = 0; s < n; ++s) { a.step_lo = s; a.step_hi = s + 1; hipLaunchKernelGGL(trunk_fwd, dim3(grid), dim3(NTHR), LDS_BYTES, stream, a); }
    }
}
```

```cpp
#include <hip/hip_runtime.h>
#include <hip/hip_cooperative_groups.h>
#include <cstdio>
#include <cstdint>
#include <hip/hip_bf16.h>
#include <cmath>
namespace cg = cooperative_groups;

#define LAS __attribute__((address_space(3)))
typedef unsigned short bf16_t;
typedef short bf16x8 __attribute__((ext_vector_type(8)));
typedef float f32x4 __attribute__((ext_vector_type(4)));
typedef float f32x2 __attribute__((ext_vector_type(2)));
typedef unsigned u32x4 __attribute__((ext_vector_type(4)));
typedef unsigned u32x2 __attribute__((ext_vector_type(2)));

constexpr int DM = 1024, NB = 8, SEQ = 8192, CTXL = 256, ML = NB * SEQ, MC = NB * CTXL, MALL = ML + MC, FH = 2816, KVR = SEQ + CTXL;
constexpr int NTHR = 512, NWAVE = 8;
constexpr int LDS_BYTES = 131072 + 2048;
constexpr float ALPHA = 1.681792830507429f, LOG2E = 1.4426950408889634f;
constexpr float QSCALE = 0.125f * 1.4426950408889634f;

constexpr size_t SZ_ROWS_BF = (size_t)MALL * 1024 * 2;
constexpr size_t OFF_H = 0;
constexpr size_t OFF_W = OFF_H + (size_t)MALL * 1024 * 4;
constexpr size_t W_FFN_IN = 0;
constexpr size_t W_FFN_OUT = W_FFN_IN + 4ull * 5632 * 1024 * 2;
constexpr size_t W_EV_IN = W_FFN_OUT + 4ull * 1024 * 2816 * 2;
constexpr size_t W_EV_OUT = W_EV_IN + 2ull * 3072 * 1024 * 2;
constexpr size_t W_GATE = W_EV_OUT + 2ull * 1024 * 1536 * 2;
constexpr size_t W_OD_IN = W_GATE + 2ull * 2 * 8 * 256 * 128 * 2;
constexpr size_t W_OD_OUT = W_OD_IN + 2ull * 1536 * 1024 * 2;
constexpr size_t W_END = W_OD_OUT + 2ull * 1024 * 1024 * 2;
constexpr size_t OFF_MOD = OFF_W + W_END;
constexpr size_t OFF_Z = OFF_MOD + 4ull * 9 * 6144 * 4;
constexpr size_t OFF_R2 = OFF_Z + (size_t)MALL * 3072 * 2;
constexpr size_t OFF_SPL = OFF_R2 + 2 * SZ_ROWS_BF;
constexpr size_t OFF_BAR = OFF_SPL + 16384;
constexpr size_t WS_NEED = OFF_BAR + 16384;
constexpr size_t ZO_QKV = 0;
constexpr size_t ZO_O = (size_t)MALL * 1536 * 2;
constexpr size_t ZO_KK = ZO_O + SZ_ROWS_BF;
constexpr size_t ZO_VT = ZO_KK + 2ull * 8 * 2 * KVR * 64 * 2;
constexpr size_t DO_VV = 0;
constexpr size_t DO_XC = 0;
constexpr size_t DO_SUMM = SZ_ROWS_BF;
constexpr size_t DO_CARRY = DO_SUMM + 8ull * 264 * 1024 * 8;

struct KArgs {
    const float* in[26];
    float* out; unsigned char* ws;
    int step_lo, step_hi;
    int steps[96];
};
enum { K_PROLOGUE = 0, K_MOD0, K_GEMM_EVIN, K_CONV_GMLP, K_GEMM_GATE, K_SCAN1, K_CARRY, K_SCAN2, K_GEMM_PLAIN, K_LN, K_GEMM_SWIGLU, K_QKPOST, K_ATTN, K_DUMP };
enum { PL_EVOUT = 0, PL_ODIN, PL_ODOUT, PL_FFNOUT };

typedef __bf16 bf16x2_t __attribute__((ext_vector_type(2)));
__device__ __forceinline__ unsigned cvt_pk_bf16(float lo, float hi) { f32x2 v = {lo, hi}; bf16x2_t b = __builtin_convertvector(v, bf16x2_t); return __builtin_bit_cast(unsigned, b); }
__device__ __forceinline__ float bf_lo(unsigned w) { return __uint_as_float(w << 16); }
__device__ __forceinline__ float bf_hi(unsigned w) { return __uint_as_float(w & 0xffff0000u); }
__device__ __forceinline__ float fast_sigmoid(float x) { return __builtin_amdgcn_rcpf(1.0f + __builtin_amdgcn_exp2f(-x * LOG2E)); }
__device__ __forceinline__ float silu_f(float x) { return x * fast_sigmoid(x); }
__device__ __forceinline__ float gelu_tanh(float x) { const float u = x + 0.044715f * x * x * x; return x * __builtin_amdgcn_rcpf(1.0f + __builtin_amdgcn_exp2f(-2.0f * 0.7978845608028654f * LOG2E * u)); }
__device__ __forceinline__ void unpack8(const u32x4 w, float (&x)[8]) { x[0] = bf_lo(w.x); x[1] = bf_hi(w.x); x[2] = bf_lo(w.y); x[3] = bf_hi(w.y); x[4] = bf_lo(w.z); x[5] = bf_hi(w.z); x[6] = bf_lo(w.w); x[7] = bf_hi(w.w); }
__device__ __forceinline__ float wave_sum(float v) {
#pragma unroll
    for (int o = 1; o < 64; o <<= 1) v += __shfl_xor(v, o);
    return v;
}

namespace pg8 {
constexpr int BM = 256, BK = 64, HALF = 128, HTB = HALF * BK * 2, STAGE_BYTES = 8 * HTB, NXCD = 8, WGM = 4;
__host__ __device__ __forceinline__ int lds_byte(int r, int c) { const int st = (r >> 4) * 2 + (c >> 5), rr = r & 15, cc = c & 31, ob = rr * 64 + cc * 2; return st * 1024 + (ob ^ (((ob >> 9) & 1) << 5)); }
__host__ __device__ __forceinline__ void stage_rc(int b, int& R, int& C) { const int st = b / 1024, sb = b % 1024, swz = sb ^ (((sb >> 9) & 1) << 5); R = (st >> 1) * 16 + swz / 64; C = (st & 1) * 32 + (swz % 64) / 2; }
__host__ __device__ __forceinline__ int perm32(int rho) { const int n = rho >> 4, i = rho & 15; return 8 * (i >> 2) + 4 * n + (i & 3); }
struct Unit { int pm, pn; };
struct Gemm { const bf16_t* A; const bf16_t* Bt; int M, N, K, lda, a_pn_off; };
struct StaticOrder {
    int nM, nN, nwg, G, c;
    __device__ void init(int M, int N, int G_, int c_) { nM = M / BM; nN = N / BM; nwg = nM * nN; G = G_; c = c_; }
    __device__ bool next(int i, Unit& u) const {
        const long L = (long)i * G + c; if (L >= nwg) return false;
        int wgid = (int)L; { const int q = nwg / NXCD, r = nwg % NXCD, xcd = wgid % NXCD, off = wgid / NXCD; wgid = (xcd < r ? xcd * (q + 1) : r * (q + 1) + (xcd - r) * q) + off; }
        const int nig = WGM * nN, gid = wgid / nig, fm = gid * WGM, gsz = (nM - fm) < WGM ? (nM - fm) : WGM;
        u.pm = fm + ((wgid % nig) % gsz); u.pn = (wgid % nig) / gsz; return true;
    }
};
template <class Epi, bool ALIGN_EPI>
__device__ __forceinline__ void gemm_phase(int tid, LAS unsigned char* lds, const Gemm g, const StaticOrder& S, const Epi& E) {
    const int wid = __builtin_amdgcn_readfirstlane(tid >> 6), lane = tid & 63, wr = wid >> 2, wc = wid & 3, fr = lane & 15, fq = lane >> 4;
    const int K = g.K, nt = K / BK;
    unsigned voffA[2], voffB[2];
#pragma unroll
    for (int i = 0; i < 2; ++i) { int R, C; stage_rc(tid * 16 + i * 8192, R, C); const int Rb = Epi::PERM ? ((R & ~31) + perm32(R & 31)) : R;
        voffA[i] = (unsigned)(R * g.lda + C) * 2u; voffB[i] = (unsigned)(Rb * K + C) * 2u; }
    const size_t kstep = (size_t)(BK * 2);
    const size_t hstepA = (size_t)HALF * g.lda * 2, hstepB = (size_t)HALF * K * 2;
    const size_t tstepA = 2 * hstepA, tstepB = 2 * hstepB;
    const unsigned ldsw = (unsigned)wid * 1024u;
    const int aoff = lds_byte(wr * 64 + fr, fq * 8), boff = lds_byte(wc * 32 + fr, fq * 8);
#define PG8_SA(b, h) (((b) * 2 + (h)) * HTB)
#define PG8_SB(b, h) ((4 + (b) * 2 + (h)) * HTB)
#define PG8_STAGE(bufoff, gbase, voff) do { _Pragma("unroll") for (int _i = 0; _i < 2; ++_i) \
        __builtin_amdgcn_global_load_lds((const unsigned*)((const char*)(gbase) + (voff)[_i]), (LAS unsigned*)(lds + (bufoff) + ldsw + _i * 8192), 16, 0, 0); } while (0)
#define PG8_LDA(dst, b, h) do { _Pragma("unroll") for (int m = 0; m < 4; ++m) _Pragma("unroll") for (int k = 0; k < 2; ++k) dst[m][k] = *(const LAS bf16x8*)(lds + PG8_SA(b, h) + aoff + m * 2048 + k * 1024); } while (0)
#define PG8_LDB(dst, b, h) do { _Pragma("unroll") for (int n = 0; n < 2; ++n) _Pragma("unroll") for (int k = 0; k < 2; ++k) dst[n][k] = *(const LAS bf16x8*)(lds + PG8_SB(b, h) + boff + n * 2048 + k * 1024); } while (0)
#define PG8_MMA(ai, bj, At, Bt) do { __builtin_amdgcn_s_setprio(1); _Pragma("unroll") for (int m = 0; m < 4; ++m) _Pragma("unroll") for (int n = 0; n < 2; ++n) _Pragma("unroll") for (int k = 0; k < 2; ++k) \
        acc[ai][bj][m][n] = __builtin_amdgcn_mfma_f32_16x16x32_bf16(Bt[n][k], At[m][k], acc[ai][bj][m][n], 0, 0, 0); __builtin_amdgcn_s_setprio(0); } while (0)
#define PG8_WAIT_V(n) asm volatile("s_waitcnt vmcnt(" #n ")" ::: "memory")
#define PG8_WAIT_L(n) asm volatile("s_waitcnt lgkmcnt(" #n ")" ::: "memory")
#define PG8_BAR __builtin_amdgcn_s_barrier()
#define PG8_SCHED __builtin_amdgcn_sched_barrier(0)
    Unit cur, nxt; int ui = 0;
    if (!S.next(0, cur)) return;
    f32x4 acc[2][2][4][2];
#pragma unroll
    for (int a = 0; a < 2; ++a)
#pragma unroll
        for (int b = 0; b < 2; ++b)
#pragma unroll
            for (int m = 0; m < 4; ++m)
#pragma unroll
                for (int n = 0; n < 2; ++n) acc[a][b][m][n] = (f32x4){0.f, 0.f, 0.f, 0.f};
    bf16x8 At[4][2], B0[2][2], B1[2][2];
    const char* cA = (const char*)g.A + (size_t)cur.pm * tstepA + (size_t)cur.pn * (size_t)g.a_pn_off; const char* cB = (const char*)g.Bt + (size_t)cur.pn * tstepB;
    PG8_STAGE(PG8_SB(0, 0), cB, voffB); PG8_STAGE(PG8_SB(0, 1), cB + hstepB, voffB); PG8_STAGE(PG8_SA(0, 0), cA, voffA); PG8_STAGE(PG8_SA(0, 1), cA + hstepA, voffA);
    if (wr == 1) PG8_BAR;
    PG8_WAIT_V(2); PG8_BAR;
    PG8_STAGE(PG8_SB(1, 0), cB + kstep, voffB); PG8_STAGE(PG8_SA(1, 0), cA + kstep, voffA); PG8_STAGE(PG8_SB(1, 1), cB + hstepB + kstep, voffB);
    PG8_WAIT_V(6); PG8_BAR;
    for (;;) {
        const bool has_next = S.next(ui + 1, nxt);
        const char* nA = has_next ? (const char*)g.A + (size_t)nxt.pm * tstepA + (size_t)nxt.pn * (size_t)g.a_pn_off : cA; const char* nB = has_next ? (const char*)g.Bt + (size_t)nxt.pn * tstepB : cB;
        for (int t = 0; t < nt; t += 2) {
            const bool last = (t == nt - 2);
            const char* a1 = cA + (size_t)(t + 1) * kstep;
            const char* a2 = last ? nA : cA + (size_t)(t + 2) * kstep; const char* b2 = last ? nB : cB + (size_t)(t + 2) * kstep;
            const char* a3 = a2 + kstep; const char* b3 = b2 + kstep;
            PG8_LDB(B0, 0, 0); PG8_LDB(B1, 0, 1); PG8_SCHED; PG8_LDA(At, 0, 0); PG8_STAGE(PG8_SA(1, 1), a1 + hstepA, voffA);
            PG8_WAIT_V(8); PG8_WAIT_L(0); PG8_BAR; PG8_MMA(0, 0, At, B0); PG8_MMA(0, 1, At, B1); PG8_BAR; PG8_SCHED;
            PG8_LDA(At, 0, 1); PG8_STAGE(PG8_SB(0, 0), b2, voffB); PG8_STAGE(PG8_SB(0, 1), b2 + hstepB, voffB); PG8_STAGE(PG8_SA(0, 0), a2, voffA);
            PG8_WAIT_V(8); PG8_WAIT_L(0); PG8_BAR; PG8_MMA(1, 0, At, B0); PG8_MMA(1, 1, At, B1); PG8_BAR; PG8_SCHED;
            PG8_LDB(B0, 1, 0); PG8_LDB(B1, 1, 1); PG8_SCHED; PG8_LDA(At, 1, 0); PG8_STAGE(PG8_SA(0, 1), a2 + hstepA, voffA);
            PG8_WAIT_V(8); PG8_WAIT_L(0); PG8_BAR; PG8_MMA(0, 0, At, B0); PG8_MMA(0, 1, At, B1); PG8_BAR; PG8_SCHED;
            PG8_LDA(At, 1, 1); PG8_STAGE(PG8_SB(1, 0), b3, voffB); PG8_STAGE(PG8_SB(1, 1), b3 + hstepB, voffB); PG8_STAGE(PG8_SA(1, 0), a3, voffA);
            PG8_WAIT_V(8); PG8_WAIT_L(0); PG8_BAR; PG8_MMA(1, 0, At, B0); PG8_MMA(1, 1, At, B1); PG8_BAR; PG8_SCHED;
        }
        if constexpr (ALIGN_EPI) { if (wr == 0) PG8_BAR; }
        E(acc, cur, wr, wc, fr, fq);
        if (!has_next) break;
#pragma unroll
        for (int a = 0; a < 2; ++a)
#pragma unroll
            for (int b = 0; b < 2; ++b)
#pragma unroll
                for (int m = 0; m < 4; ++m)
#pragma unroll
                    for (int n = 0; n < 2; ++n) acc[a][b][m][n] = (f32x4){0.f, 0.f, 0.f, 0.f};
        cur = nxt; cA = nA; cB = nB; ++ui;
        if constexpr (ALIGN_EPI) { if (wr == 1) PG8_BAR; }
    }
    PG8_WAIT_V(0);
    if constexpr (!ALIGN_EPI) { if (wr == 0) PG8_BAR; }
    PG8_BAR;
#undef PG8_SA
#undef PG8_SB
#undef PG8_STAGE
#undef PG8_LDA
#undef PG8_LDB
#undef PG8_MMA
#undef PG8_WAIT_V
#undef PG8_WAIT_L
#undef PG8_BAR
#undef PG8_SCHED
}
}

struct EpiStore {
    static constexpr bool PERM = true;
    bf16_t* O; int ldc; int gelu_tiles;
    __device__ __forceinline__ void operator()(const f32x4 (&acc)[2][2][4][2], const pg8::Unit& u, int wr, int wc, int fr, int fq) const {
        const int row0 = u.pm * 256 + wr * 64 + fr, col0 = u.pn * 256 + wc * 32 + 8 * fq; const bool act = u.pn < gelu_tiles;
#pragma unroll
        for (int ai = 0; ai < 2; ++ai)
#pragma unroll
            for (int m = 0; m < 4; ++m) { bf16_t* rowp = O + (size_t)(row0 + ai * 128 + m * 16) * ldc + col0;
#pragma unroll
                for (int bj = 0; bj < 2; ++bj) { f32x4 v0 = acc[ai][bj][m][0], v1 = acc[ai][bj][m][1];
                    if (act) {
#pragma unroll
                        for (int e = 0; e < 4; ++e) { v0[e] = gelu_tanh(v0[e]); v1[e] = gelu_tanh(v1[e]); } }
                    u32x4 w; w.x = cvt_pk_bf16(v0[0], v0[1]); w.y = cvt_pk_bf16(v0[2], v0[3]); w.z = cvt_pk_bf16(v1[0], v1[1]); w.w = cvt_pk_bf16(v1[2], v1[3]);
                    *(u32x4*)(rowp + bj * 128) = w; } }
    }
};
struct EpiSwiglu {
    static constexpr bool PERM = true;
    bf16_t* O; int ldc;
    __device__ __forceinline__ void operator()(const f32x4 (&acc)[2][2][4][2], const pg8::Unit& u, int wr, int wc, int fr, int fq) const {
        const int row0 = u.pm * 256 + wr * 64 + fr, col0 = u.pn * 128 + wc * 32 + 8 * fq;
#pragma unroll
        for (int ai = 0; ai < 2; ++ai)
#pragma unroll
            for (int m = 0; m < 4; ++m) { bf16_t* rowp = O + (size_t)(row0 + ai * 128 + m * 16) * ldc + col0;
                f32x4 v0, v1;
#pragma unroll
                for (int e = 0; e < 4; ++e) { v0[e] = silu_f(acc[ai][0][m][0][e]) * acc[ai][1][m][0][e]; v1[e] = silu_f(acc[ai][0][m][1][e]) * acc[ai][1][m][1][e]; }
                u32x4 w; w.x = cvt_pk_bf16(v0[0], v0[1]); w.y = cvt_pk_bf16(v0[2], v0[3]); w.z = cvt_pk_bf16(v1[0], v1[1]); w.w = cvt_pk_bf16(v1[2], v1[3]);
                __builtin_nontemporal_store(w, (u32x4*)rowp); }
    }
};
struct EpiGate {
    static constexpr bool PERM = true;
    bf16_t* LA; bf16_t* BBo; const bf16_t* XC; const float* gb_r; const float* gb_i; const float* spl;
    __device__ __forceinline__ void operator()(const f32x4 (&acc)[2][2][4][2], const pg8::Unit& u, int wr, int wc, int fr, int fq) const {
        const int row0 = u.pm * 256 + wr * 64 + fr, ch0 = u.pn * 128 + wc * 32 + 8 * fq;
#pragma unroll
        for (int ai = 0; ai < 2; ++ai)
#pragma unroll
            for (int m = 0; m < 4; ++m) { const size_t off = (size_t)(row0 + ai * 128 + m * 16) * 1024 + ch0;
                const u32x4 xw = *(const u32x4*)(XC + off);
                u32x4 w1, w2;
#pragma unroll
                for (int n = 0; n < 2; ++n) {
                    const f32x4 br = *(const f32x4*)(gb_r + ch0 + 4 * n), bi = *(const f32x4*)(gb_i + ch0 + 4 * n), sp = *(const f32x4*)(spl + ch0 + 4 * n);
                    const unsigned xa = n == 0 ? xw.x : xw.z, xb = n == 0 ? xw.y : xw.w;
                    const float xv[4] = {bf_lo(xa), bf_hi(xa), bf_lo(xb), bf_hi(xb)};
                    float la[4], bb[4];
#pragma unroll
                    for (int e = 0; e < 4; ++e) { const float gr = acc[ai][0][m][n][e] + br[e], gi = acc[ai][1][m][n][e] + bi[e];
                        const float l_ = sp[e] * fast_sigmoid(gr); la[e] = l_;
                        const float om = fmaxf(0.0f, 1.0f - __builtin_amdgcn_exp2f(2.0f * LOG2E * l_)); bb[e] = __builtin_amdgcn_sqrtf(om) * fast_sigmoid(gi) * xv[e]; }
                    if (n == 0) { w1.x = cvt_pk_bf16(la[0], la[1]); w1.y = cvt_pk_bf16(la[2], la[3]); w2.x = cvt_pk_bf16(bb[0], bb[1]); w2.y = cvt_pk_bf16(bb[2], bb[3]); }
                    else { w1.z = cvt_pk_bf16(la[0], la[1]); w1.w = cvt_pk_bf16(la[2], la[3]); w2.z = cvt_pk_bf16(bb[0], bb[1]); w2.w = cvt_pk_bf16(bb[2], bb[3]); }
                }
                *(u32x4*)(LA + off) = w1; *(u32x4*)(BBo + off) = w2; }
    }
};

__device__ __forceinline__ int colmap(int id, int n) {
    if (id == 1) { const int t = n >> 8, w = n & 255; return w < 128 ? t * 128 + w : FH + t * 128 + (w - 128); }
    if (id == 2) return n < 1024 ? n : (n < 2048 ? n + 1024 : n - 1024);
    return n;
}
__device__ __forceinline__ void tr_item(const float* W, int ldsrc, int K, bf16_t* WT, int n0, int k0, int mapid, LAS float* scr, int lane) {
    const int sc = colmap(mapid, n0 + (lane & 31));
#pragma unroll 8
    for (int i = 0; i < 32; ++i) { const int kk = 2 * i + (lane >> 5); scr[kk * 33 + (lane & 31)] = W[(size_t)(k0 + kk) * ldsrc + sc]; }
    asm volatile("s_waitcnt lgkmcnt(0)" ::: "memory");
    const int c = lane & 7;
#pragma unroll
    for (int j = 0; j < 4; ++j) { const int n = (lane >> 3) + 8 * j; const LAS float* s = scr + (8 * c) * 33 + n;
        u32x4 o; o.x = cvt_pk_bf16(s[0 * 33], s[1 * 33]); o.y = cvt_pk_bf16(s[2 * 33], s[3 * 33]); o.z = cvt_pk_bf16(s[4 * 33], s[5 * 33]); o.w = cvt_pk_bf16(s[6 * 33], s[7 * 33]);
        *(u32x4*)(WT + (size_t)(n0 + n) * K + k0 + 8 * c) = o; }
    asm volatile("s_waitcnt lgkmcnt(0)" ::: "memory");
}
__device__ __forceinline__ void phase_prologue(const KArgs& a, const int z, const int tid, LAS unsigned char* lds) {
    const int lane = tid & 63, wave = tid >> 6;
    LAS float* sv = (LAS float*)(lds + 73728);
    LAS float* part = (LAS float*)(lds + 110592);
    float* MOD = (float*)((a.ws + z) + OFF_MOD);
    for (int i = tid; i < 9 * 1024; i += NTHR) { const int s = i >> 10, k = i & 1023; const float v = s < 8 ? a.in[z + 1][s * 1024 + k] : a.in[z + 3][k]; sv[i] = v / (1.0f + __expf(-v)); }
    __syncthreads();
    for (int item = blockIdx.x; item < 768; item += gridDim.x) {
        const int l = item / 192, n0 = (item % 192) * 32, ks = tid >> 5, cl = tid & 31;
        const float* w = a.in[z + 4] + (size_t)l * 1024 * 6144 + n0 + cl;
        float acc[9];
#pragma unroll
        for (int s = 0; s < 9; ++s) acc[s] = 0.f;
        const int k0 = ks * 64;
        for (int kb = 0; kb < 64; kb += 16) { float wv[16];
#pragma unroll
            for (int k = 0; k < 16; ++k) wv[k] = w[(size_t)(k0 + kb + k) * 6144];
#pragma unroll
            for (int k = 0; k < 16; ++k)
#pragma unroll
                for (int s = 0; s < 9; ++s) acc[s] += sv[s * 1024 + k0 + kb + k] * wv[k]; }
#pragma unroll
        for (int s = 0; s < 9; ++s) part[(ks * 9 + s) * 32 + cl] = acc[s];
        __syncthreads();
        for (int idx = tid; idx < 288; idx += NTHR) { const int s = idx >> 5, n = idx & 31; float r = a.in[z + 5][l * 6144 + n0 + n];
#pragma unroll
            for (int w16 = 0; w16 < 16; ++w16) r += part[(w16 * 9 + s) * 32 + n];
            MOD[(size_t)(l * 9 + s) * 6144 + n0 + n] = r; }
        __syncthreads();
    }
    for (int i = blockIdx.x * NTHR + tid; i < 4096; i += gridDim.x * NTHR) ((float*)((a.ws + z) + OFF_SPL))[i] = -8.0f * log1pf(__expf(-a.in[z + 18][i]));
    LAS float* scr = (LAS float*)(lds + wave * 8448);
    unsigned char* WB = (a.ws + z) + OFF_W;
    const int gw = blockIdx.x * NWAVE + wave, NGW = gridDim.x * NWAVE;
    for (int it = gw; it < 24576; it += NGW) {
        int r = it;
        if (r < 11264) { const int l = r / 2816, q = r % 2816, kb = q / 176, nb = q % 176;
            tr_item(a.in[z + 10] + (size_t)l * 1024 * 5632, 5632, 1024, (bf16_t*)(WB + W_FFN_IN) + (size_t)l * 5632 * 1024, nb * 32, kb * 64, 1, scr, lane); continue; }
        r -= 11264;
        if (r < 5632) { const int l = r / 1408, q = r % 1408, kb = q / 32, nb = q % 32;
            tr_item(a.in[z + 11] + (size_t)l * 2816 * 1024, 1024, 2816, (bf16_t*)(WB + W_FFN_OUT) + (size_t)l * 1024 * 2816, nb * 32, kb * 64, 0, scr, lane); continue; }
        r -= 5632;
        if (r < 3072) { const int j = r / 1536, q = r % 1536, kb = q / 96, nb = q % 96;
            tr_item(a.in[z + 12] + (size_t)j * 1024 * 3072, 3072, 1024, (bf16_t*)(WB + W_EV_IN) + (size_t)j * 3072 * 1024, nb * 32, kb * 64, 2, scr, lane); continue; }
        r -= 3072;
        if (r < 1536) { const int j = r / 768, q = r % 768, kb = q / 32, nb = q % 32;
            tr_item(a.in[z + 13] + (size_t)j * 1536 * 1024, 1024, 1536, (bf16_t*)(WB + W_EV_OUT) + (size_t)j * 1024 * 1536, nb * 32, kb * 64, 0, scr, lane); continue; }
        r -= 1536;
        if (r < 512) { const int blk = r >> 3, q = r & 7, kb = q >> 2, nb = q & 3; const int h = blk & 7, k = (blk >> 3) & 1, d = (blk >> 4) & 1, j = blk >> 5;
            tr_item(a.in[z + 16] + (size_t)blk * 16384, 128, 128, (bf16_t*)(WB + W_GATE) + (size_t)j * (2 * 8 * 256 * 128) + (size_t)((d * 8 + h) * 256 + k * 128) * 128, nb * 32, kb * 64, 0, scr, lane); continue; }
        r -= 512;
        if (r < 1536) { const int j = r / 768, q = r % 768, kb = q / 48, nb = q % 48;
            tr_item(a.in[z + 21] + (size_t)j * 1024 * 1536, 1536, 1024, (bf16_t*)(WB + W_OD_IN) + (size_t)j * 1536 * 1024, nb * 32, kb * 64, 0, scr, lane); continue; }
        r -= 1536;
        { const int j = r / 512, q = r % 512, kb = q / 32, nb = q % 32;
            tr_item(a.in[z + 22] + (size_t)j * 1024 * 1024, 1024, 1024, (bf16_t*)(WB + W_OD_OUT) + (size_t)j * 1024 * 1024, nb * 32, kb * 64, 0, scr, lane); }
    }
}

struct LnCtx { float* H; const float* MOD; bf16_t* A; const bf16_t* Y; const float* gam; const float* bet; float* outp; int l, which, lm, shi, sci, gi; bool final_, from_in; const float* xin; const float* cin; };
__device__ __forceinline__ const float* ln_src(const LnCtx& c, int row) { return c.from_in ? (row < ML ? c.xin + (size_t)row * 1024 : c.cin + (size_t)(row - ML) * 1024) : c.H + (size_t)row * 1024; }
struct LnPar { f32x4 g[4], gm[4], bt[4], sh[4], sc[4]; };
__device__ __forceinline__ void ln_load_par(const LnCtx& c, int lane, int ms, LnPar& p) {
    const float* gp = c.MOD + (size_t)(c.l * 9 + ms) * 6144 + c.gi * 1024;
    const float* shp = c.MOD + (size_t)(c.lm * 9 + ms) * 6144 + c.shi * 1024; const float* scp = c.MOD + (size_t)(c.lm * 9 + ms) * 6144 + c.sci * 1024;
#pragma unroll
    for (int j = 0; j < 4; ++j) { const int o = 4 * lane + 256 * j;
        if (c.which != 0) p.g[j] = *(const f32x4*)(gp + o);
        if (!c.final_) { p.sh[j] = *(const f32x4*)(shp + o); p.sc[j] = *(const f32x4*)(scp + o) + 1.0f; } }
}
__device__ __forceinline__ void ln_finish(const LnCtx& c, const LnPar& p, int lane, int row, f32x4 (&v)[4], const u32x2 (&yw)[4]) {
    if (c.which != 0) {
        float s = 0.f;
#pragma unroll
        for (int j = 0; j < 4; ++j) { const f32x4 g = p.g[j];
            v[j][0] = ALPHA * v[j][0] + g[0] * bf_lo(yw[j].x); v[j][1] = ALPHA * v[j][1] + g[1] * bf_hi(yw[j].x); v[j][2] = ALPHA * v[j][2] + g[2] * bf_lo(yw[j].y); v[j][3] = ALPHA * v[j][3] + g[3] * bf_hi(yw[j].y);
            s += (v[j][0] + v[j][1]) + (v[j][2] + v[j][3]); }
        const float mean = wave_sum(s) * (1.0f / 1024.0f); float s2 = 0.f;
#pragma unroll
        for (int j = 0; j < 4; ++j) { v[j] = v[j] - mean; s2 += (v[j][0] * v[j][0] + v[j][1] * v[j][1]) + (v[j][2] * v[j][2] + v[j][3] * v[j][3]); }
        const float rstd = rsqrtf(wave_sum(s2) * (1.0f / 1024.0f) + 1e-6f);
        float* dst = c.final_ ? c.outp + (size_t)row * 1024 : c.H + (size_t)row * 1024;
#pragma unroll
        for (int j = 0; j < 4; ++j) { v[j] = v[j] * rstd * p.gm[j] + p.bt[j]; __builtin_nontemporal_store(v[j], (f32x4*)(dst + 4 * lane + 256 * j)); }
    }
    if (!c.final_) {
#pragma unroll
        for (int j = 0; j < 4; ++j) { const f32x4 o = v[j] * p.sc[j] + p.sh[j]; u32x2 w; w.x = cvt_pk_bf16(o[0], o[1]); w.y = cvt_pk_bf16(o[2], o[3]);
            *(u32x2*)(c.A + (size_t)row * 1024 + 4 * lane + 256 * j) = w; }
    }
}
__device__ __forceinline__ void phase_ln(const KArgs& a, const int z, const int tid, int l, int which, const int r_lo, const int r_hi, const int vb, const int nvb) {
    const int lane = tid & 63, wave = tid >> 6;
    const int gw = vb * NWAVE + wave, NGW = nvb * NWAVE;
    LnCtx c;
    c.H = (float*)((a.ws + z) + OFF_H); c.MOD = (const float*)((a.ws + z) + OFF_MOD);
    c.A = (bf16_t*)((a.ws + z) + OFF_R2); c.Y = (const bf16_t*)((a.ws + z) + OFF_R2 + SZ_ROWS_BF);
    c.final_ = (l == 3 && which == 2); c.from_in = (which == 0) || (which == 1 && l == 0);
    c.gam = which == 1 ? a.in[z + 6] + l * 1024 : a.in[z + 8] + l * 1024; c.bet = which == 1 ? a.in[z + 7] + l * 1024 : a.in[z + 9] + l * 1024;
    c.l = l; c.which = which; c.lm = which == 0 ? 0 : (which == 1 ? l : l + 1); c.shi = which == 1 ? 3 : 0; c.sci = which == 1 ? 4 : 1; c.gi = which == 1 ? 2 : 5;
    c.outp = (a.out + z); c.xin = a.in[z + 0]; c.cin = a.in[z + 2];
    const int per = (r_hi - r_lo + NGW - 1) / NGW, w_lo = r_lo + gw * per, w_hi = (w_lo + per < r_hi) ? w_lo + per : r_hi;
    LnPar p; int cur_ms = -1;
    if (which != 0) {
#pragma unroll
        for (int j = 0; j < 4; ++j) { p.gm[j] = *(const f32x4*)(c.gam + 4 * lane + 256 * j); p.bt[j] = *(const f32x4*)(c.bet + 4 * lane + 256 * j); } }
    for (int row0 = w_lo; row0 < w_hi; row0 += 2) {
        const int row1 = row0 + 1; const bool has1 = row1 < w_hi;
        f32x4 v0[4], v1[4]; u32x2 y0[4], y1[4];
        const float* s0 = ln_src(c, row0); const float* s1 = ln_src(c, has1 ? row1 : row0);
#pragma unroll
        for (int j = 0; j < 4; ++j) { v0[j] = __builtin_nontemporal_load((const f32x4*)(s0 + 4 * lane + 256 * j)); v1[j] = __builtin_nontemporal_load((const f32x4*)(s1 + 4 * lane + 256 * j)); }
        if (which != 0) {
#pragma unroll
            for (int j = 0; j < 4; ++j) { y0[j] = __builtin_nontemporal_load((const u32x2*)(c.Y + (size_t)row0 * 1024 + 4 * lane + 256 * j)); y1[j] = __builtin_nontemporal_load((const u32x2*)(c.Y + (size_t)(has1 ? row1 : row0) * 1024 + 4 * lane + 256 * j)); } }
        else {
#pragma unroll
            for (int j = 0; j < 4; ++j) { y0[j] = (u32x2){0u, 0u}; y1[j] = (u32x2){0u, 0u}; } }
        { const int ms = row0 < ML ? (row0 >> 13) : 8; if (ms != cur_ms) { ln_load_par(c, lane, ms, p); cur_ms = ms; } }
        ln_finish(c, p, lane, row0, v0, y0);
        if (has1) { const int ms = row1 < ML ? (row1 >> 13) : 8; if (ms != cur_ms) { ln_load_par(c, lane, ms, p); cur_ms = ms; }
            ln_finish(c, p, lane, row1, v1, y1); }
    }
}

__device__ __forceinline__ void phase_gmlp(const KArgs& a, const int z, const int tid, int jl, LAS unsigned char* lds, const int vb, const int nvb) {
    const int lane = tid & 63, wave = tid >> 6;
    bf16_t* Z = (bf16_t*)((a.ws + z) + OFF_Z);
    LAS bf16_t* VNT = (LAS bf16_t*)lds;
    const float* Wsp = a.in[z + 19] + (size_t)jl * 4 * 128 * 128; const float* Bsp = a.in[z + 20] + (size_t)jl * 4 * 128;
    for (int item = vb; item < 528 * 4; item += nvb) {
        const int ci = item >> 2, g = item & 3;
        const int row0 = ci < 512 ? ci * 128 : ML + (ci - 512) * 128;
        u32x4 wv[16];
#pragma unroll
        for (int rr = 0; rr < 16; ++rr) wv[rr] = *(const u32x4*)(Z + (size_t)(row0 + wave * 16 + rr) * 3072 + 1536 + 8 * lane);
        float s1[16], s2[16];
#pragma unroll
        for (int rr = 0; rr < 16; ++rr) { float x[8]; unpack8(wv[rr], x); float t1 = 0.f, t2 = 0.f;
#pragma unroll
            for (int e = 0; e < 8; ++e) { t1 += x[e]; t2 += x[e] * x[e]; }
            s1[rr] = t1; s2[rr] = t2; }
#pragma unroll
        for (int o = 1; o < 64; o <<= 1) {
#pragma unroll
            for (int rr = 0; rr < 16; ++rr) { s1[rr] += __shfl_xor(s1[rr], o); s2[rr] += __shfl_xor(s2[rr], o); } }
        if ((lane >> 4) == g) {
#pragma unroll
            for (int rr = 0; rr < 16; ++rr) { const int q = wave * 16 + rr; float x[8]; unpack8(wv[rr], x);
                const float mean = s1[rr] * (1.0f / 512.0f), var = fmaxf(s2[rr] * (1.0f / 512.0f) - mean * mean, 0.f), rstd = rsqrtf(var + 1e-6f);
#pragma unroll
                for (int e = 0; e < 8; e += 2) { const unsigned pk = cvt_pk_bf16((x[e] - mean) * rstd, (x[e + 1] - mean) * rstd);
                    VNT[(8 * (lane & 15) + e) * 136 + q] = (bf16_t)(pk & 0xffffu); VNT[(8 * (lane & 15) + e + 1) * 136 + q] = (bf16_t)(pk >> 16); } } }
        bf16x8 bfr[4];
        { const float* wp = Wsp + (size_t)(g * 128 + wave * 16 + (lane & 15)) * 128 + 8 * (lane >> 4);
#pragma unroll
          for (int ks = 0; ks < 4; ++ks) { const f32x4 w0 = *(const f32x4*)(wp + 32 * ks), w1 = *(const f32x4*)(wp + 32 * ks + 4);
              u32x4 p; p.x = cvt_pk_bf16(w0[0], w0[1]); p.y = cvt_pk_bf16(w0[2], w0[3]); p.z = cvt_pk_bf16(w1[0], w1[1]); p.w = cvt_pk_bf16(w1[2], w1[3]); bfr[ks] = __builtin_bit_cast(bf16x8, p); } }
        __syncthreads();
        const int p = wave * 16 + (lane & 15); const float bias = Bsp[g * 128 + p];
        bf16_t* urow = Z + (size_t)(row0 + p) * 3072 + 1024 + g * 128;
#pragma unroll
        for (int dt = 0; dt < 8; ++dt) {
            f32x4 acc = (f32x4){0.f, 0.f, 0.f, 0.f};
#pragma unroll
            for (int ks = 0; ks < 4; ++ks) { const bf16x8 af = *(const LAS bf16x8*)(VNT + (16 * dt + (lane & 15)) * 136 + 32 * ks + 8 * (lane >> 4));
                acc = __builtin_amdgcn_mfma_f32_16x16x32_bf16(af, bfr[ks], acc, 0, 0, 0); }
            bf16_t* up = urow + 16 * dt + 4 * (lane >> 4); const u32x2 uw = *(const u32x2*)up;
            u32x2 o; o.x = cvt_pk_bf16(bf_lo(uw.x) * (acc[0] + bias), bf_hi(uw.x) * (acc[1] + bias)); o.y = cvt_pk_bf16(bf_lo(uw.y) * (acc[2] + bias), bf_hi(uw.y) * (acc[3] + bias));
            *(u32x2*)up = o;
        }
        __syncthreads();
    }
}
__device__ __forceinline__ void phase_conv(const KArgs& a, const int z, const int tid, int jl, const int rg_lo, const int nrg, const int vb, const int nvb) {
    bf16_t* Z = (bf16_t*)((a.ws + z) + OFF_Z);
    bf16_t* XC = (bf16_t*)((unsigned char*)(a.out + z) + DO_XC);
    const float* cw = a.in[z + 14] + (size_t)jl * 4 * 1024; const float* cb = a.in[z + 15] + (size_t)jl * 1024;
    for (int idx = vb * NTHR + tid; idx < nrg * 128; idx += nvb * NTHR) {
        const int rg = rg_lo + (idx >> 7), c0 = (idx & 127) * 8, row0 = rg * 16;
        int t0, len; if (row0 < ML) { t0 = row0 & 8191; len = SEQ; } else { t0 = (row0 - ML) & 255; len = CTXL; }
        u32x4 xw[19];
#pragma unroll
        for (int i = 0; i < 19; ++i) { const int tt = t0 - 2 + i; xw[i] = (u32x4){0u, 0u, 0u, 0u};
            if (tt >= 0 && tt < len) xw[i] = *(const u32x4*)(Z + (size_t)(row0 - 2 + i) * 3072 + 2048 + c0); }
        float wk[4][8], bs[8];
#pragma unroll
        for (int k = 0; k < 4; ++k) { const f32x4 w0 = *(const f32x4*)(cw + k * 1024 + c0), w1 = *(const f32x4*)(cw + k * 1024 + c0 + 4);
            wk[k][0] = w0[0]; wk[k][1] = w0[1]; wk[k][2] = w0[2]; wk[k][3] = w0[3]; wk[k][4] = w1[0]; wk[k][5] = w1[1]; wk[k][6] = w1[2]; wk[k][7] = w1[3]; }
        { const f32x4 b0 = *(const f32x4*)(cb + c0), b1 = *(const f32x4*)(cb + c0 + 4); bs[0] = b0[0]; bs[1] = b0[1]; bs[2] = b0[2]; bs[3] = b0[3]; bs[4] = b1[0]; bs[5] = b1[1]; bs[6] = b1[2]; bs[7] = b1[3]; }
#pragma unroll
        for (int r = 0; r < 16; ++r) {
            float o[8];
#pragma unroll
            for (int e = 0; e < 8; ++e) o[e] = bs[e];
#pragma unroll
            for (int k = 0; k < 4; ++k) { const u32x4 w = xw[r + k];
                o[0] += bf_lo(w.x) * wk[k][0]; o[1] += bf_hi(w.x) * wk[k][1]; o[2] += bf_lo(w.y) * wk[k][2]; o[3] += bf_hi(w.y) * wk[k][3];
                o[4] += bf_lo(w.z) * wk[k][4]; o[5] += bf_hi(w.z) * wk[k][5]; o[6] += bf_lo(w.w) * wk[k][6]; o[7] += bf_hi(w.w) * wk[k][7]; }
            u32x4 ow; ow.x = cvt_pk_bf16(o[0], o[1]); ow.y = cvt_pk_bf16(o[2], o[3]); ow.z = cvt_pk_bf16(o[4], o[5]); ow.w = cvt_pk_bf16(o[6], o[7]);
            *(u32x4*)(XC + (size_t)(row0 + r) * 1024 + c0) = ow;
        }
    }
}

__device__ __forceinline__ int scan_row_p(int d, int b, int p) {
    if (p < 256) return ML + b * 256 + (d == 0 ? p : 255 - p);
    const int t = p - 256; return b * SEQ + (d == 0 ? t : 8191 - t);
}
template <int PASS, int DIR, int NB>
__device__ __forceinline__ void scan_body(const KArgs& a, const int z, const int tid) {
    const bf16_t* LA = (const bf16_t*)((a.ws + z) + OFF_R2); const bf16_t* BBp = (const bf16_t*)((a.ws + z) + OFF_R2 + SZ_ROWS_BF);
    bf16_t* Z = (bf16_t*)((a.ws + z) + OFF_Z);
    float* SUMM = (float*)((unsigned char*)(a.out + z) + DO_SUMM); const float* CAR = (const float*)((unsigned char*)(a.out + z) + DO_CARRY);
    const int sub = tid >> 7, ch = (tid & 127) * 8;
    for (int blk = blockIdx.x; blk < 512; blk += gridDim.x) {
        const int item = blk * 4 + sub, b = item >> 8, sc = item & 255, p0 = sc * 33;
        float h[8], P[8];
#pragma unroll
        for (int e = 0; e < 8; ++e) { h[e] = 0.f; P[e] = 0.f; }
        if (PASS == 2) { const f32x4 c0 = *(const f32x4*)(CAR + (size_t)item * 1024 + ch), c1 = *(const f32x4*)(CAR + (size_t)item * 1024 + ch + 4);
            h[0] = c0[0]; h[1] = c0[1]; h[2] = c0[2]; h[3] = c0[3]; h[4] = c1[0]; h[5] = c1[1]; h[6] = c1[2]; h[7] = c1[3]; }
        for (int i0 = 0; i0 < 33; i0 += NB) {
            u32x4 lw[NB], bw[NB], fw[NB], gw[NB]; int rows[NB];
#pragma unroll
            for (int i = 0; i < NB; ++i) { rows[i] = scan_row_p(DIR, b, p0 + i0 + i);
                if (PASS == 2) { lw[i] = __builtin_nontemporal_load((const u32x4*)(LA + (size_t)rows[i] * 1024 + ch)); bw[i] = __builtin_nontemporal_load((const u32x4*)(BBp + (size_t)rows[i] * 1024 + ch)); }
                else { lw[i] = *(const u32x4*)(LA + (size_t)rows[i] * 1024 + ch); bw[i] = *(const u32x4*)(BBp + (size_t)rows[i] * 1024 + ch); }
                if (PASS == 2 && DIR == 1) { fw[i] = *(const u32x4*)(Z + (size_t)rows[i] * 3072 + 2048 + ch); gw[i] = *(const u32x4*)(Z + (size_t)rows[i] * 3072 + ch); } }
#pragma unroll
            for (int i = 0; i < NB; ++i) { float l[8], bb[8]; unpack8(lw[i], l); unpack8(bw[i], bb);
#pragma unroll
                for (int e = 0; e < 8; ++e) { h[e] = __builtin_amdgcn_exp2f(l[e] * LOG2E) * h[e] + bb[e]; if (PASS == 1) P[e] += l[e]; }
                if (PASS == 2 && DIR == 0) { u32x4 o; o.x = cvt_pk_bf16(h[0], h[1]); o.y = cvt_pk_bf16(h[2], h[3]); o.z = cvt_pk_bf16(h[4], h[5]); o.w = cvt_pk_bf16(h[6], h[7]);
                    *(u32x4*)(Z + (size_t)rows[i] * 3072 + 2048 + ch) = o; }
                if (PASS == 2 && DIR == 1) { float f[8], g[8]; unpack8(fw[i], f); unpack8(gw[i], g);
                    u32x4 o; o.x = cvt_pk_bf16(g[0] * (f[0] + h[0]), g[1] * (f[1] + h[1])); o.y = cvt_pk_bf16(g[2] * (f[2] + h[2]), g[3] * (f[3] + h[3]));
                    o.z = cvt_pk_bf16(g[4] * (f[4] + h[4]), g[5] * (f[5] + h[5])); o.w = cvt_pk_bf16(g[6] * (f[6] + h[6]), g[7] * (f[7] + h[7]));
                    *(u32x4*)(Z + (size_t)rows[i] * 3072 + ch) = o; }
            }
        }
        if (PASS == 1) { float* sp = SUMM + ((size_t)item * 1024 + ch) * 2;
#pragma unroll
            for (int e = 0; e < 8; e += 2) *(f32x4*)(sp + 2 * e) = (f32x4){P[e], h[e], P[e + 1], h[e + 1]}; }
    }
}
__device__ __forceinline__ void phase_scan(const KArgs& a, const int z, const int tid, int d, int pass) {
    if (pass == 1) { if (d == 0) scan_body<1, 0, 11>(a, z, tid); else scan_body<1, 1, 11>(a, z, tid); }
    else { if (d == 0) scan_body<2, 0, 11>(a, z, tid); else scan_body<2, 1, 3>(a, z, tid); }
}
__device__ __forceinline__ void phase_carry(const KArgs& a, const int z, const int tid, LAS unsigned char* lds) {
    const float* SUMM = (const float*)((unsigned char*)(a.out + z) + DO_SUMM); float* CAR = (float*)((unsigned char*)(a.out + z) + DO_CARRY);
    LAS float* segP = (LAS float*)lds; LAS float* segS = (LAS float*)(lds + 2048);
    const int seg = tid >> 6, cl = tid & 63;
    for (int blk = blockIdx.x; blk < 128; blk += gridDim.x) {
        const int b = blk >> 4, ch = (blk & 15) * 64 + cl; const size_t o0 = (size_t)(b * 256 + seg * 32) * 1024 + ch;
        f32x2 s[32];
#pragma unroll
        for (int k = 0; k < 32; ++k) s[k] = *(const f32x2*)(SUMM + (o0 + (size_t)k * 1024) * 2);
        float ps = 0.f, sa = 0.f;
#pragma unroll
        for (int k = 0; k < 32; ++k) { sa = __builtin_amdgcn_exp2f(s[k].x * LOG2E) * sa + s[k].y; ps += s[k].x; }
        segP[seg * 64 + cl] = ps; segS[seg * 64 + cl] = sa;
        __syncthreads();
        float c = 0.f;
        for (int j = 0; j < seg; ++j) c = __builtin_amdgcn_exp2f(segP[j * 64 + cl] * LOG2E) * c + segS[j * 64 + cl];
#pragma unroll
        for (int k = 0; k < 32; ++k) { CAR[o0 + (size_t)k * 1024] = c; c = __builtin_amdgcn_exp2f(s[k].x * LOG2E) * c + s[k].y; }
        __syncthreads();
    }
}

__device__ __forceinline__ void phase_qkpost(const KArgs& a, const int z, const int tid, int jl, const int r_lo, const int nrows, const int vb, const int nvb) {
    const bf16_t* Zq = (const bf16_t*)((a.ws + z) + OFF_Z + ZO_QKV); bf16_t* KK = (bf16_t*)((a.ws + z) + OFF_Z + ZO_KK); bf16_t* VV = (bf16_t*)((unsigned char*)(a.out + z) + DO_VV);
    const float* kn = a.in[z + 24] + jl * 64;
    for (int idx = vb * NTHR + tid; idx < 8 * nrows; idx += nvb * NTHR) {
        const int s8 = idx / nrows, row = r_lo + (idx - s8 * nrows), slot = 16 + s8;
        const bool lat = row < ML; const int t = lat ? (row & 8191) : ((row - ML) & 255), b = lat ? (row >> 13) : ((row - ML) >> 8);
        const int kvrow = lat ? 256 + t : t, type = slot >= 20, hh = slot & 1;
        const bf16_t* src = Zq + (size_t)row * 1536 + slot * 64;
        const size_t dsto = ((size_t)((type * 8 + b) * 2 + hh) * KVR + kvrow) * 64;
        u32x4 w[8];
#pragma unroll
        for (int c = 0; c < 8; ++c) w[c] = *(const u32x4*)(src + 8 * c);
        if (slot & 2) {
#pragma unroll
            for (int c = 0; c < 8; ++c) *(u32x4*)(VV + dsto + 8 * c) = w[c];
            continue; }
        float v[64];
#pragma unroll
        for (int c = 0; c < 8; ++c) { v[8 * c] = bf_lo(w[c].x); v[8 * c + 1] = bf_hi(w[c].x); v[8 * c + 2] = bf_lo(w[c].y); v[8 * c + 3] = bf_hi(w[c].y); v[8 * c + 4] = bf_lo(w[c].z); v[8 * c + 5] = bf_hi(w[c].z); v[8 * c + 6] = bf_lo(w[c].w); v[8 * c + 7] = bf_hi(w[c].w); }
        if (type == 0) { float ss = 0.f;
#pragma unroll
            for (int dd = 0; dd < 64; ++dd) ss += v[dd] * v[dd];
            const float r = rsqrtf(ss * (1.0f / 64.0f) + 1e-6f);
#pragma unroll
            for (int dd = 0; dd < 64; ++dd) v[dd] = v[dd] * r * kn[dd]; }
        if (lat) { const float pr = (float)(t >> 6), pc = (float)(t & 63);
#pragma unroll
            for (int f = 0; f < 16; ++f) { const float invf = exp2f(-(float)f * 0.8304820237218406f) * 0.15915494309189535f;
                { const float rev = pr * invf, cs = __builtin_amdgcn_cosf(rev), sn = __builtin_amdgcn_sinf(rev); const float x1 = v[f], x2 = v[16 + f]; v[f] = x1 * cs - x2 * sn; v[16 + f] = x2 * cs + x1 * sn; }
                { const float rev = pc * invf, cs = __builtin_amdgcn_cosf(rev), sn = __builtin_amdgcn_sinf(rev); const float x1 = v[32 + f], x2 = v[48 + f]; v[32 + f] = x1 * cs - x2 * sn; v[48 + f] = x2 * cs + x1 * sn; } } }
#pragma unroll
        for (int c = 0; c < 8; ++c) { u32x4 o; o.x = cvt_pk_bf16(v[8 * c], v[8 * c + 1]); o.y = cvt_pk_bf16(v[8 * c + 2], v[8 * c + 3]); o.z = cvt_pk_bf16(v[8 * c + 4], v[8 * c + 5]); o.w = cvt_pk_bf16(v[8 * c + 6], v[8 * c + 7]);
            *(u32x4*)(KK + dsto + 8 * c) = o; }
    }
}

namespace attn_body {
using bf16=__hip_bfloat16;
using bf16x8=__attribute__((ext_vector_type(8)))short;
using s16x4=__attribute__((ext_vector_type(4)))short;
using f32x16=__attribute__((ext_vector_type(16)))float;
using u32x4=__attribute__((ext_vector_type(4)))unsigned;
constexpr int D=64;
constexpr int NW=8,QBLK=32,QB=QBLK*NW,KVBLK=64;
constexpr int ATTN_UNIT_ROWS=QB;
__device__ __forceinline__ int crow(int r,int hi){return (r&3)+8*(r>>2)+4*hi;}
#define SBAR() __builtin_amdgcn_sched_barrier(0)
constexpr int NSLOT=3, SLOTB=8192;
constexpr int LDS_K=0, LDS_V=NSLOT*SLOTB, LDS_WS=2*NSLOT*SLOTB, LDS_OST=LDS_WS+NW*64*4, LDS_BYTES=LDS_OST+NW*4096;
constexpr float C2=0.125f*1.4426950408889634f;
__device__ __forceinline__ void glds16(const void*gsrc,unsigned lds_dst){unsigned keep;
  asm volatile("s_mov_b32 %0, m0\n\ts_mov_b32 m0, %2\n\ts_nop 0\n\tglobal_load_lds_dwordx4 %1, off\n\ts_mov_b32 m0, %0":"=&s"(keep):"v"(gsrc),"s"(lds_dst):"memory");}
__device__ __forceinline__ float max3f(float a,float b,float c){float r;asm("v_max3_f32 %0, %1, %2, %3":"=v"(r):"v"(a),"v"(b),"v"(c));return r;}
__device__ __forceinline__ float max2f(float a,float b){float r;asm("v_max_f32_e32 %0, %1, %2":"=v"(r):"v"(a),"v"(b));return r;}
__device__ __forceinline__ float fadd_s(float a,float b){float r;asm("v_add_f32_e32 %0, %1, %2":"=v"(r):"v"(a),"v"(b));return r;}
__device__ __forceinline__ float fsub_s(float a,float b){float r;asm("v_sub_f32_e32 %0, %1, %2":"=v"(r):"v"(a),"v"(b));return r;}
typedef float f32x2_t __attribute__((ext_vector_type(2))); typedef __bf16 bf16x2_t __attribute__((ext_vector_type(2)));
__device__ __forceinline__ unsigned cvtpk_s(float lo,float hi){f32x2_t v={lo,hi};bf16x2_t b=__builtin_convertvector(v,bf16x2_t);return __builtin_bit_cast(unsigned,b);}
#define WAIT_BAR(N) asm volatile("s_waitcnt vmcnt(" #N ") lgkmcnt(0)\n\ts_barrier":::"memory")

__device__ __forceinline__ void qkt(f32x16&p0,f32x16&p1,const char*Kslot,const bf16x8*qr,const f32x16&negm,int r32,int hi){
  const char*kb=Kslot+hi*1024+r32*16;
  #pragma unroll
  for(int d0=0;d0<4;++d0){
    const bf16x8 b0=*reinterpret_cast<const bf16x8*>(kb+d0*2048);
    const bf16x8 b1=*reinterpret_cast<const bf16x8*>(kb+d0*2048+512);
    if(d0==0){p0=__builtin_amdgcn_mfma_f32_32x32x16_bf16(b0,qr[0],negm,0,0,0);p1=__builtin_amdgcn_mfma_f32_32x32x16_bf16(b1,qr[0],negm,0,0,0);}
    else{p0=__builtin_amdgcn_mfma_f32_32x32x16_bf16(b0,qr[d0],p0,0,0,0);p1=__builtin_amdgcn_mfma_f32_32x32x16_bf16(b1,qr[d0],p1,0,0,0);}}
}
typedef __attribute__((address_space(3))) const char* lds_cptr;
typedef short v4i16_t __attribute__((ext_vector_type(4)));
__device__ __forceinline__ void kload8(bf16x8*kf,lds_cptr kp){
  kf[0]=*(const __attribute__((address_space(3))) bf16x8*)(kp);      kf[1]=*(const __attribute__((address_space(3))) bf16x8*)(kp+512);
  kf[2]=*(const __attribute__((address_space(3))) bf16x8*)(kp+2048); kf[3]=*(const __attribute__((address_space(3))) bf16x8*)(kp+2560);
  kf[4]=*(const __attribute__((address_space(3))) bf16x8*)(kp+4096); kf[5]=*(const __attribute__((address_space(3))) bf16x8*)(kp+4608);
  kf[6]=*(const __attribute__((address_space(3))) bf16x8*)(kp+6144); kf[7]=*(const __attribute__((address_space(3))) bf16x8*)(kp+6656);
}
__device__ __forceinline__ void kload2(bf16x8*kf,lds_cptr kp,int j){ kf[2*j]=*(const __attribute__((address_space(3))) bf16x8*)(kp+j*2048); kf[2*j+1]=*(const __attribute__((address_space(3))) bf16x8*)(kp+j*2048+512); }
__device__ __forceinline__ s16x4 vtr(lds_cptr p){ return __builtin_bit_cast(s16x4,__builtin_amdgcn_ds_read_tr16_b64_v4i16((__attribute__((address_space(3))) v4i16_t*)p)); }
__device__ __forceinline__ float rowmax(const f32x16&p0,const f32x16&p1){
  float a=max3f(p0[0],p0[1],p1[0]),b=max3f(p0[2],p0[3],p1[1]);a=max3f(a,p1[2],p1[3]);
  #pragma unroll
  for(int r=4;r<16;r+=4){a=max3f(a,p0[r],p0[r+1]);b=max3f(b,p0[r+2],p0[r+3]);a=max3f(a,p1[r],p1[r+1]);b=max3f(b,p1[r+2],p1[r+3]);}
  const float m=max2f(a,b);
  auto rr=__builtin_amdgcn_permlane32_swap(__float_as_uint(m),__float_as_uint(m),false,false);
  return max2f(__uint_as_float(rr[0]),__uint_as_float(rr[1]));
}
__device__ __forceinline__ void pv(f32x16*o,int vb,bf16x8 pa0,bf16x8 pa1,bf16x8 pa2,bf16x8 pa3){
  #pragma unroll
  for(int d0=0;d0<2;++d0){s16x4 lo[4],hi[4];
    #pragma unroll
    for(int ks=0;ks<4;++ks){
      asm volatile("ds_read_b64_tr_b16 %0,%1 offset:%c2":"=&v"(lo[ks]):"v"(vb),"i"(d0*4096+ks*1024):"memory");
      asm volatile("ds_read_b64_tr_b16 %0,%1 offset:%c2":"=&v"(hi[ks]):"v"(vb),"i"(d0*4096+ks*1024+512):"memory");}
    asm volatile("s_waitcnt lgkmcnt(0)":::"memory");SBAR();
    #define PK(k) (bf16x8){lo[k][0],lo[k][1],lo[k][2],lo[k][3],hi[k][0],hi[k][1],hi[k][2],hi[k][3]}
    o[d0]=__builtin_amdgcn_mfma_f32_32x32x16_bf16(pa0,PK(0),o[d0],0,0,0);
    o[d0]=__builtin_amdgcn_mfma_f32_32x32x16_bf16(pa1,PK(1),o[d0],0,0,0);
    o[d0]=__builtin_amdgcn_mfma_f32_32x32x16_bf16(pa2,PK(2),o[d0],0,0,0);
    o[d0]=__builtin_amdgcn_mfma_f32_32x32x16_bf16(pa3,PK(3),o[d0],0,0,0);
    #undef PK
  }
}

#ifndef ATTN_STORE16
#define ATTN_STORE16(p,v) (*(u32x4*)(p)=(v))
#endif
__device__ __forceinline__ void wmask(f32x16&p0,f32x16&p1,int t,int wid,int r32,int hi,int q0){
  const float NEG=-INFINITY; const int ks=q0-128+64*(t-4);
  if(ks<0||ks>=8192){
    #pragma unroll
    for(int r=0;r<16;++r){p0[r]=NEG;p1[r]=NEG;}
    return; }
  const int lo=64*(t-4)-128-(wid*32+31), hi_=64*(t-4)-128+63-wid*32;
  if(lo>=-128&&hi_<=128)return;
  const int base=64*(t-4)-128+4*hi-(wid*32+r32);
  #pragma unroll
  for(int r=0;r<16;++r){const int d0=base+(r&3)+8*(r>>2), d1=d0+32; if(d0>128||d0<-128)p0[r]=NEG; if(d1>128||d1<-128)p1[r]=NEG;}
}
template<int THRL,bool WIN> __device__ __forceinline__ void attn_unit(const bf16*Qb,int PQ,const bf16*__restrict__ Kh,int PK,const bf16*__restrict__ Vh,int PV,bf16*Ob,int PO,const int NT,char*shm,const int tid,const int q0,const float sink2,const float*qg,const int tpos0){
  const int lane=tid&63,r32=lane&31,hi=lane>>5; const int wid=__builtin_amdgcn_readfirstlane(tid>>6);
  const bf16*Qw=Qb+(long)(wid*QBLK)*PQ;
  const unsigned lds0=(unsigned)(uintptr_t)shm;
  float*wsf=(float*)(shm+LDS_WS)+wid*64;
  const bf16*ksrc=Kh+(long)lane*PK+wid*8;
  const bf16*vsrc=Vh+(long)(16*(wid&3)+(lane>>2))*PV+(wid>>2)*32+(lane&3)*8;
  const unsigned kdst=lds0+LDS_K+wid*1024, vdst=lds0+LDS_V+wid*1024;
  #define KOFF(t) ((WIN&&(t)>=4)?min(max(64*(t)+q0-128,0),8448-64):64*(t))
  #define DMA_K(t,slot) glds16(ksrc+(long)KOFF(t)*PK,(unsigned)__builtin_amdgcn_readfirstlane(kdst+(slot)))
  #define DMA_V(t,slot) glds16(vsrc+(long)KOFF(t)*PV,(unsigned)__builtin_amdgcn_readfirstlane(vdst+(slot)))
  const int vb0=(int)(lds0+LDS_V)+((lane>>4)&1)*32+(lane&3)*8+(4*hi+((lane&15)>>2))*64;
  const char*Kbase=shm+LDS_K; bf16x8 kf[8];
  const lds_cptr shm3=(lds_cptr)shm; const lds_cptr kp0=shm3+LDS_K+hi*1024+r32*16; const lds_cptr vp0=shm3+LDS_V+((lane>>4)&1)*32+(lane&3)*8+(4*hi+((lane&15)>>2))*64;
  DMA_K(0,0);DMA_V(0,0);DMA_K(1,SLOTB);
  bf16x8 qr[4];
  #pragma unroll
  for(int d0=0;d0<4;++d0)qr[d0]=*reinterpret_cast<const bf16x8*>(&Qw[(long)r32*PQ+d0*16+hi*8]);
  {
    float x[32];
    #pragma unroll
    for(int d0=0;d0<4;++d0){
      #pragma unroll
      for(int e=0;e<8;++e)x[8*d0+e]=__uint_as_float(((unsigned)(unsigned short)qr[d0][e])<<16);}
    if(qg){float ss=0.f;
      #pragma unroll
      for(int i=0;i<32;++i)ss+=x[i]*x[i];
      ss+=__shfl_xor(ss,32);
      const float rn=rsqrtf(ss*(1.0f/64.0f)+1e-6f);
      #pragma unroll
      for(int d0=0;d0<4;++d0){
        #pragma unroll
        for(int e=0;e<8;++e)x[8*d0+e]*=rn*qg[16*d0+8*hi+e];}}
    if(tpos0>=0){const int tq=tpos0+wid*QBLK+r32; const float pr=(float)(tq>>6),pc=(float)(tq&63);
      #pragma unroll
      for(int e=0;e<8;++e){const float invf=__builtin_amdgcn_exp2f(-(float)(8*hi+e)*0.8304820237218406f)*0.15915494309189535f;
        {const float rev=pr*invf,cs=__builtin_amdgcn_cosf(rev),sn=__builtin_amdgcn_sinf(rev);const float x1=x[e],x2=x[8+e];x[e]=x1*cs-x2*sn;x[8+e]=x2*cs+x1*sn;}
        {const float rev=pc*invf,cs=__builtin_amdgcn_cosf(rev),sn=__builtin_amdgcn_sinf(rev);const float x1=x[16+e],x2=x[24+e];x[16+e]=x1*cs-x2*sn;x[24+e]=x2*cs+x1*sn;}}}
    #pragma unroll
    for(int d0=0;d0<4;++d0){u32x4 w;w.x=cvtpk_s(x[8*d0]*C2,x[8*d0+1]*C2);w.y=cvtpk_s(x[8*d0+2]*C2,x[8*d0+3]*C2);w.z=cvtpk_s(x[8*d0+4]*C2,x[8*d0+5]*C2);w.w=cvtpk_s(x[8*d0+6]*C2,x[8*d0+7]*C2);qr[d0]=__builtin_bit_cast(bf16x8,w);}
  }
  float mhat=0.f,l_reg=0.f;f32x16 o[2];o[0]=f32x16{};o[1]=f32x16{};f32x16 negm=f32x16{}; if constexpr(!WIN){asm volatile("":"+v"(negm));}
  #define CMASK(P0,P1,t) do{ if(WIN&&(t)>=4) wmask(P0,P1,(t),wid,r32,hi,q0); }while(0)
  bool resc=false;
  #define START(P0,P1) do{ const float rm=rowmax(P0,P1); resc=false; \
    { const float dl=rm; mhat=fadd_s(mhat,dl); \
      _Pragma("unroll") for(int r=0;r<16;++r){P0[r]=fsub_s(P0[r],dl);P1[r]=fsub_s(P1[r],dl);} \
      if constexpr(!WIN){ _Pragma("unroll") for(int r=0;r<16;++r)negm[r]=-mhat; asm volatile("":"+v"(negm)); } } \
    _Pragma("unroll") for(int r=0;r<16;++r)P0[r]=__builtin_amdgcn_exp2f(P0[r]); }while(0)
  #define RESC() do{ if(resc){ asm volatile("s_waitcnt lgkmcnt(0)":::"memory"); \
      _Pragma("unroll") for(int d_=0;d_<2;++d_) _Pragma("unroll") for(int r=0;r<16;++r)o[d_][r]*=wsf[crow(r,hi)]; } }while(0)
  f32x16 pA0,pA1,pB0,pB1;
  int sl_prev=0,sl_cur=0,sl_next=SLOTB;
  #define ROT() do{sl_prev=sl_cur;sl_cur=sl_next;sl_next=(sl_next==(NSLOT-1)*SLOTB)?0:sl_next+SLOTB;}while(0)
  DMA_K(2,2*SLOTB);
  WAIT_BAR(3);
  qkt(pA0,pA1,Kbase,qr,(WIN?f32x16{}:negm),r32,hi);asm volatile("s_nop 15\n\ts_nop 7":"+v"(pA0),"+v"(pA1));CMASK(pA0,pA1,0);
  START(pA0,pA1);
  _Pragma("unroll") for(int r=0;r<16;++r)pA1[r]=__builtin_amdgcn_exp2f(pA1[r]);
  WAIT_BAR(0);
  DMA_K(3,0);DMA_V(1,SLOTB);
  ROT();
  kload8(kf,kp0+sl_cur);
  WAIT_BAR(2);
  s16x4 vlo[8],vhi[8]; u32x4 pw0,pw1,pw2,pw3;
  #define PKW(P,B) cvtpk_s(P[B],P[B+1])
  #define PAF(k) __builtin_bit_cast(bf16x8,pw##k)
  #define VFR(i) (bf16x8){vlo[i][0],vlo[i][1],vlo[i][2],vlo[i][3],vhi[i][0],vhi[i][1],vhi[i][2],vhi[i][3]}
  #define PIN(x) asm volatile("":"+v"(x))
  #define MX3(a,b,c) __builtin_fmaxf(__builtin_fmaxf((a),(b)),(c))
  #define GAPA(MF,A0,A1,A2,A3,W0,W1,PW) do{ MF; sacc+=A0; sacc+=A1; sacc+=A2; sacc+=A3; PIN(sacc); W0; W1; PIN(PW); SBAR(); }while(0)
  #define EX(v) __builtin_amdgcn_exp2f(v)
  #define GAPB(MF,X,B) do{ MF; X[B]=EX(X[B]); X[B+1]=EX(X[B+1]); X[B+2]=EX(X[B+2]); X[B+3]=EX(X[B+3]); PIN(X); SBAR(); }while(0)
  #define VRD(i) do{ vlo[i]=vtr(vp_+(((i)>>2)*4096+((i)&3)*1024)); vhi[i]=vtr(vp_+(((i)>>2)*4096+((i)&3)*1024+512)); }while(0)
  #define KRD(G,j) do{ if(G){ kload2(kf,kp0+sl_next,j); SBAR(); } }while(0)
  #define STEP(C0,C1,P0,P1,t,GK,GV,GL) do{ SBAR(); \
    const lds_cptr vp_=vp0+sl_prev; \
    VRD(0); SBAR(); float sacc=(P0[0]+P0[1]); \
    GAPA(C0=__builtin_amdgcn_mfma_f32_32x32x16_bf16(kf[0],qr[0],(WIN?f32x16{}:negm),0,0,0), P0[2],P0[3],P0[4],P0[5],     pw0[0]=PKW(P0,0), pw0[1]=PKW(P0,2), pw0); \
    VRD(4); SBAR(); GAPA(C1=__builtin_amdgcn_mfma_f32_32x32x16_bf16(kf[1],qr[0],(WIN?f32x16{}:negm),0,0,0), P0[6],P0[7],P0[8],P0[9],     pw0[2]=PKW(P0,4), pw0[3]=PKW(P0,6), pw0); \
    VRD(1); SBAR(); GAPA(C0=__builtin_amdgcn_mfma_f32_32x32x16_bf16(kf[2],qr[1],C0,0,0,0),   P0[10],P0[11],P0[12],P0[13], pw1[0]=PKW(P0,8), pw1[1]=PKW(P0,10), pw1); \
    VRD(5); SBAR(); GAPA(C1=__builtin_amdgcn_mfma_f32_32x32x16_bf16(kf[3],qr[1],C1,0,0,0),   P0[14],P0[15],P1[0],P1[1],   pw1[2]=PKW(P0,12),pw1[3]=PKW(P0,14), pw1); \
    VRD(2); SBAR(); GAPA(C0=__builtin_amdgcn_mfma_f32_32x32x16_bf16(kf[4],qr[2],C0,0,0,0),   P1[2],P1[3],P1[4],P1[5],     pw2[0]=PKW(P1,0), pw2[1]=PKW(P1,2), pw2); \
    VRD(6); SBAR(); GAPA(C1=__builtin_amdgcn_mfma_f32_32x32x16_bf16(kf[5],qr[2],C1,0,0,0),   P1[6],P1[7],P1[8],P1[9],     pw2[2]=PKW(P1,4), pw2[3]=PKW(P1,6), pw2); \
    VRD(3); SBAR(); GAPA(C0=__builtin_amdgcn_mfma_f32_32x32x16_bf16(kf[6],qr[3],C0,0,0,0),   P1[10],P1[11],P1[12],P1[13], pw3[0]=PKW(P1,8), pw3[1]=PKW(P1,10), pw3); \
    VRD(7); SBAR(); GAPA(C1=__builtin_amdgcn_mfma_f32_32x32x16_bf16(kf[7],qr[3],C1,0,0,0),   P1[14],P1[15],0.f,0.f,       pw3[2]=PKW(P1,12),pw3[3]=PKW(P1,14), pw3); \
    l_reg+=sacc; \
    if(GK){DMA_K((t)+3,sl_cur);} if(GV){DMA_V((t)+1,sl_next);} \
    if constexpr(WIN){ _Pragma("unroll") for(int r=0;r<16;++r){C0[r]-=mhat;C1[r]-=mhat;} } \
    CMASK(C0,C1,t); \
    { float a=MX3(C0[0],C0[1],C1[0]),b=MX3(C0[2],C0[3],C1[1]); a=MX3(a,C1[2],C1[3]); \
      _Pragma("unroll") for(int r=4;r<16;r+=4){a=MX3(a,C0[r],C0[r+1]);b=MX3(b,C0[r+2],C0[r+3]);a=MX3(a,C1[r],C1[r+1]);b=MX3(b,C1[r+2],C1[r+3]);} \
      float rm=__builtin_fmaxf(a,b); { auto rr=__builtin_amdgcn_permlane32_swap(__float_as_uint(rm),__float_as_uint(rm),false,false); rm=__builtin_fmaxf(__uint_as_float(rr[0]),__uint_as_float(rr[1])); } \
      resc=false; \
      if(__builtin_expect(__any(rm>(float)THRL),0)){ const float dl=__builtin_fmaxf(rm,0.f); mhat+=dl; \
        _Pragma("unroll") for(int r=0;r<16;++r){C0[r]-=dl;C1[r]-=dl;} \
        if constexpr(!WIN){ _Pragma("unroll") for(int r=0;r<16;++r)negm[r]=-mhat; asm volatile("":"+v"(negm)); } \
        const float f=__builtin_amdgcn_exp2f(-dl); l_reg*=f; if(hi==0)wsf[r32]=f; resc=true; } } \
    SBAR(); \
    GAPB(o[0]=__builtin_amdgcn_mfma_f32_32x32x16_bf16(PAF(0),VFR(0),o[0],0,0,0), C0,0); \
    GAPB(o[1]=__builtin_amdgcn_mfma_f32_32x32x16_bf16(PAF(0),VFR(4),o[1],0,0,0), C0,4); \
    KRD(GL,0); GAPB(o[0]=__builtin_amdgcn_mfma_f32_32x32x16_bf16(PAF(1),VFR(1),o[0],0,0,0), C0,8); \
    KRD(GL,1); GAPB(o[1]=__builtin_amdgcn_mfma_f32_32x32x16_bf16(PAF(1),VFR(5),o[1],0,0,0), C0,12); \
    KRD(GL,2); GAPB(o[0]=__builtin_amdgcn_mfma_f32_32x32x16_bf16(PAF(2),VFR(2),o[0],0,0,0), C1,0); \
    KRD(GL,3); GAPB(o[1]=__builtin_amdgcn_mfma_f32_32x32x16_bf16(PAF(2),VFR(6),o[1],0,0,0), C1,4); \
    GAPB(o[0]=__builtin_amdgcn_mfma_f32_32x32x16_bf16(PAF(3),VFR(3),o[0],0,0,0), C1,8); \
    GAPB(o[1]=__builtin_amdgcn_mfma_f32_32x32x16_bf16(PAF(3),VFR(7),o[1],0,0,0), C1,12); \
    }while(0)
  int t=1;
  #undef CMASK
  #define CMASK(P0,P1,t) do{ if(WIN&&(t)>=4) wmask(P0,P1,(t),wid,r32,hi,q0); }while(0)
  for(;t+5<NT;t+=2){
    STEP(pB0,pB1,pA0,pA1,t,true,true,true);     WAIT_BAR(2); RESC(); ROT();
    STEP(pA0,pA1,pB0,pB1,t+1,true,true,true);   WAIT_BAR(2); RESC(); ROT();
  }
  #undef CMASK
  #define CMASK(P0,P1,t) do{ if(WIN&&(t)>=4) wmask(P0,P1,(t),wid,r32,hi,q0); }while(0)
  #define ENDW(tt) do{ if((tt)+3<NT){WAIT_BAR(2);} else if((tt)+2<NT){WAIT_BAR(1);} else {WAIT_BAR(0);} }while(0)
  for(;t+1<NT;t+=2){
    STEP(pB0,pB1,pA0,pA1,t,(t+3<NT),(t+1<NT),(t+1<NT));       ENDW(t);   RESC(); ROT();
    STEP(pA0,pA1,pB0,pB1,t+1,(t+4<NT),(t+2<NT),(t+2<NT));     ENDW(t+1); RESC(); ROT();
  }
  STEP(pB0,pB1,pA0,pA1,NT-1,false,false,false); RESC();
  { float sacc=pB0[0]+pB0[1]; _Pragma("unroll") for(int r=2;r<16;++r)sacc+=pB0[r]; _Pragma("unroll") for(int r=0;r<16;++r)sacc+=pB1[r]; l_reg+=sacc;
    pw0=(u32x4){PKW(pB0,0),PKW(pB0,2),PKW(pB0,4),PKW(pB0,6)};pw1=(u32x4){PKW(pB0,8),PKW(pB0,10),PKW(pB0,12),PKW(pB0,14)};pw2=(u32x4){PKW(pB1,0),PKW(pB1,2),PKW(pB1,4),PKW(pB1,6)};pw3=(u32x4){PKW(pB1,8),PKW(pB1,10),PKW(pB1,12),PKW(pB1,14)};
    SBAR(); pv(o,vb0+sl_cur,PAF(0),PAF(1),PAF(2),PAF(3)); }
  #undef PKW
  #undef PAF
  #undef VFR
  #undef PIN
  #undef MX3
  #undef GAPA
  #undef GAPB
  #undef EX
  #undef VRD
  #undef KRD
  #undef STEP
  #undef ENDW
  {auto rr=__builtin_amdgcn_permlane32_swap(__float_as_uint(l_reg),__float_as_uint(l_reg),false,false);l_reg=__uint_as_float(rr[0])+__uint_as_float(rr[1]);}
  if(WIN)l_reg+=__builtin_amdgcn_exp2f(__uint_as_float(__builtin_amdgcn_readfirstlane(__float_as_uint(sink2)))-mhat);
  if(hi==0)wsf[32+r32]=l_reg;asm volatile("s_waitcnt lgkmcnt(0)":::"memory");
  float rli[16];
  #pragma unroll
  for(int r=0;r<16;++r)rli[r]=__builtin_amdgcn_rcpf(wsf[32+crow(r,hi)]);
  bf16*Ow=Ob+(long)(wid*QBLK)*PO;
  { bf16*stg=(bf16*)(shm+LDS_OST)+wid*2048;
    #pragma unroll
    for(int r=0;r<16;++r){const int orow=crow(r,hi);
      #pragma unroll
      for(int d0=0;d0<2;++d0)stg[orow*64+d0*32+r32]=__float2bfloat16(o[d0][r]*rli[r]);}
    asm volatile("s_waitcnt lgkmcnt(0)":::"memory");
    #pragma unroll
    for(int i=0;i<4;++i){const int row=i*8+(lane>>3),ch=lane&7; const u32x4 v=*(const u32x4*)(stg+row*64+ch*8); ATTN_STORE16(Ow+(long)row*PO+ch*8,v);} }
  asm volatile("s_waitcnt lgkmcnt(0)\n\ts_barrier":::"memory");
  #undef DMA_K
  #undef KOFF
  #undef DMA_V
  #undef CMASK
  #undef START
  #undef RESC
  #undef ROT
}
constexpr int ATTN_LDS_BYTES=LDS_BYTES;
#undef SBAR
#undef WAIT_BAR
}
__device__ __forceinline__ unsigned long long phase_attn(const KArgs& a, const int z, const int tid, int jl, bool with_ctx, char* lds_gen) {
    const int lane = tid & 63, wave = tid >> 6, l15 = lane & 15, lg = lane >> 4;
    const bf16_t* Zq = (const bf16_t*)((a.ws + z) + OFF_Z + ZO_QKV); const bf16_t* KK = (const bf16_t*)((a.ws + z) + OFF_Z + ZO_KK); const bf16_t* VT = (const bf16_t*)((a.ws + z) + OFF_Z + ZO_VT);
    bf16_t* O = (bf16_t*)((a.ws + z) + OFF_Z + ZO_O);
    const float* sinkp = a.in[z + 25] + jl * 8; const float* qn = a.in[z + 23] + jl * 64;
    const int gw = blockIdx.x * NWAVE + wave, NGW = gridDim.x * NWAVE;
    const int nitems = with_ctx ? 16384 + 512 : 16384;
    {
        const bf16_t* VV = (const bf16_t*)((unsigned char*)(a.out + z) + DO_VV);
        const int G = gridDim.x, bx = blockIdx.x, vcu = (G % 8 == 0) ? (bx % 8) * (G / 8) + bx / 8 : bx, per = (2048 + G - 1) / G;
        for (int i = 0; i < per; ++i) { const int u = vcu * per + i; if (u >= 2048) break;
            const int b = (u >> 8) & 7, qb = (u >> 3) & 31, h = u & 7, g = h >> 2;
            attn_body::attn_unit<8, false>((const attn_body::bf16*)(Zq + (size_t)(b * SEQ + qb * 256) * 1536 + h * 64), 1536,
                                    (const attn_body::bf16*)(KK + (size_t)(b * 2 + g) * KVR * 64), 64, (const attn_body::bf16*)(VV + (size_t)(b * 2 + g) * KVR * 64), 64,
                                    (attn_body::bf16*)(O + (size_t)(b * SEQ + qb * 256) * 1024 + h * 64), 1024, KVR / 64, lds_gen, tid, 0, 0.f, qn, qb * 256); }
        for (int i = 0; i < per; ++i) { const int u = vcu * per + i; if (u >= 2048) break;
            const int b = (u >> 8) & 7, qb = (u >> 3) & 31, h = u & 7, g = h >> 2;
            attn_body::attn_unit<8, true>((const attn_body::bf16*)(Zq + (size_t)(b * SEQ + qb * 256) * 1536 + 512 + h * 64), 1536,
                                    (const attn_body::bf16*)(KK + (size_t)((8 + b) * 2 + g) * KVR * 64), 64, (const attn_body::bf16*)(VV + (size_t)((8 + b) * 2 + g) * KVR * 64), 64,
                                    (attn_body::bf16*)(O + (size_t)(b * SEQ + qb * 256) * 1024 + 512 + h * 64), 1024, 12, lds_gen, tid, qb * 256, sinkp[h] * LOG2E, nullptr, qb * 256); }
        if (with_ctx) {
            for (int u = vcu; u < 128; u += G) { const int type = u >> 6, b = (u >> 3) & 7, h = u & 7, g = h >> 2;
                attn_body::attn_unit<8, true>((const attn_body::bf16*)(Zq + (size_t)(ML + b * CTXL) * 1536 + type * 512 + h * 64), 1536,
                                    (const attn_body::bf16*)(KK + (size_t)((type * 8 + b) * 2 + g) * KVR * 64), 64, (const attn_body::bf16*)(VV + (size_t)((type * 8 + b) * 2 + g) * KVR * 64), 64,
                                    (attn_body::bf16*)(O + (size_t)(ML + b * CTXL) * 1024 + type * 512 + h * 64), 1024, 4, lds_gen, tid, 0, type ? sinkp[h] * LOG2E : -1e30f, type ? nullptr : qn, -1); }
        }
    }
    return 0ull;
#if 0
    const unsigned long long t_simple0 = __builtin_amdgcn_s_memrealtime();
    for (int item = 8192 + gw; item < nitems; item += NGW) {
        int mode, bg, qtile;
        if (item < 8192) { mode = 0; bg = item >> 9; qtile = item & 511; }
        else if (item < 16384) { mode = 1; bg = (item - 8192) >> 9; qtile = item & 511; }
        else if (item < 16384 + 256) { mode = 2; bg = (item - 16384) >> 4; qtile = item & 15; }
        else { mode = 3; bg = (item - 16640) >> 4; qtile = item & 15; }
        const int b = bg >> 1, g = bg & 1, type = mode & 1;
        const int rowbase = (mode < 2) ? b * SEQ + 16 * qtile : ML + b * CTXL + 16 * qtile;
        const int qcol = type * 512 + g * 256;
        const bf16_t* Kb = KK + (size_t)((type * 8 + b) * 2 + g) * KVR * 64;
        const bf16_t* Vb = VT + (size_t)((type * 8 + b) * 2 + g) * 64 * KVR;
        const int nA = (mode == 0) ? 264 : 8;
        int lo = 0, nB = 0; const int q0 = 16 * qtile;
        if (mode == 1) { lo = q0 >= 128 ? ((q0 - 128) >> 5) : 0; int hi = ((q0 + 143) >> 5) + 1; if (hi > 256) hi = 256; nB = hi - lo; }
        const int ntot = nA + nB;
        bf16x8 qf[4][2];
        { const bf16_t* qp = Zq + (size_t)(rowbase + l15) * 1536 + qcol + 8 * lg;
#pragma unroll
          for (int qt = 0; qt < 4; ++qt)
#pragma unroll
              for (int ks = 0; ks < 2; ++ks) qf[qt][ks] = *(const bf16x8*)(qp + 64 * qt + 32 * ks); }
        f32x4 oacc[4][4]; float mrun[4], lsum[4];
#pragma unroll
        for (int qt = 0; qt < 4; ++qt) { mrun[qt] = -1e30f; lsum[qt] = 0.f;
#pragma unroll
            for (int dt = 0; dt < 4; ++dt) oacc[qt][dt] = (f32x4){0.f, 0.f, 0.f, 0.f}; }
        bf16x8 kf[2][2]; u32x2 vlo[4], vhi[4];
        const bf16_t* kp = Kb + (size_t)l15 * 64 + 8 * lg; const bf16_t* vp = Vb + (size_t)l15 * KVR + 4 * lg;
#define LOAD_KV(KF, VLO, VHI, kvrow0) do { \
        _Pragma("unroll") for (int kt = 0; kt < 2; ++kt) _Pragma("unroll") for (int ks = 0; ks < 2; ++ks) KF[kt][ks] = *(const bf16x8*)(kp + (size_t)((kvrow0) + 16 * kt) * 64 + 32 * ks); \
        _Pragma("unroll") for (int dt = 0; dt < 4; ++dt) { VLO[dt] = *(const u32x2*)(vp + (size_t)(16 * dt) * KVR + (kvrow0)); VHI[dt] = *(const u32x2*)(vp + (size_t)(16 * dt) * KVR + (kvrow0) + 16); } } while (0)
        LOAD_KV(kf, vlo, vhi, 0);
        for (int blk = 0; blk < ntot; ++blk) {
            const int nb_ = (blk + 1 < ntot) ? blk + 1 : blk;
            const int kvnext = nb_ < nA ? 32 * nb_ : 256 + 32 * (lo + nb_ - nA);
            bf16x8 kfn[2][2]; u32x2 vlon[4], vhin[4];
            LOAD_KV(kfn, vlon, vhin, kvnext);
            const bool masked = blk >= nA; const int kpos0 = 32 * (lo + blk - nA) + 4 * lg;
            bf16x8 vf[4];
#pragma unroll
            for (int dt = 0; dt < 4; ++dt) { u32x4 w; w.x = vlo[dt].x; w.y = vlo[dt].y; w.z = vhi[dt].x; w.w = vhi[dt].y; vf[dt] = __builtin_bit_cast(bf16x8, w); }
#pragma unroll
            for (int qt = 0; qt < 4; ++qt) {
                f32x4 s0 = (f32x4){0.f, 0.f, 0.f, 0.f}, s1 = (f32x4){0.f, 0.f, 0.f, 0.f};
                s0 = __builtin_amdgcn_mfma_f32_16x16x32_bf16(kf[0][0], qf[qt][0], s0, 0, 0, 0); s0 = __builtin_amdgcn_mfma_f32_16x16x32_bf16(kf[0][1], qf[qt][1], s0, 0, 0, 0);
                s1 = __builtin_amdgcn_mfma_f32_16x16x32_bf16(kf[1][0], qf[qt][0], s1, 0, 0, 0); s1 = __builtin_amdgcn_mfma_f32_16x16x32_bf16(kf[1][1], qf[qt][1], s1, 0, 0, 0);
                if (masked) { const int qpos = q0 + l15;
#pragma unroll
                    for (int r = 0; r < 4; ++r) { const int d0 = kpos0 + r - qpos, d1 = d0 + 16;
                        if (d0 > 128 || d0 < -128) s0[r] = -1e30f; if (d1 > 128 || d1 < -128) s1[r] = -1e30f; } }
                float mx = fmaxf(fmaxf(fmaxf(s0[0], s0[1]), fmaxf(s0[2], s0[3])), fmaxf(fmaxf(s1[0], s1[1]), fmaxf(s1[2], s1[3])));
                mx = fmaxf(mx, __shfl_xor(mx, 16)); mx = fmaxf(mx, __shfl_xor(mx, 32));
                if (__any(mx > mrun[qt])) {
                    const float mnew = fmaxf(mrun[qt], mx), al = __builtin_amdgcn_exp2f(mrun[qt] - mnew); mrun[qt] = mnew; lsum[qt] *= al;
#pragma unroll
                    for (int dt = 0; dt < 4; ++dt) oacc[qt][dt] = oacc[qt][dt] * al; }
                const float mnew = mrun[qt];
                float ps = 0.f;
#pragma unroll
                for (int r = 0; r < 4; ++r) { s0[r] = __builtin_amdgcn_exp2f(s0[r] - mnew); s1[r] = __builtin_amdgcn_exp2f(s1[r] - mnew); ps += s0[r] + s1[r]; }
                lsum[qt] += ps;
                u32x4 pw; pw.x = cvt_pk_bf16(s0[0], s0[1]); pw.y = cvt_pk_bf16(s0[2], s0[3]); pw.z = cvt_pk_bf16(s1[0], s1[1]); pw.w = cvt_pk_bf16(s1[2], s1[3]);
                const bf16x8 pf = __builtin_bit_cast(bf16x8, pw);
#pragma unroll
                for (int dt = 0; dt < 4; ++dt) oacc[qt][dt] = __builtin_amdgcn_mfma_f32_16x16x32_bf16(vf[dt], pf, oacc[qt][dt], 0, 0, 0);
            }
#pragma unroll
            for (int kt = 0; kt < 2; ++kt)
#pragma unroll
                for (int ks = 0; ks < 2; ++ks) kf[kt][ks] = kfn[kt][ks];
#pragma unroll
            for (int dt = 0; dt < 4; ++dt) { vlo[dt] = vlon[dt]; vhi[dt] = vhin[dt]; }
        }
#undef LOAD_KV
#pragma unroll
        for (int qt = 0; qt < 4; ++qt) { float lt = lsum[qt]; lt += __shfl_xor(lt, 16); lt += __shfl_xor(lt, 32);
            if (type == 1) lt += __builtin_amdgcn_exp2f(sinkp[4 * g + qt] * LOG2E - mrun[qt]);
            const float inv = 1.0f / lt;
            bf16_t* op = O + (size_t)(rowbase + l15) * 1024 + qcol + 64 * qt + 4 * lg;
#pragma unroll
            for (int dt = 0; dt < 4; ++dt) { u32x2 w; w.x = cvt_pk_bf16(oacc[qt][dt][0] * inv, oacc[qt][dt][1] * inv); w.y = cvt_pk_bf16(oacc[qt][dt][2] * inv, oacc[qt][dt][3] * inv);
                *(u32x2*)(op + 16 * dt) = w; } }
    }
    return __builtin_amdgcn_s_memrealtime() - t_simple0;
#endif
}

#define RLX_AGENT __ATOMIC_RELAXED, __HIP_MEMORY_SCOPE_AGENT
#define XB_TMO      128
#define XB_XCNT(j)  (256  + 64 * (j))
#define XB_XSUB(j)  (1280 + 64 * (j))
#define XB_XGEN(j)  (2304 + 64 * (j))
#define XB_TOP      3328
#define XB_TOPGEN   3392
#define XCD_BAR_WORDS 3456
#define XB_SPIN_CAP (1u << 18)

__device__ __forceinline__ unsigned xb_ld(unsigned* p)              { return __hip_atomic_load(p, __ATOMIC_RELAXED, __HIP_MEMORY_SCOPE_AGENT); }
__device__ __forceinline__ unsigned xb_add(unsigned* p, unsigned v) { return __hip_atomic_fetch_add(p, v, __ATOMIC_RELAXED, __HIP_MEMORY_SCOPE_AGENT); }
__device__ __forceinline__ unsigned xb_xcc_id() { return (unsigned)__builtin_amdgcn_s_getreg((3 << 11) | 20) & 0xFu; }
#define XB_SPIN(cond, bar) do { unsigned _sp = 0; while (cond) { __builtin_amdgcn_s_sleep(1); \
    if ((++_sp & 255u) == 0u) { if (xb_ld(&(bar)[XB_TMO])) break; if (_sp > XB_SPIN_CAP) { atomicAdd(&(bar)[XB_TMO], 1u); break; } } } } while (0)

struct XcdBarrier {
    unsigned* bar; unsigned x;
    volatile LAS unsigned* st;
};

__device__ __forceinline__ XcdBarrier xcd_barrier_post(unsigned* bar, volatile LAS unsigned* st) {
    XcdBarrier b; b.bar = bar; b.x = xb_xcc_id(); b.st = st;
    if (threadIdx.x == 0) (void)xb_add(&bar[XB_XCNT(b.x)], 1u);
    return b;
}
__device__ __forceinline__ void xcd_barrier_complete(unsigned* bar, unsigned x, unsigned& nloc, unsigned& nx) {
    const unsigned G = gridDim.x * gridDim.y * gridDim.z;
    unsigned sum, cnt, mine, sp = 0u;
    for (;;) {
        sum = 0u; cnt = 0u; mine = 0u;
#pragma unroll
        for (unsigned j = 0; j < 16; ++j) { const unsigned c = xb_ld(&bar[XB_XCNT(j)]); sum += c; cnt += (c > 0u) ? 1u : 0u; mine = (j == x) ? c : mine; }
        if (sum == G) break;
        __builtin_amdgcn_s_sleep(1);
        if ((++sp & 255u) == 0u) { if (xb_ld(&bar[XB_TMO])) break; if (sp > XB_SPIN_CAP) { atomicAdd(&bar[XB_TMO], 1u); break; } }
    }
    nloc = mine > 0u ? mine : 1u; nx = cnt > 0u ? cnt : 1u;
}

__device__ __forceinline__ void xcd_barrier(const XcdBarrier& b) {
    asm volatile("s_waitcnt vmcnt(0)" ::: "memory");
    __syncthreads();
    if (threadIdx.x == 0) {
        unsigned* bar = b.bar;
        __builtin_amdgcn_s_waitcnt(0);
        unsigned nloc = b.st[0], nx = b.st[1];
        if (nloc == 0u) { xcd_barrier_complete(bar, b.x, nloc, nx); b.st[0] = nloc; b.st[1] = nx; }
        const unsigned old = xb_add(&bar[XB_XSUB(b.x)], 1u);
        const unsigned gen = old / nloc;
        if (old + 1u == (gen + 1u) * nloc) {
            __builtin_amdgcn_fence(__ATOMIC_RELEASE, "agent");
            asm volatile("s_waitcnt vmcnt(0)" ::: "memory");
            const unsigned og = xb_add(&bar[XB_TOP], 1u);
            const unsigned tg = og / nx;
            if (og + 1u == (tg + 1u) * nx) xb_add(&bar[XB_TOPGEN], 1u);
            else XB_SPIN(xb_ld(&bar[XB_TOPGEN]) == tg, bar);
            __builtin_amdgcn_fence(__ATOMIC_ACQUIRE, "agent");
            xb_add(&bar[XB_XGEN(b.x)], 1u);
            asm volatile("s_waitcnt vmcnt(0)" ::: "memory");
        } else {
            XB_SPIN(xb_ld(&bar[XB_XGEN(b.x)]) == gen, bar);
            __builtin_amdgcn_fence(__ATOMIC_ACQUIRE, "agent");
            asm volatile("s_waitcnt vmcnt(0)" ::: "memory");
        }
    }
    __syncthreads();
}

__global__ void __launch_bounds__(NTHR, 2) trunk_fwd(KArgs a) {
    extern __shared__ __attribute__((aligned(16))) unsigned char lds_raw[];
    LAS unsigned char* lds = (LAS unsigned char*)lds_raw;
    cg::grid_group grid = cg::this_grid();
    if (threadIdx.x < 16) ((LAS unsigned*)(lds + 131072))[threadIdx.x] = 0u;
    __syncthreads();
    const XcdBarrier xbar = xcd_barrier_post((unsigned*)(a.ws + OFF_BAR), (volatile LAS unsigned*)(lds + 131072 + 32));
#ifdef PROBE_KIND
    unsigned long long t_acc = 0;
#endif
    for (int si = a.step_lo; si < a.step_hi; ++si) {
        int tid = threadIdx.x; asm volatile("" : "+v"(tid));
        int z = 0; asm volatile("" : "+s"(z));
        unsigned char* ws = a.ws + z; unsigned char* WB = ws + OFF_W;
        const int st = a.steps[si], kind = st & 0xff, l = (st >> 8) & 0xf, arg = (st >> 12) & 0xf, jl = l >> 1;
        const int Mrows = (l == 3) ? ML : MALL;
#ifdef PROBE_KIND
        const unsigned long long t_0 = __builtin_amdgcn_s_memrealtime();
#endif
#ifdef ONLY
        if (kind != ONLY) continue;
#endif
        switch (kind) {
        case K_PROLOGUE: phase_prologue(a, z, tid, lds); break;
        case K_MOD0: phase_ln(a, z, tid, 0, 0, 0, MALL, blockIdx.x, gridDim.x); break;
        case K_LN: { const int which = arg & 3; const bool ctx_only = (arg >> 2) & 1;
            phase_ln(a, z, tid, l, which, ctx_only ? ML : 0, (l == 3) ? ML : MALL, blockIdx.x, gridDim.x); break; }
        case K_GEMM_EVIN: {
            const bool latonly = (arg >> 2) & 1, tail = (arg >> 3) & 1;
            pg8::Gemm g{(const bf16_t*)(ws + OFF_R2), (const bf16_t*)(WB + W_EV_IN) + (size_t)jl * 3072 * 1024, MALL, 3072, 1024, 1024, 0};
            EpiStore E{(bf16_t*)(ws + OFF_Z), 3072, 8};
            int M_ = MALL, G_ = gridDim.x; bool do_gemm = true;
            if (latonly) M_ = ML;
            if (tail) { g.A += (size_t)ML * 1024; E.O += (size_t)ML * 3072; M_ = MC; G_ = 96; do_gemm = blockIdx.x < 96; }
            g.M = M_;
            if (do_gemm) { pg8::StaticOrder S; S.init(M_, 3072, G_, blockIdx.x); pg8::gemm_phase<EpiStore, true>(tid, lds, g, S, E); }
            else phase_conv(a, z, tid, jl, 0, ML / 16, blockIdx.x - 96, gridDim.x - 96);
            break; }
        case K_GEMM_PLAIN: {
            const int pk = arg & 3; const bool latonly = (arg >> 2) & 1, tail = (arg >> 3) & 1;
            pg8::Gemm g; EpiStore E; int M_, N_;
            if (pk == PL_EVOUT) { g = pg8::Gemm{(const bf16_t*)(ws + OFF_Z), (const bf16_t*)(WB + W_EV_OUT) + (size_t)jl * 1024 * 1536, MALL, 1024, 1536, 3072, 0}; M_ = MALL; N_ = 1024; E = EpiStore{(bf16_t*)(ws + OFF_R2 + SZ_ROWS_BF), 1024, 0}; }
            else if (pk == PL_ODIN) { g = pg8::Gemm{(const bf16_t*)(ws + OFF_R2), (const bf16_t*)(WB + W_OD_IN) + (size_t)jl * 1536 * 1024, MALL, 1536, 1024, 1024, 0}; M_ = MALL; N_ = 1536; E = EpiStore{(bf16_t*)(ws + OFF_Z + ZO_QKV), 1536, 0}; }
            else if (pk == PL_ODOUT) { g = pg8::Gemm{(const bf16_t*)(ws + OFF_Z + ZO_O), (const bf16_t*)(WB + W_OD_OUT) + (size_t)jl * 1024 * 1024, Mrows, 1024, 1024, 1024, 0}; M_ = Mrows; N_ = 1024; E = EpiStore{(bf16_t*)(ws + OFF_R2 + SZ_ROWS_BF), 1024, 0}; }
            else { g = pg8::Gemm{(const bf16_t*)(ws + OFF_Z), (const bf16_t*)(WB + W_FFN_OUT) + (size_t)l * 1024 * 2816, Mrows, 1024, 2816, 2816, 0}; M_ = Mrows; N_ = 1024; E = EpiStore{(bf16_t*)(ws + OFF_R2 + SZ_ROWS_BF), 1024, 0}; }
            int G_ = gridDim.x; bool do_gemm = true;
            if (latonly) M_ = ML;
            const int tg = 8 * (N_ / 256);
            if (tail) { g.A += (size_t)ML * g.lda; E.O += (size_t)ML * E.ldc; M_ = MC; G_ = tg; do_gemm = blockIdx.x < tg; }
            g.M = M_;
            if (do_gemm) { pg8::StaticOrder S; S.init(M_, N_, G_, blockIdx.x); pg8::gemm_phase<EpiStore, true>(tid, lds, g, S, E); }
            else if (pk == PL_ODIN) phase_qkpost(a, z, tid, jl, 0, ML, blockIdx.x - tg, gridDim.x - tg);
            else phase_ln(a, z, tid, l, pk == PL_FFNOUT ? 2 : 1, 0, ML, blockIdx.x - tg, gridDim.x - tg);
            break; }
        case K_GEMM_SWIGLU: {
            pg8::Gemm g{(const bf16_t*)(ws + OFF_R2), (const bf16_t*)(WB + W_FFN_IN) + (size_t)l * 5632 * 1024, Mrows, 5632, 1024, 1024, 0};
            pg8::StaticOrder S; S.init(Mrows, 5632, gridDim.x, blockIdx.x);
            EpiSwiglu E{(bf16_t*)(ws + OFF_Z), 2816};
            pg8::gemm_phase<EpiSwiglu, true>(tid, lds, g, S, E); break; }
        case K_GEMM_GATE: {
            const int d = arg;
            pg8::Gemm g{(const bf16_t*)((unsigned char*)(a.out + z) + DO_XC), (const bf16_t*)(WB + W_GATE) + (size_t)jl * (2 * 8 * 256 * 128) + (size_t)d * 8 * 256 * 128, MALL, 2048, 128, 1024, 256};
            pg8::StaticOrder S; S.init(MALL, 2048, gridDim.x, blockIdx.x);
            EpiGate E{(bf16_t*)(ws + OFF_R2), (bf16_t*)(ws + OFF_R2 + SZ_ROWS_BF), (const bf16_t*)((unsigned char*)(a.out + z) + DO_XC),
                      a.in[z + 17] + (size_t)((jl * 2 + d) * 2 + 0) * 1024, a.in[z + 17] + (size_t)((jl * 2 + d) * 2 + 1) * 1024, (const float*)(ws + OFF_SPL) + (size_t)(jl * 2 + d) * 1024};
            pg8::gemm_phase<EpiGate, true>(tid, lds, g, S, E); break; }
        case K_CONV_GMLP: if (arg & 4) phase_conv(a, z, tid, jl, ML / 16, MC / 16, blockIdx.x, gridDim.x); else phase_conv(a, z, tid, jl, 0, MALL / 16, blockIdx.x, gridDim.x); break;
        case K_SCAN1: phase_scan(a, z, tid, arg, 1); break;
        case K_CARRY:
            phase_carry(a, z, tid, lds);
            if (arg == 0) phase_gmlp(a, z, tid, jl, lds, blockIdx.x, gridDim.x);
            break;
        case K_SCAN2: phase_scan(a, z, tid, arg, 2); break;
        case K_QKPOST: if (arg & 4) phase_qkpost(a, z, tid, jl, ML, MC, blockIdx.x, gridDim.x); else phase_qkpost(a, z, tid, jl, 0, MALL, blockIdx.x, gridDim.x); break;
        case K_ATTN: { const unsigned long long ts_ = phase_attn(a, z, tid, jl, l != 3, (char*)lds_raw);
#ifdef PROBE_ATTN_SIMPLE
            t_acc += ts_;
#else
            (void)ts_;
#endif
            break; }
        case K_DUMP: {
            const float* H = (const float*)(ws + OFF_H); const bf16_t* A_ = (const bf16_t*)(ws + OFF_R2); const bf16_t* Y_ = (const bf16_t*)(ws + OFF_R2 + SZ_ROWS_BF); const bf16_t* Z_ = (const bf16_t*)(ws + OFF_Z);
            for (size_t i = (size_t)blockIdx.x * NTHR + tid; i < (size_t)ML * 1024; i += (size_t)gridDim.x * NTHR) { const size_t row = i >> 10, c = i & 1023;
                (a.out + z)[i] = H[i] + bf_lo(A_[i]) + bf_lo(Y_[i]) + bf_lo(Z_[row * 3072 + c]) + bf_lo(Z_[row * 3072 + 1024 + c]) + bf_lo(Z_[row * 3072 + 2048 + c]); }
            break; }
        default: break;
        }
        if (si + 1 < a.step_hi) { if (si == a.step_lo) grid.sync(); else xcd_barrier(xbar); }
#ifdef PROBE_KIND
        if (kind == PROBE_KIND) t_acc += __builtin_amdgcn_s_memrealtime() - t_0;
#endif
    }
#ifdef PROBE_KIND
    { const unsigned long long t_s = __builtin_amdgcn_s_memrealtime(); while (__builtin_amdgcn_s_memrealtime() - t_s < t_acc) __builtin_amdgcn_s_sleep(8); }
#endif
}

extern "C" void kernel_launch(void* const* d_in, const int* in_sizes, int n_in, void* d_out, int out_size, void* d_ws, size_t ws_size, hipStream_t stream) {
    static int grid = 0;
    if (grid == 0) {
        if (n_in != 26 || out_size != ML * 1024 || ws_size < WS_NEED) { fprintf(stderr, "kernel_launch: unexpected problem (n_in %d out %d ws %zu need %zu)\n", n_in, out_size, ws_size, (size_t)WS_NEED); grid = -1; return; }
        int dev = 0, cus = 0, per_cu = 0;
        (void)hipGetDevice(&dev); (void)hipDeviceGetAttribute(&cus, hipDeviceAttributeMultiprocessorCount, dev);
        if (hipFuncSetAttribute((const void*)trunk_fwd, hipFuncAttributeMaxDynamicSharedMemorySize, LDS_BYTES) != hipSuccess) fprintf(stderr, "kernel_launch: hipFuncSetAttribute failed\n");
        if (hipOccupancyMaxActiveBlocksPerMultiprocessor(&per_cu, (const void*)trunk_fwd, NTHR, LDS_BYTES) != hipSuccess || per_cu < 1) { fprintf(stderr, "kernel_launch: occupancy query says %d\n", per_cu); per_cu = 1; }
        (void)hipGetLastError();
        if (per_cu > 1) per_cu = 1;
        grid = cus * per_cu;
    }
    if (grid < 0) return;
    KArgs a{};
    for (int i = 0; i < 26; ++i) a.in[i] = (const float*)d_in[i];
    a.out = (float*)d_out; a.ws = (unsigned char*)d_ws;
    int n = 0;
#ifndef PROBE_DUP
#define PROBE_DUP 0
#endif
#define STEP(kind, l, arg) do { a.steps[n++] = (kind) | ((l) << 8) | ((arg) << 12); if ((PROBE_DUP >> (kind)) & 1) a.steps[n++] = (kind) | ((l) << 8) | ((arg) << 12); } while (0)
    STEP(K_PROLOGUE, 0, 0); STEP(K_MOD0, 0, 0);
    const bool split = grid >= 192;
    for (int l = 0; l < 4; ++l) {
        const bool sp = split && l != 3;
        if ((l & 1) == 0) {
            if (split) { STEP(K_GEMM_EVIN, l, 4); STEP(K_GEMM_EVIN, l, 8); STEP(K_CONV_GMLP, l, 4); } else { STEP(K_GEMM_EVIN, l, 0); STEP(K_CONV_GMLP, l, 0); }
            for (int d = 0; d < 2; ++d) { STEP(K_GEMM_GATE, l, d); STEP(K_SCAN1, l, d); STEP(K_CARRY, l, d); STEP(K_SCAN2, l, d); }
            if (sp) { STEP(K_GEMM_PLAIN, l, PL_EVOUT | 4); STEP(K_GEMM_PLAIN, l, PL_EVOUT | 8); STEP(K_LN, l, 1 | 4); } else { STEP(K_GEMM_PLAIN, l, PL_EVOUT); STEP(K_LN, l, 1); }
        } else {
            if (split) { STEP(K_GEMM_PLAIN, l, PL_ODIN | 4); STEP(K_GEMM_PLAIN, l, PL_ODIN | 8); STEP(K_QKPOST, l, 4); } else { STEP(K_GEMM_PLAIN, l, PL_ODIN); STEP(K_QKPOST, l, 0); }
            STEP(K_ATTN, l, 0);
            if (sp) { STEP(K_GEMM_PLAIN, l, PL_ODOUT | 4); STEP(K_GEMM_PLAIN, l, PL_ODOUT | 8); STEP(K_LN, l, 1 | 4); } else { STEP(K_GEMM_PLAIN, l, PL_ODOUT); STEP(K_LN, l, 1); }
        }
        STEP(K_GEMM_SWIGLU, l, 0);
        if (sp) { STEP(K_GEMM_PLAIN, l, PL_FFNOUT | 4); STEP(K_GEMM_PLAIN, l, PL_FFNOUT | 8); STEP(K_LN, l, 2 | 4); } else { STEP(K_GEMM_PLAIN, l, PL_FFNOUT); STEP(K_LN, l, 2); }
    }
#undef STEP
#ifdef TRUNC
    n = TRUNC; a.steps[n++] = K_DUMP;
#endif
    a.step_lo = 0; a.step_hi = n;
    (void)hipMemsetAsync((unsigned char*)d_ws + OFF_BAR, 0, 16384, stream);
    void* args[] = {&a};
#ifndef FORCE_MULTI
#define FORCE_MULTI 0
#endif
    hipError_t e = FORCE_MULTI ? hipErrorUnknown : hipLaunchCooperativeKernel((const void*)trunk_fwd, dim3(grid), dim3(NTHR), args, LDS_BYTES, stream);
    if (e != hipSuccess) {
        if (!FORCE_MULTI) fprintf(stderr, "kernel_launch: cooperative launch failed: %s (grid %d); falling back to one launch per step\n", hipGetErrorString(e), grid);
        (void)hipGetLastError();
        for (int s = 0; s < n; ++s) { a.step_lo = s; a.step_hi = s + 1; hipLaunchKernelGGL(trunk_fwd, dim3(grid), dim3(NTHR), LDS_BYTES, stream, a); }
    }
}
```

```cpp
#include <hip/hip_runtime.h>
#include <hip/hip_cooperative_groups.h>
#include <cstdio>
#include <cstdint>
#include <hip/hip_bf16.h>
#include <cmath>
namespace cg = cooperative_groups;

#define LAS __attribute__((address_space(3)))
typedef unsigned short bf16_t;
typedef short bf16x8 __attribute__((ext_vector_type(8)));
typedef float f32x4 __attribute__((ext_vector_type(4)));
typedef float f32x2 __attribute__((ext_vector_type(2)));
typedef unsigned u32x4 __attribute__((ext_vector_type(4)));
typedef unsigned u32x2 __attribute__((ext_vector_type(2)));

constexpr int DM = 1024, NB = 8, SEQ = 8192, CTXL = 256, ML = NB * SEQ, MC = NB * CTXL, MALL = ML + MC, FH = 2816, KVR = SEQ + CTXL;
constexpr int NTHR = 512, NWAVE = 8;
constexpr int LDS_BYTES = 131072 + 2048;
constexpr float ALPHA = 1.681792830507429f, LOG2E = 1.4426950408889634f;
constexpr float QSCALE = 0.125f * 1.4426950408889634f;

constexpr size_t SZ_ROWS_BF = (size_t)MALL * 1024 * 2;
constexpr size_t OFF_H = 0;
constexpr size_t OFF_W = OFF_H + (size_t)MALL * 1024 * 4;
constexpr size_t W_FFN_IN = 0;
constexpr size_t W_FFN_OUT = W_FFN_IN + 4ull * 5632 * 1024 * 2;
constexpr size_t W_EV_IN = W_FFN_OUT + 4ull * 1024 * 2816 * 2;
constexpr size_t W_EV_OUT = W_EV_IN + 2ull * 3072 * 1024 * 2;
constexpr size_t W_GATE = W_EV_OUT + 2ull * 1024 * 1536 * 2;
constexpr size_t W_OD_IN = W_GATE + 2ull * 2 * 8 * 256 * 128 * 2;
constexpr size_t W_OD_OUT = W_OD_IN + 2ull * 1536 * 1024 * 2;
constexpr size_t W_END = W_OD_OUT + 2ull * 1024 * 1024 * 2;
constexpr size_t OFF_MOD = OFF_W + W_END;
constexpr size_t OFF_Z = OFF_MOD + 4ull * 9 * 6144 * 4;
constexpr size_t OFF_R2 = OFF_Z + (size_t)MALL * 3072 * 2;
constexpr size_t OFF_SPL = OFF_R2 + 2 * SZ_ROWS_BF;
constexpr size_t OFF_BAR = OFF_SPL + 16384;
constexpr size_t WS_NEED = OFF_BAR + 16384;
constexpr size_t ZO_QKV = 0;
constexpr size_t ZO_O = (size_t)MALL * 1536 * 2;
constexpr size_t ZO_KK = ZO_O + SZ_ROWS_BF;
constexpr size_t ZO_VT = ZO_KK + 2ull * 8 * 2 * KVR * 64 * 2;
constexpr size_t DO_VV = 0;
constexpr size_t DO_XC = 0;
constexpr size_t DO_SUMM = SZ_ROWS_BF;
constexpr size_t DO_CARRY = DO_SUMM + 8ull * 264 * 1024 * 8;

struct KArgs {
    const float* in[26];
    float* out; unsigned char* ws;
    int step_lo, step_hi;
    int steps[96];
};
enum { K_PROLOGUE = 0, K_MOD0, K_GEMM_EVIN, K_CONV_GMLP, K_GEMM_GATE, K_SCAN1, K_CARRY, K_SCAN2, K_GEMM_PLAIN, K_LN, K_GEMM_SWIGLU, K_QKPOST, K_ATTN, K_DUMP };
enum { PL_EVOUT = 0, PL_ODIN, PL_ODOUT, PL_FFNOUT };

typedef __bf16 bf16x2_t __attribute__((ext_vector_type(2)));
__device__ __forceinline__ unsigned cvt_pk_bf16(float lo, float hi) { f32x2 v = {lo, hi}; bf16x2_t b = __builtin_convertvector(v, bf16x2_t); return __builtin_bit_cast(unsigned, b); }
__device__ __forceinline__ float bf_lo(unsigned w) { return __uint_as_float(w << 16); }
__device__ __forceinline__ float bf_hi(unsigned w) { return __uint_as_float(w & 0xffff0000u); }
__device__ __forceinline__ float fast_sigmoid(float x) { return __builtin_amdgcn_rcpf(1.0f + __builtin_amdgcn_exp2f(-x * LOG2E)); }
__device__ __forceinline__ float silu_f(float x) { return x * fast_sigmoid(x); }
__device__ __forceinline__ float gelu_tanh(float x) { const float u = x + 0.044715f * x * x * x; return x * __builtin_amdgcn_rcpf(1.0f + __builtin_amdgcn_exp2f(-2.0f * 0.7978845608028654f * LOG2E * u)); }
__device__ __forceinline__ void unpack8(const u32x4 w, float (&x)[8]) { x[0] = bf_lo(w.x); x[1] = bf_hi(w.x); x[2] = bf_lo(w.y); x[3] = bf_hi(w.y); x[4] = bf_lo(w.z); x[5] = bf_hi(w.z); x[6] = bf_lo(w.w); x[7] = bf_hi(w.w); }
__device__ __forceinline__ float wave_sum(float v) {
#pragma unroll
    for (int o = 1; o < 64; o <<= 1) v += __shfl_xor(v, o);
    return v;
}

namespace pg8 {
constexpr int BM = 256, BK = 64, HALF = 128, HTB = HALF * BK * 2, STAGE_BYTES = 8 * HTB, NXCD = 8, WGM = 4;
__host__ __device__ __forceinline__ int lds_byte(int r, int c) { const int st = (r >> 4) * 2 + (c >> 5), rr = r & 15, cc = c & 31, ob = rr * 64 + cc * 2; return st * 1024 + (ob ^ (((ob >> 9) & 1) << 5)); }
__host__ __device__ __forceinline__ void stage_rc(int b, int& R, int& C) { const int st = b / 1024, sb = b % 1024, swz = sb ^ (((sb >> 9) & 1) << 5); R = (st >> 1) * 16 + swz / 64; C = (st & 1) * 32 + (swz % 64) / 2; }
__host__ __device__ __forceinline__ int perm32(int rho) { const int n = rho >> 4, i = rho & 15; return 8 * (i >> 2) + 4 * n + (i & 3); }
struct Unit { int pm, pn; };
struct Gemm { const bf16_t* A; const bf16_t* Bt; int M, N, K, lda, a_pn_off; };
struct StaticOrder {
    int nM, nN, nwg, G, c;
    __device__ void init(int M, int N, int G_, int c_) { nM = M / BM; nN = N / BM; nwg = nM * nN; G = G_; c = c_; }
    __device__ bool next(int i, Unit& u) const {
        const long L = (long)i * G + c; if (L >= nwg) return false;
        int wgid = (int)L; { const int q = nwg / NXCD, r = nwg % NXCD, xcd = wgid % NXCD, off = wgid / NXCD; wgid = (xcd < r ? xcd * (q + 1) : r * (q + 1) + (xcd - r) * q) + off; }
        const int nig = WGM * nN, gid = wgid / nig, fm = gid * WGM, gsz = (nM - fm) < WGM ? (nM - fm) : WGM;
        u.pm = fm + ((wgid % nig) % gsz); u.pn = (wgid % nig) / gsz; return true;
    }
};
template <class Epi, bool ALIGN_EPI>
__device__ __forceinline__ void gemm_phase(int tid, LAS unsigned char* lds, const Gemm g, const StaticOrder& S, const Epi& E) {
    const int wid = __builtin_amdgcn_readfirstlane(tid >> 6), lane = tid & 63, wr = wid >> 2, wc = wid & 3, fr = lane & 15, fq = lane >> 4;
    const int K = g.K, nt = K / BK;
    unsigned voffA[2], voffB[2];
#pragma unroll
    for (int i = 0; i < 2; ++i) { int R, C; stage_rc(tid * 16 + i * 8192, R, C); const int Rb = Epi::PERM ? ((R & ~31) + perm32(R & 31)) : R;
        voffA[i] = (unsigned)(R * g.lda + C) * 2u; voffB[i] = (unsigned)(Rb * K + C) * 2u; }
    const size_t kstep = (size_t)(BK * 2);
    const size_t hstepA = (size_t)HALF * g.lda * 2, hstepB = (size_t)HALF * K * 2;
    const size_t tstepA = 2 * hstepA, tstepB = 2 * hstepB;
    const unsigned ldsw = (unsigned)wid * 1024u;
    const int aoff = lds_byte(wr * 64 + fr, fq * 8), boff = lds_byte(wc * 32 + fr, fq * 8);
#define PG8_SA(b, h) (((b) * 2 + (h)) * HTB)
#define PG8_SB(b, h) ((4 + (b) * 2 + (h)) * HTB)
#define PG8_STAGE(bufoff, gbase, voff) do { _Pragma("unroll") for (int _i = 0; _i < 2; ++_i) \
        __builtin_amdgcn_global_load_lds((const unsigned*)((const char*)(gbase) + (voff)[_i]), (LAS unsigned*)(lds + (bufoff) + ldsw + _i * 8192), 16, 0, 0); } while (0)
#define PG8_LDA(dst, b, h) do { _Pragma("unroll") for (int m = 0; m < 4; ++m) _Pragma("unroll") for (int k = 0; k < 2; ++k) dst[m][k] = *(const LAS bf16x8*)(lds + PG8_SA(b, h) + aoff + m * 2048 + k * 1024); } while (0)
#define PG8_LDB(dst, b, h) do { _Pragma("unroll") for (int n = 0; n < 2; ++n) _Pragma("unroll") for (int k = 0; k < 2; ++k) dst[n][k] = *(const LAS bf16x8*)(lds + PG8_SB(b, h) + boff + n * 2048 + k * 1024); } while (0)
#define PG8_MMA(ai, bj, At, Bt) do { __builtin_amdgcn_s_setprio(1); _Pragma("unroll") for (int m = 0; m < 4; ++m) _Pragma("unroll") for (int n = 0; n < 2; ++n) _Pragma("unroll") for (int k = 0; k < 2; ++k) \
        acc[ai][bj][m][n] = __builtin_amdgcn_mfma_f32_16x16x32_bf16(Bt[n][k], At[m][k], acc[ai][bj][m][n], 0, 0, 0); __builtin_amdgcn_s_setprio(0); } while (0)
#define PG8_WAIT_V(n) asm volatile("s_waitcnt vmcnt(" #n ")" ::: "memory")
#define PG8_WAIT_L(n) asm volatile("s_waitcnt lgkmcnt(" #n ")" ::: "memory")
#define PG8_BAR __builtin_amdgcn_s_barrier()
#define PG8_SCHED __builtin_amdgcn_sched_barrier(0)
    Unit cur, nxt; int ui = 0;
    if (!S.next(0, cur)) return;
    f32x4 acc[2][2][4][2];
#pragma unroll
    for (int a = 0; a < 2; ++a)
#pragma unroll
        for (int b = 0; b < 2; ++b)
#pragma unroll
            for (int m = 0; m < 4; ++m)
#pragma unroll
                for (int n = 0; n < 2; ++n) acc[a][b][m][n] = (f32x4){0.f, 0.f, 0.f, 0.f};
    bf16x8 At[4][2], B0[2][2], B1[2][2];
    const char* cA = (const char*)g.A + (size_t)cur.pm * tstepA + (size_t)cur.pn * (size_t)g.a_pn_off; const char* cB = (const char*)g.Bt + (size_t)cur.pn * tstepB;
    PG8_STAGE(PG8_SB(0, 0), cB, voffB); PG8_STAGE(PG8_SB(0, 1), cB + hstepB, voffB); PG8_STAGE(PG8_SA(0, 0), cA, voffA); PG8_STAGE(PG8_SA(0, 1), cA + hstepA, voffA);
    if (wr == 1) PG8_BAR;
    PG8_WAIT_V(2); PG8_BAR;
    PG8_STAGE(PG8_SB(1, 0), cB + kstep, voffB); PG8_STAGE(PG8_SA(1, 0), cA + kstep, voffA); PG8_STAGE(PG8_SB(1, 1), cB + hstepB + kstep, voffB);
    PG8_WAIT_V(6); PG8_BAR;
    for (;;) {
        const bool has_next = S.next(ui + 1, nxt);
        const char* nA = has_next ? (const char*)g.A + (size_t)nxt.pm * tstepA + (size_t)nxt.pn * (size_t)g.a_pn_off : cA; const char* nB = has_next ? (const char*)g.Bt + (size_t)nxt.pn * tstepB : cB;
        for (int t = 0; t < nt; t += 2) {
            const bool last = (t == nt - 2);
            const char* a1 = cA + (size_t)(t + 1) * kstep;
            const char* a2 = last ? nA : cA + (size_t)(t + 2) * kstep; const char* b2 = last ? nB : cB + (size_t)(t + 2) * kstep;
            const char* a3 = a2 + kstep; const char* b3 = b2 + kstep;
            PG8_LDB(B0, 0, 0); PG8_LDB(B1, 0, 1); PG8_SCHED; PG8_LDA(At, 0, 0); PG8_STAGE(PG8_SA(1, 1), a1 + hstepA, voffA);
            PG8_WAIT_V(8); PG8_WAIT_L(0); PG8_BAR; PG8_MMA(0, 0, At, B0); PG8_MMA(0, 1, At, B1); PG8_BAR; PG8_SCHED;
            PG8_LDA(At, 0, 1); PG8_STAGE(PG8_SB(0, 0), b2, voffB); PG8_STAGE(PG8_SB(0, 1), b2 + hstepB, voffB); PG8_STAGE(PG8_SA(0, 0), a2, voffA);
            PG8_WAIT_V(8); PG8_WAIT_L(0); PG8_BAR; PG8_MMA(1, 0, At, B0); PG8_MMA(1, 1, At, B1); PG8_BAR; PG8_SCHED;
            PG8_LDB(B0, 1, 0); PG8_LDB(B1, 1, 1); PG8_SCHED; PG8_LDA(At, 1, 0); PG8_STAGE(PG8_SA(0, 1), a2 + hstepA, voffA);
            PG8_WAIT_V(8); PG8_WAIT_L(0); PG8_BAR; PG8_MMA(0, 0, At, B0); PG8_MMA(0, 1, At, B1); PG8_BAR; PG8_SCHED;
            PG8_LDA(At, 1, 1); PG8_STAGE(PG8_SB(1, 0), b3, voffB); PG8_STAGE(PG8_SB(1, 1), b3 + hstepB, voffB); PG8_STAGE(PG8_SA(1, 0), a3, voffA);
            PG8_WAIT_V(8); PG8_WAIT_L(0); PG8_BAR; PG8_MMA(1, 0, At, B0); PG8_MMA(1, 1, At, B1); PG8_BAR; PG8_SCHED;
        }
        if constexpr (ALIGN_EPI) { if (wr == 0) PG8_BAR; }
        E(acc, cur, wr, wc, fr, fq);
        if (!has_next) break;
#pragma unroll
        for (int a = 0; a < 2; ++a)
#pragma unroll
            for (int b = 0; b < 2; ++b)
#pragma unroll
                for (int m = 0; m < 4; ++m)
#pragma unroll
                    for (int n = 0; n < 2; ++n) acc[a][b][m][n] = (f32x4){0.f, 0.f, 0.f, 0.f};
        cur = nxt; cA = nA; cB = nB; ++ui;
        if constexpr (ALIGN_EPI) { if (wr == 1) PG8_BAR; }
    }
    PG8_WAIT_V(0);
    if constexpr (!ALIGN_EPI) { if (wr == 0) PG8_BAR; }
    PG8_BAR;
#undef PG8_SA
#undef PG8_SB
#undef PG8_STAGE
#undef PG8_LDA
#undef PG8_LDB
#undef PG8_MMA
#undef PG8_WAIT_V
#undef PG8_WAIT_L
#undef PG8_BAR
#undef PG8_SCHED
}
}

struct EpiStore {
    static constexpr bool PERM = true;
    bf16_t* O; int ldc; int gelu_tiles;
    __device__ __forceinline__ void operator()(const f32x4 (&acc)[2][2][4][2], const pg8::Unit& u, int wr, int wc, int fr, int fq) const {
        const int row0 = u.pm * 256 + wr * 64 + fr, col0 = u.pn * 256 + wc * 32 + 8 * fq; const bool act = u.pn < gelu_tiles;
#pragma unroll
        for (int ai = 0; ai < 2; ++ai)
#pragma unroll
            for (int m = 0; m < 4; ++m) { bf16_t* rowp = O + (size_t)(row0 + ai * 128 + m * 16) * ldc + col0;
#pragma unroll
                for (int bj = 0; bj < 2; ++bj) { f32x4 v0 = acc[ai][bj][m][0], v1 = acc[ai][bj][m][1];
                    if (act) {
#pragma unroll
                        for (int e = 0; e < 4; ++e) { v0[e] = gelu_tanh(v0[e]); v1[e] = gelu_tanh(v1[e]); } }
                    u32x4 w; w.x = cvt_pk_bf16(v0[0], v0[1]); w.y = cvt_pk_bf16(v0[2], v0[3]); w.z = cvt_pk_bf16(v1[0], v1[1]); w.w = cvt_pk_bf16(v1[2], v1[3]);
                    *(u32x4*)(rowp + bj * 128) = w; } }
    }
};
struct EpiSwiglu {
    static constexpr bool PERM = true;
    bf16_t* O; int ldc;
    __device__ __forceinline__ void operator()(const f32x4 (&acc)[2][2][4][2], const pg8::Unit& u, int wr, int wc, int fr, int fq) const {
        const int row0 = u.pm * 256 + wr * 64 + fr, col0 = u.pn * 128 + wc * 32 + 8 * fq;
#pragma unroll
        for (int ai = 0; ai < 2; ++ai)
#pragma unroll
            for (int m = 0; m < 4; ++m) { bf16_t* rowp = O + (size_t)(row0 + ai * 128 + m * 16) * ldc + col0;
                f32x4 v0, v1;
#pragma unroll
                for (int e = 0; e < 4; ++e) { v0[e] = silu_f(acc[ai][0][m][0][e]) * acc[ai][1][m][0][e]; v1[e] = silu_f(acc[ai][0][m][1][e]) * acc[ai][1][m][1][e]; }
                u32x4 w; w.x = cvt_pk_bf16(v0[0], v0[1]); w.y = cvt_pk_bf16(v0[2], v0[3]); w.z = cvt_pk_bf16(v1[0], v1[1]); w.w = cvt_pk_bf16(v1[2], v1[3]);
                __builtin_nontemporal_store(w, (u32x4*)rowp); }
    }
};
struct EpiGate {
    static constexpr bool PERM = true;
    bf16_t* LA; bf16_t* BBo; const bf16_t* XC; const float* gb_r; const float* gb_i; const float* spl;
    __device__ __forceinline__ void operator()(const f32x4 (&acc)[2][2][4][2], const pg8::Unit& u, int wr, int wc, int fr, int fq) const {
        const int row0 = u.pm * 256 + wr * 64 + fr, ch0 = u.pn * 128 + wc * 32 + 8 * fq;
#pragma unroll
        for (int ai = 0; ai < 2; ++ai)
#pragma unroll
            for (int m = 0; m < 4; ++m) { const size_t off = (size_t)(row0 + ai * 128 + m * 16) * 1024 + ch0;
                const u32x4 xw = *(const u32x4*)(XC + off);
                u32x4 w1, w2;
#pragma unroll
                for (int n = 0; n < 2; ++n) {
                    const f32x4 br = *(const f32x4*)(gb_r + ch0 + 4 * n), bi = *(const f32x4*)(gb_i + ch0 + 4 * n), sp = *(const f32x4*)(spl + ch0 + 4 * n);
                    const unsigned xa = n == 0 ? xw.x : xw.z, xb = n == 0 ? xw.y : xw.w;
                    const float xv[4] = {bf_lo(xa), bf_hi(xa), bf_lo(xb), bf_hi(xb)};
                    float la[4], bb[4];
#pragma unroll
                    for (int e = 0; e < 4; ++e) { const float gr = acc[ai][0][m][n][e] + br[e], gi = acc[ai][1][m][n][e] + bi[e];
                        const float l_ = sp[e] * fast_sigmoid(gr); la[e] = l_;
                        const float om = fmaxf(0.0f, 1.0f - __builtin_amdgcn_exp2f(2.0f * LOG2E * l_)); bb[e] = __builtin_amdgcn_sqrtf(om) * fast_sigmoid(gi) * xv[e]; }
                    if (n == 0) { w1.x = cvt_pk_bf16(la[0], la[1]); w1.y = cvt_pk_bf16(la[2], la[3]); w2.x = cvt_pk_bf16(bb[0], bb[1]); w2.y = cvt_pk_bf16(bb[2], bb[3]); }
                    else { w1.z = cvt_pk_bf16(la[0], la[1]); w1.w = cvt_pk_bf16(la[2], la[3]); w2.z = cvt_pk_bf16(bb[0], bb[1]); w2.w = cvt_pk_bf16(bb[2], bb[3]); }
                }
                *(u32x4*)(LA + off) = w1; *(u32x4*)(BBo + off) = w2; }
    }
};

__device__ __forceinline__ int colmap(int id, int n) {
    if (id == 1) { const int t = n >> 8, w = n & 255; return w < 128 ? t * 128 + w : FH + t * 128 + (w - 128); }
    if (id == 2) return n < 1024 ? n : (n < 2048 ? n + 1024 : n - 1024);
    return n;
}
__device__ __forceinline__ void tr_item(const float* W, int ldsrc, int K, bf16_t* WT, int n0, int k0, int mapid, LAS float* scr, int lane) {
    const int sc = colmap(mapid, n0 + (lane & 31));
#pragma unroll 8
    for (int i = 0; i < 32; ++i) { const int kk = 2 * i + (lane >> 5); scr[kk * 33 + (lane & 31)] = W[(size_t)(k0 + kk) * ldsrc + sc]; }
    asm volatile("s_waitcnt lgkmcnt(0)" ::: "memory");
    const int c = lane & 7;
#pragma unroll
    for (int j = 0; j < 4; ++j) { const int n = (lane >> 3) + 8 * j; const LAS float* s = scr + (8 * c) * 33 + n;
        u32x4 o; o.x = cvt_pk_bf16(s[0 * 33], s[1 * 33]); o.y = cvt_pk_bf16(s[2 * 33], s[3 * 33]); o.z = cvt_pk_bf16(s[4 * 33], s[5 * 33]); o.w = cvt_pk_bf16(s[6 * 33], s[7 * 33]);
        *(u32x4*)(WT + (size_t)(n0 + n) * K + k0 + 8 * c) = o; }
    asm volatile("s_waitcnt lgkmcnt(0)" ::: "memory");
}
__device__ __forceinline__ void phase_prologue(const KArgs& a, const int z, const int tid, LAS unsigned char* lds) {
    const int lane = tid & 63, wave = tid >> 6;
    LAS float* sv = (LAS float*)(lds + 73728);
    LAS float* part = (LAS float*)(lds + 110592);
    float* MOD = (float*)((a.ws + z) + OFF_MOD);
    for (int i = tid; i < 9 * 1024; i += NTHR) { const int s = i >> 10, k = i & 1023; const float v = s < 8 ? a.in[z + 1][s * 1024 + k] : a.in[z + 3][k]; sv[i] = v / (1.0f + __expf(-v)); }
    __syncthreads();
    for (int item = blockIdx.x; item < 768; item += gridDim.x) {
        const int l = item / 192, n0 = (item % 192) * 32, ks = tid >> 5, cl = tid & 31;
        const float* w = a.in[z + 4] + (size_t)l * 1024 * 6144 + n0 + cl;
        float acc[9];
#pragma unroll
        for (int s = 0; s < 9; ++s) acc[s] = 0.f;
        const int k0 = ks * 64;
        for (int kb = 0; kb < 64; kb += 16) { float wv[16];
#pragma unroll
            for (int k = 0; k < 16; ++k) wv[k] = w[(size_t)(k0 + kb + k) * 6144];
#pragma unroll
            for (int k = 0; k < 16; ++k)
#pragma unroll
                for (int s = 0; s < 9; ++s) acc[s] += sv[s * 1024 + k0 + kb + k] * wv[k]; }
#pragma unroll
        for (int s = 0; s < 9; ++s) part[(ks * 9 + s) * 32 + cl] = acc[s];
        __syncthreads();
        for (int idx = tid; idx < 288; idx += NTHR) { const int s = idx >> 5, n = idx & 31; float r = a.in[z + 5][l * 6144 + n0 + n];
#pragma unroll
            for (int w16 = 0; w16 < 16; ++w16) r += part[(w16 * 9 + s) * 32 + n];
            MOD[(size_t)(l * 9 + s) * 6144 + n0 + n] = r; }
        __syncthreads();
    }
    for (int i = blockIdx.x * NTHR + tid; i < 4096; i += gridDim.x * NTHR) ((float*)((a.ws + z) + OFF_SPL))[i] = -8.0f * log1pf(__expf(-a.in[z + 18][i]));
    LAS float* scr = (LAS float*)(lds + wave * 8448);
    unsigned char* WB = (a.ws + z) + OFF_W;
    const int gw = blockIdx.x * NWAVE + wave, NGW = gridDim.x * NWAVE;
    for (int it = gw; it < 24576; it += NGW) {
        int r = it;
        if (r < 11264) { const int l = r / 2816, q = r % 2816, kb = q / 176, nb = q % 176;
            tr_item(a.in[z + 10] + (size_t)l * 1024 * 5632, 5632, 1024, (bf16_t*)(WB + W_FFN_IN) + (size_t)l * 5632 * 1024, nb * 32, kb * 64, 1, scr, lane); continue; }
        r -= 11264;
        if (r < 5632) { const int l = r / 1408, q = r % 1408, kb = q / 32, nb = q % 32;
            tr_item(a.in[z + 11] + (size_t)l * 2816 * 1024, 1024, 2816, (bf16_t*)(WB + W_FFN_OUT) + (size_t)l * 1024 * 2816, nb * 32, kb * 64, 0, scr, lane); continue; }
        r -= 5632;
        if (r < 3072) { const int j = r / 1536, q = r % 1536, kb = q / 96, nb = q % 96;
            tr_item(a.in[z + 12] + (size_t)j * 1024 * 3072, 3072, 1024, (bf16_t*)(WB + W_EV_IN) + (size_t)j * 3072 * 1024, nb * 32, kb * 64, 2, scr, lane); continue; }
        r -= 3072;
        if (r < 1536) { const int j = r / 768, q = r % 768, kb = q / 32, nb = q % 32;
            tr_item(a.in[z + 13] + (size_t)j * 1536 * 1024, 1024, 1536, (bf16_t*)(WB + W_EV_OUT) + (size_t)j * 1024 * 1536, nb * 32, kb * 64, 0, scr, lane); continue; }
        r -= 1536;
        if (r < 512) { const int blk = r >> 3, q = r & 7, kb = q >> 2, nb = q & 3; const int h = blk & 7, k = (blk >> 3) & 1, d = (blk >> 4) & 1, j = blk >> 5;
            tr_item(a.in[z + 16] + (size_t)blk * 16384, 128, 128, (bf16_t*)(WB + W_GATE) + (size_t)j * (2 * 8 * 256 * 128) + (size_t)((d * 8 + h) * 256 + k * 128) * 128, nb * 32, kb * 64, 0, scr, lane); continue; }
        r -= 512;
        if (r < 1536) { const int j = r / 768, q = r % 768, kb = q / 48, nb = q % 48;
            tr_item(a.in[z + 21] + (size_t)j * 1024 * 1536, 1536, 1024, (bf16_t*)(WB + W_OD_IN) + (size_t)j * 1536 * 1024, nb * 32, kb * 64, 0, scr, lane); continue; }
        r -= 1536;
        { const int j = r / 512, q = r % 512, kb = q / 32, nb = q % 32;
            tr_item(a.in[z + 22] + (size_t)j * 1024 * 1024, 1024, 1024, (bf16_t*)(WB + W_OD_OUT) + (size_t)j * 1024 * 1024, nb * 32, kb * 64, 0, scr, lane); }
    }
}

struct LnCtx { float* H; const float* MOD; bf16_t* A; const bf16_t* Y; const float* gam; const float* bet; float* outp; int l, which, lm, shi, sci, gi; bool final_, from_in; const float* xin; const float* cin; };
__device__ __forceinline__ const float* ln_src(const LnCtx& c, int row) { return c.from_in ? (row < ML ? c.xin + (size_t)row * 1024 : c.cin + (size_t)(row - ML) * 1024) : c.H + (size_t)row * 1024; }
struct LnPar { f32x4 g[4], gm[4], bt[4], sh[4], sc[4]; };
__device__ __forceinline__ void ln_load_par(const LnCtx& c, int lane, int ms, LnPar& p) {
    const float* gp = c.MOD + (size_t)(c.l * 9 + ms) * 6144 + c.gi * 1024;
    const float* shp = c.MOD + (size_t)(c.lm * 9 + ms) * 6144 + c.shi * 1024; const float* scp = c.MOD + (size_t)(c.lm * 9 + ms) * 6144 + c.sci * 1024;
#pragma unroll
    for (int j = 0; j < 4; ++j) { const int o = 4 * lane + 256 * j;
        if (c.which != 0) p.g[j] = *(const f32x4*)(gp + o);
        if (!c.final_) { p.sh[j] = *(const f32x4*)(shp + o); p.sc[j] = *(const f32x4*)(scp + o) + 1.0f; } }
}
__device__ __forceinline__ void ln_finish(const LnCtx& c, const LnPar& p, int lane, int row, f32x4 (&v)[4], const u32x2 (&yw)[4]) {
    if (c.which != 0) {
        float s = 0.f;
#pragma unroll
        for (int j = 0; j < 4; ++j) { const f32x4 g = p.g[j];
            v[j][0] = ALPHA * v[j][0] + g[0] * bf_lo(yw[j].x); v[j][1] = ALPHA * v[j][1] + g[1] * bf_hi(yw[j].x); v[j][2] = ALPHA * v[j][2] + g[2] * bf_lo(yw[j].y); v[j][3] = ALPHA * v[j][3] + g[3] * bf_hi(yw[j].y);
            s += (v[j][0] + v[j][1]) + (v[j][2] + v[j][3]); }
        const float mean = wave_sum(s) * (1.0f / 1024.0f); float s2 = 0.f;
#pragma unroll
        for (int j = 0; j < 4; ++j) { v[j] = v[j] - mean; s2 += (v[j][0] * v[j][0] + v[j][1] * v[j][1]) + (v[j][2] * v[j][2] + v[j][3] * v[j][3]); }
        const float rstd = rsqrtf(wave_sum(s2) * (1.0f / 1024.0f) + 1e-6f);
        float* dst = c.final_ ? c.outp + (size_t)row * 1024 : c.H + (size_t)row * 1024;
#pragma unroll
        for (int j = 0; j < 4; ++j) { v[j] = v[j] * rstd * p.gm[j] + p.bt[j]; __builtin_nontemporal_store(v[j], (f32x4*)(dst + 4 * lane + 256 * j)); }
    }
    if (!c.final_) {
#pragma unroll
        for (int j = 0; j < 4; ++j) { const f32x4 o = v[j] * p.sc[j] + p.sh[j]; u32x2 w; w.x = cvt_pk_bf16(o[0], o[1]); w.y = cvt_pk_bf16(o[2], o[3]);
            *(u32x2*)(c.A + (size_t)row * 1024 + 4 * lane + 256 * j) = w; }
    }
}
__device__ __forceinline__ void phase_ln(const KArgs& a, const int z, const int tid, int l, int which, const int r_lo, const int r_hi, const int vb, const int nvb) {
    const int lane = tid & 63, wave = tid >> 6;
    const int gw = vb * NWAVE + wave, NGW = nvb * NWAVE;
    LnCtx c;
    c.H = (float*)((a.ws + z) + OFF_H); c.MOD = (const float*)((a.ws + z) + OFF_MOD);
    c.A = (bf16_t*)((a.ws + z) + OFF_R2); c.Y = (const bf16_t*)((a.ws + z) + OFF_R2 + SZ_ROWS_BF);
    c.final_ = (l == 3 && which == 2); c.from_in = (which == 0) || (which == 1 && l == 0);
    c.gam = which == 1 ? a.in[z + 6] + l * 1024 : a.in[z + 8] + l * 1024; c.bet = which == 1 ? a.in[z + 7] + l * 1024 : a.in[z + 9] + l * 1024;
    c.l = l; c.which = which; c.lm = which == 0 ? 0 : (which == 1 ? l : l + 1); c.shi = which == 1 ? 3 : 0; c.sci = which == 1 ? 4 : 1; c.gi = which == 1 ? 2 : 5;
    c.outp = (a.out + z); c.xin = a.in[z + 0]; c.cin = a.in[z + 2];
    const int per = (r_hi - r_lo + NGW - 1) / NGW, w_lo = r_lo + gw * per, w_hi = (w_lo + per < r_hi) ? w_lo + per : r_hi;
    LnPar p; int cur_ms = -1;
    if (which != 0) {
#pragma unroll
        for (int j = 0; j < 4; ++j) { p.gm[j] = *(const f32x4*)(c.gam + 4 * lane + 256 * j); p.bt[j] = *(const f32x4*)(c.bet + 4 * lane + 256 * j); } }
    for (int row0 = w_lo; row0 < w_hi; row0 += 2) {
        const int row1 = row0 + 1; const bool has1 = row1 < w_hi;
        f32x4 v0[4], v1[4]; u32x2 y0[4], y1[4];
        const float* s0 = ln_src(c, row0); const float* s1 = ln_src(c, has1 ? row1 : row0);
#pragma unroll
        for (int j = 0; j < 4; ++j) { v0[j] = __builtin_nontemporal_load((const f32x4*)(s0 + 4 * lane + 256 * j)); v1[j] = __builtin_nontemporal_load((const f32x4*)(s1 + 4 * lane + 256 * j)); }
        if (which != 0) {
#pragma unroll
            for (int j = 0; j < 4; ++j) { y0[j] = __builtin_nontemporal_load((const u32x2*)(c.Y + (size_t)row0 * 1024 + 4 * lane + 256 * j)); y1[j] = __builtin_nontemporal_load((const u32x2*)(c.Y + (size_t)(has1 ? row1 : row0) * 1024 + 4 * lane + 256 * j)); } }
        else {
#pragma unroll
            for (int j = 0; j < 4; ++j) { y0[j] = (u32x2){0u, 0u}; y1[j] = (u32x2){0u, 0u}; } }
        { const int ms = row0 < ML ? (row0 >> 13) : 8; if (ms != cur_ms) { ln_load_par(c, lane, ms, p); cur_ms = ms; } }
        ln_finish(c, p, lane, row0, v0, y0);
        if (has1) { const int ms = row1 < ML ? (row1 >> 13) : 8; if (ms != cur_ms) { ln_load_par(c, lane, ms, p); cur_ms = ms; }
            ln_finish(c, p, lane, row1, v1, y1); }
    }
}

__device__ __forceinline__ void phase_gmlp(const KArgs& a, const int z, const int tid, int jl, LAS unsigned char* lds, const int vb, const int nvb) {
    const int lane = tid & 63, wave = tid >> 6;
    bf16_t* Z = (bf16_t*)((a.ws + z) + OFF_Z);
    LAS bf16_t* VNT = (LAS bf16_t*)lds;
    const float* Wsp = a.in[z + 19] + (size_t)jl * 4 * 128 * 128; const float* Bsp = a.in[z + 20] + (size_t)jl * 4 * 128;
    for (int ci = vb; ci < 528; ci += nvb) {
        const int row0 = ci < 512 ? ci * 128 : ML + (ci - 512) * 128;
        u32x4 wv[16];
#pragma unroll
        for (int rr = 0; rr < 16; ++rr) wv[rr] = *(const u32x4*)(Z + (size_t)(row0 + wave * 16 + rr) * 3072 + 1536 + 8 * lane);
        float s1[16], s2[16];
#pragma unroll
        for (int rr = 0; rr < 16; ++rr) { float x[8]; unpack8(wv[rr], x); float t1 = 0.f, t2 = 0.f;
#pragma unroll
            for (int e = 0; e < 8; ++e) { t1 += x[e]; t2 += x[e] * x[e]; }
            s1[rr] = t1; s2[rr] = t2; }
#pragma unroll
        for (int o = 1; o < 64; o <<= 1) {
#pragma unroll
            for (int rr = 0; rr < 16; ++rr) { s1[rr] += __shfl_xor(s1[rr], o); s2[rr] += __shfl_xor(s2[rr], o); } }
        const int p = wave * 16 + (lane & 15);
        for (int g = 0; g < 4; ++g) {
            if ((lane >> 4) == g) {
#pragma unroll
                for (int rr = 0; rr < 16; ++rr) { const int q = wave * 16 + rr; float x[8]; unpack8(wv[rr], x);
                    const float mean = s1[rr] * (1.0f / 512.0f), var = fmaxf(s2[rr] * (1.0f / 512.0f) - mean * mean, 0.f), rstd = rsqrtf(var + 1e-6f);
#pragma unroll
                    for (int e = 0; e < 8; e += 2) { const unsigned pk = cvt_pk_bf16((x[e] - mean) * rstd, (x[e + 1] - mean) * rstd);
                        VNT[(8 * (lane & 15) + e) * 136 + q] = (bf16_t)(pk & 0xffffu); VNT[(8 * (lane & 15) + e + 1) * 136 + q] = (bf16_t)(pk >> 16); } } }
            bf16x8 bfr[4];
            { const float* wp = Wsp + (size_t)(g * 128 + p) * 128 + 8 * (lane >> 4);
#pragma unroll
              for (int ks = 0; ks < 4; ++ks) { const f32x4 w0 = *(const f32x4*)(wp + 32 * ks), w1 = *(const f32x4*)(wp + 32 * ks + 4);
                  u32x4 pw; pw.x = cvt_pk_bf16(w0[0], w0[1]); pw.y = cvt_pk_bf16(w0[2], w0[3]); pw.z = cvt_pk_bf16(w1[0], w1[1]); pw.w = cvt_pk_bf16(w1[2], w1[3]); bfr[ks] = __builtin_bit_cast(bf16x8, pw); } }
            const float bias = Bsp[g * 128 + p];
            bf16_t* urow = Z + (size_t)(row0 + p) * 3072 + 1024 + g * 128;
            u32x2 uw[8];
#pragma unroll
            for (int dt = 0; dt < 8; ++dt) uw[dt] = *(const u32x2*)(urow + 16 * dt + 4 * (lane >> 4));
            __syncthreads();
#pragma unroll
            for (int dt = 0; dt < 8; ++dt) {
                f32x4 acc = (f32x4){0.f, 0.f, 0.f, 0.f};
#pragma unroll
                for (int ks = 0; ks < 4; ++ks) { const bf16x8 af = *(const LAS bf16x8*)(VNT + (16 * dt + (lane & 15)) * 136 + 32 * ks + 8 * (lane >> 4));
                    acc = __builtin_amdgcn_mfma_f32_16x16x32_bf16(af, bfr[ks], acc, 0, 0, 0); }
                u32x2 o; o.x = cvt_pk_bf16(bf_lo(uw[dt].x) * (acc[0] + bias), bf_hi(uw[dt].x) * (acc[1] + bias)); o.y = cvt_pk_bf16(bf_lo(uw[dt].y) * (acc[2] + bias), bf_hi(uw[dt].y) * (acc[3] + bias));
                *(u32x2*)(urow + 16 * dt + 4 * (lane >> 4)) = o;
            }
            __syncthreads();
        }
    }
}
__device__ __forceinline__ void phase_conv(const KArgs& a, const int z, const int tid, int jl, const int rg_lo, const int nrg, const int vb, const int nvb) {
    bf16_t* Z = (bf16_t*)((a.ws + z) + OFF_Z);
    bf16_t* XC = (bf16_t*)((unsigned char*)(a.out + z) + DO_XC);
    const float* cw = a.in[z + 14] + (size_t)jl * 4 * 1024; const float* cb = a.in[z + 15] + (size_t)jl * 1024;
    for (int idx = vb * NTHR + tid; idx < nrg * 128; idx += nvb * NTHR) {
        const int rg = rg_lo + (idx >> 7), c0 = (idx & 127) * 8, row0 = rg * 16;
        int t0, len; if (row0 < ML) { t0 = row0 & 8191; len = SEQ; } else { t0 = (row0 - ML) & 255; len = CTXL; }
        u32x4 xw[19];
#pragma unroll
        for (int i = 0; i < 19; ++i) { const int tt = t0 - 2 + i; xw[i] = (u32x4){0u, 0u, 0u, 0u};
            if (tt >= 0 && tt < len) xw[i] = *(const u32x4*)(Z + (size_t)(row0 - 2 + i) * 3072 + 2048 + c0); }
        float wk[4][8], bs[8];
#pragma unroll
        for (int k = 0; k < 4; ++k) { const f32x4 w0 = *(const f32x4*)(cw + k * 1024 + c0), w1 = *(const f32x4*)(cw + k * 1024 + c0 + 4);
            wk[k][0] = w0[0]; wk[k][1] = w0[1]; wk[k][2] = w0[2]; wk[k][3] = w0[3]; wk[k][4] = w1[0]; wk[k][5] = w1[1]; wk[k][6] = w1[2]; wk[k][7] = w1[3]; }
        { const f32x4 b0 = *(const f32x4*)(cb + c0), b1 = *(const f32x4*)(cb + c0 + 4); bs[0] = b0[0]; bs[1] = b0[1]; bs[2] = b0[2]; bs[3] = b0[3]; bs[4] = b1[0]; bs[5] = b1[1]; bs[6] = b1[2]; bs[7] = b1[3]; }
#pragma unroll
        for (int r = 0; r < 16; ++r) {
            float o[8];
#pragma unroll
            for (int e = 0; e < 8; ++e) o[e] = bs[e];
#pragma unroll
            for (int k = 0; k < 4; ++k) { const u32x4 w = xw[r + k];
                o[0] += bf_lo(w.x) * wk[k][0]; o[1] += bf_hi(w.x) * wk[k][1]; o[2] += bf_lo(w.y) * wk[k][2]; o[3] += bf_hi(w.y) * wk[k][3];
                o[4] += bf_lo(w.z) * wk[k][4]; o[5] += bf_hi(w.z) * wk[k][5]; o[6] += bf_lo(w.w) * wk[k][6]; o[7] += bf_hi(w.w) * wk[k][7]; }
            u32x4 ow; ow.x = cvt_pk_bf16(o[0], o[1]); ow.y = cvt_pk_bf16(o[2], o[3]); ow.z = cvt_pk_bf16(o[4], o[5]); ow.w = cvt_pk_bf16(o[6], o[7]);
            *(u32x4*)(XC + (size_t)(row0 + r) * 1024 + c0) = ow;
        }
    }
}

__device__ __forceinline__ int scan_row_p(int d, int b, int p) {
    if (p < 256) return ML + b * 256 + (d == 0 ? p : 255 - p);
    const int t = p - 256; return b * SEQ + (d == 0 ? t : 8191 - t);
}
template <int PASS, int DIR, int NB>
__device__ __forceinline__ void scan_body(const KArgs& a, const int z, const int tid) {
    const bf16_t* LA = (const bf16_t*)((a.ws + z) + OFF_R2); const bf16_t* BBp = (const bf16_t*)((a.ws + z) + OFF_R2 + SZ_ROWS_BF);
    bf16_t* Z = (bf16_t*)((a.ws + z) + OFF_Z);
    float* SUMM = (float*)((unsigned char*)(a.out + z) + DO_SUMM); const float* CAR = (const float*)((unsigned char*)(a.out + z) + DO_CARRY);
    const int sub = tid >> 7, ch = (tid & 127) * 8;
    for (int blk = blockIdx.x; blk < 512; blk += gridDim.x) {
        const int item = blk * 4 + sub, b = item >> 8, sc = item & 255, p0 = sc * 33;
        float h[8], P[8];
#pragma unroll
        for (int e = 0; e < 8; ++e) { h[e] = 0.f; P[e] = 0.f; }
        if (PASS == 2) { const f32x4 c0 = *(const f32x4*)(CAR + (size_t)item * 1024 + ch), c1 = *(const f32x4*)(CAR + (size_t)item * 1024 + ch + 4);
            h[0] = c0[0]; h[1] = c0[1]; h[2] = c0[2]; h[3] = c0[3]; h[4] = c1[0]; h[5] = c1[1]; h[6] = c1[2]; h[7] = c1[3]; }
        for (int i0 = 0; i0 < 33; i0 += NB) {
            u32x4 lw[NB], bw[NB], fw[NB], gw[NB]; int rows[NB];
#pragma unroll
            for (int i = 0; i < NB; ++i) { rows[i] = scan_row_p(DIR, b, p0 + i0 + i);
                if (PASS == 2) { lw[i] = __builtin_nontemporal_load((const u32x4*)(LA + (size_t)rows[i] * 1024 + ch)); bw[i] = __builtin_nontemporal_load((const u32x4*)(BBp + (size_t)rows[i] * 1024 + ch)); }
                else { lw[i] = *(const u32x4*)(LA + (size_t)rows[i] * 1024 + ch); bw[i] = *(const u32x4*)(BBp + (size_t)rows[i] * 1024 + ch); }
                if (PASS == 2 && DIR == 1) { fw[i] = *(const u32x4*)(Z + (size_t)rows[i] * 3072 + 2048 + ch); gw[i] = *(const u32x4*)(Z + (size_t)rows[i] * 3072 + ch); } }
#pragma unroll
            for (int i = 0; i < NB; ++i) { float l[8], bb[8]; unpack8(lw[i], l); unpack8(bw[i], bb);
#pragma unroll
                for (int e = 0; e < 8; ++e) { h[e] = __builtin_amdgcn_exp2f(l[e] * LOG2E) * h[e] + bb[e]; if (PASS == 1) P[e] += l[e]; }
                if (PASS == 2 && DIR == 0) { u32x4 o; o.x = cvt_pk_bf16(h[0], h[1]); o.y = cvt_pk_bf16(h[2], h[3]); o.z = cvt_pk_bf16(h[4], h[5]); o.w = cvt_pk_bf16(h[6], h[7]);
                    *(u32x4*)(Z + (size_t)rows[i] * 3072 + 2048 + ch) = o; }
                if (PASS == 2 && DIR == 1) { float f[8], g[8]; unpack8(fw[i], f); unpack8(gw[i], g);
                    u32x4 o; o.x = cvt_pk_bf16(g[0] * (f[0] + h[0]), g[1] * (f[1] + h[1])); o.y = cvt_pk_bf16(g[2] * (f[2] + h[2]), g[3] * (f[3] + h[3]));
                    o.z = cvt_pk_bf16(g[4] * (f[4] + h[4]), g[5] * (f[5] + h[5])); o.w = cvt_pk_bf16(g[6] * (f[6] + h[6]), g[7] * (f[7] + h[7]));
                    *(u32x4*)(Z + (size_t)rows[i] * 3072 + ch) = o; }
            }
        }
        if (PASS == 1) { float* sp = SUMM + ((size_t)item * 1024 + ch) * 2;
#pragma unroll
            for (int e = 0; e < 8; e += 2) *(f32x4*)(sp + 2 * e) = (f32x4){P[e], h[e], P[e + 1], h[e + 1]}; }
    }
}
__device__ __forceinline__ void phase_scan(const KArgs& a, const int z, const int tid, int d, int pass) {
    if (pass == 1) { if (d == 0) scan_body<1, 0, 11>(a, z, tid); else scan_body<1, 1, 11>(a, z, tid); }
    else { if (d == 0) scan_body<2, 0, 11>(a, z, tid); else scan_body<2, 1, 3>(a, z, tid); }
}
__device__ __forceinline__ void phase_carry(const KArgs& a, const int z, const int tid, LAS unsigned char* lds) {
    const float* SUMM = (const float*)((unsigned char*)(a.out + z) + DO_SUMM); float* CAR = (float*)((unsigned char*)(a.out + z) + DO_CARRY);
    LAS float* segP = (LAS float*)lds; LAS float* segS = (LAS float*)(lds + 2048);
    const int seg = tid >> 6, cl = tid & 63;
    for (int blk = blockIdx.x; blk < 128; blk += gridDim.x) {
        const int b = blk >> 4, ch = (blk & 15) * 64 + cl; const size_t o0 = (size_t)(b * 256 + seg * 32) * 1024 + ch;
        f32x2 s[32];
#pragma unroll
        for (int k = 0; k < 32; ++k) s[k] = *(const f32x2*)(SUMM + (o0 + (size_t)k * 1024) * 2);
        float ps = 0.f, sa = 0.f;
#pragma unroll
        for (int k = 0; k < 32; ++k) { sa = __builtin_amdgcn_exp2f(s[k].x * LOG2E) * sa + s[k].y; ps += s[k].x; }
        segP[seg * 64 + cl] = ps; segS[seg * 64 + cl] = sa;
        __syncthreads();
        float c = 0.f;
        for (int j = 0; j < seg; ++j) c = __builtin_amdgcn_exp2f(segP[j * 64 + cl] * LOG2E) * c + segS[j * 64 + cl];
#pragma unroll
        for (int k = 0; k < 32; ++k) { CAR[o0 + (size_t)k * 1024] = c; c = __builtin_amdgcn_exp2f(s[k].x * LOG2E) * c + s[k].y; }
        __syncthreads();
    }
}

__device__ __forceinline__ void phase_qkpost(const KArgs& a, const int z, const int tid, int jl, const int r_lo, const int nrows, const int vb, const int nvb) {
    const bf16_t* Zq = (const bf16_t*)((a.ws + z) + OFF_Z + ZO_QKV); bf16_t* KK = (bf16_t*)((a.ws + z) + OFF_Z + ZO_KK); bf16_t* VV = (bf16_t*)((unsigned char*)(a.out + z) + DO_VV);
    const float* kn = a.in[z + 24] + jl * 64;
    for (int idx = vb * NTHR + tid; idx < 8 * nrows; idx += nvb * NTHR) {
        const int s8 = idx / nrows, row = r_lo + (idx - s8 * nrows), slot = 16 + s8;
        const bool lat = row < ML; const int t = lat ? (row & 8191) : ((row - ML) & 255), b = lat ? (row >> 13) : ((row - ML) >> 8);
        const int kvrow = lat ? 256 + t : t, type = slot >= 20, hh = slot & 1;
        const bf16_t* src = Zq + (size_t)row * 1536 + slot * 64;
        const size_t dsto = ((size_t)((type * 8 + b) * 2 + hh) * KVR + kvrow) * 64;
        u32x4 w[8];
#pragma unroll
        for (int c = 0; c < 8; ++c) w[c] = *(const u32x4*)(src + 8 * c);
        if (slot & 2) {
#pragma unroll
            for (int c = 0; c < 8; ++c) *(u32x4*)(VV + dsto + 8 * c) = w[c];
            continue; }
        float v[64];
#pragma unroll
        for (int c = 0; c < 8; ++c) { v[8 * c] = bf_lo(w[c].x); v[8 * c + 1] = bf_hi(w[c].x); v[8 * c + 2] = bf_lo(w[c].y); v[8 * c + 3] = bf_hi(w[c].y); v[8 * c + 4] = bf_lo(w[c].z); v[8 * c + 5] = bf_hi(w[c].z); v[8 * c + 6] = bf_lo(w[c].w); v[8 * c + 7] = bf_hi(w[c].w); }
        if (type == 0) { float ss = 0.f;
#pragma unroll
            for (int dd = 0; dd < 64; ++dd) ss += v[dd] * v[dd];
            const float r = rsqrtf(ss * (1.0f / 64.0f) + 1e-6f);
#pragma unroll
            for (int dd = 0; dd < 64; ++dd) v[dd] = v[dd] * r * kn[dd]; }
        if (lat) { const float pr = (float)(t >> 6), pc = (float)(t & 63);
#pragma unroll
            for (int f = 0; f < 16; ++f) { const float invf = exp2f(-(float)f * 0.8304820237218406f) * 0.15915494309189535f;
                { const float rev = pr * invf, cs = __builtin_amdgcn_cosf(rev), sn = __builtin_amdgcn_sinf(rev); const float x1 = v[f], x2 = v[16 + f]; v[f] = x1 * cs - x2 * sn; v[16 + f] = x2 * cs + x1 * sn; }
                { const float rev = pc * invf, cs = __builtin_amdgcn_cosf(rev), sn = __builtin_amdgcn_sinf(rev); const float x1 = v[32 + f], x2 = v[48 + f]; v[32 + f] = x1 * cs - x2 * sn; v[48 + f] = x2 * cs + x1 * sn; } } }
#pragma unroll
        for (int c = 0; c < 8; ++c) { u32x4 o; o.x = cvt_pk_bf16(v[8 * c], v[8 * c + 1]); o.y = cvt_pk_bf16(v[8 * c + 2], v[8 * c + 3]); o.z = cvt_pk_bf16(v[8 * c + 4], v[8 * c + 5]); o.w = cvt_pk_bf16(v[8 * c + 6], v[8 * c + 7]);
            *(u32x4*)(KK + dsto + 8 * c) = o; }
    }
}

namespace attn_body {
using bf16=__hip_bfloat16;
using bf16x8=__attribute__((ext_vector_type(8)))short;
using s16x4=__attribute__((ext_vector_type(4)))short;
using f32x16=__attribute__((ext_vector_type(16)))float;
using u32x4=__attribute__((ext_vector_type(4)))unsigned;
constexpr int D=64;
constexpr int NW=8,QBLK=32,QB=QBLK*NW,KVBLK=64;
constexpr int ATTN_UNIT_ROWS=QB;
__device__ __forceinline__ int crow(int r,int hi){return (r&3)+8*(r>>2)+4*hi;}
#define SBAR() __builtin_amdgcn_sched_barrier(0)
constexpr int NSLOT=3, SLOTB=8192;
constexpr int LDS_K=0, LDS_V=NSLOT*SLOTB, LDS_WS=2*NSLOT*SLOTB, LDS_OST=LDS_WS+NW*64*4, LDS_BYTES=LDS_OST+NW*4096;
constexpr float C2=0.125f*1.4426950408889634f;
__device__ __forceinline__ void glds16(const void*gsrc,unsigned lds_dst){unsigned keep;
  asm volatile("s_mov_b32 %0, m0\n\ts_mov_b32 m0, %2\n\ts_nop 0\n\tglobal_load_lds_dwordx4 %1, off\n\ts_mov_b32 m0, %0":"=&s"(keep):"v"(gsrc),"s"(lds_dst):"memory");}
__device__ __forceinline__ float max3f(float a,float b,float c){float r;asm("v_max3_f32 %0, %1, %2, %3":"=v"(r):"v"(a),"v"(b),"v"(c));return r;}
__device__ __forceinline__ float max2f(float a,float b){float r;asm("v_max_f32_e32 %0, %1, %2":"=v"(r):"v"(a),"v"(b));return r;}
__device__ __forceinline__ float fadd_s(float a,float b){float r;asm("v_add_f32_e32 %0, %1, %2":"=v"(r):"v"(a),"v"(b));return r;}
__device__ __forceinline__ float fsub_s(float a,float b){float r;asm("v_sub_f32_e32 %0, %1, %2":"=v"(r):"v"(a),"v"(b));return r;}
typedef float f32x2_t __attribute__((ext_vector_type(2))); typedef __bf16 bf16x2_t __attribute__((ext_vector_type(2)));
__device__ __forceinline__ unsigned cvtpk_s(float lo,float hi){f32x2_t v={lo,hi};bf16x2_t b=__builtin_convertvector(v,bf16x2_t);return __builtin_bit_cast(unsigned,b);}
#define WAIT_BAR(N) asm volatile("s_waitcnt vmcnt(" #N ") lgkmcnt(0)\n\ts_barrier":::"memory")

__device__ __forceinline__ void qkt(f32x16&p0,f32x16&p1,const char*Kslot,const bf16x8*qr,const f32x16&negm,int r32,int hi){
  const char*kb=Kslot+hi*1024+r32*16;
  #pragma unroll
  for(int d0=0;d0<4;++d0){
    const bf16x8 b0=*reinterpret_cast<const bf16x8*>(kb+d0*2048);
    const bf16x8 b1=*reinterpret_cast<const bf16x8*>(kb+d0*2048+512);
    if(d0==0){p0=__builtin_amdgcn_mfma_f32_32x32x16_bf16(b0,qr[0],negm,0,0,0);p1=__builtin_amdgcn_mfma_f32_32x32x16_bf16(b1,qr[0],negm,0,0,0);}
    else{p0=__builtin_amdgcn_mfma_f32_32x32x16_bf16(b0,qr[d0],p0,0,0,0);p1=__builtin_amdgcn_mfma_f32_32x32x16_bf16(b1,qr[d0],p1,0,0,0);}}
}
typedef __attribute__((address_space(3))) const char* lds_cptr;
typedef short v4i16_t __attribute__((ext_vector_type(4)));
__device__ __forceinline__ void kload8(bf16x8*kf,lds_cptr kp){
  kf[0]=*(const __attribute__((address_space(3))) bf16x8*)(kp);      kf[1]=*(const __attribute__((address_space(3))) bf16x8*)(kp+512);
  kf[2]=*(const __attribute__((address_space(3))) bf16x8*)(kp+2048); kf[3]=*(const __attribute__((address_space(3))) bf16x8*)(kp+2560);
  kf[4]=*(const __attribute__((address_space(3))) bf16x8*)(kp+4096); kf[5]=*(const __attribute__((address_space(3))) bf16x8*)(kp+4608);
  kf[6]=*(const __attribute__((address_space(3))) bf16x8*)(kp+6144); kf[7]=*(const __attribute__((address_space(3))) bf16x8*)(kp+6656);
}
__device__ __forceinline__ void kload2(bf16x8*kf,lds_cptr kp,int j){ kf[2*j]=*(const __attribute__((address_space(3))) bf16x8*)(kp+j*2048); kf[2*j+1]=*(const __attribute__((address_space(3))) bf16x8*)(kp+j*2048+512); }
__device__ __forceinline__ s16x4 vtr(lds_cptr p){ return __builtin_bit_cast(s16x4,__builtin_amdgcn_ds_read_tr16_b64_v4i16((__attribute__((address_space(3))) v4i16_t*)p)); }
__device__ __forceinline__ float rowmax(const f32x16&p0,const f32x16&p1){
  float a=max3f(p0[0],p0[1],p1[0]),b=max3f(p0[2],p0[3],p1[1]);a=max3f(a,p1[2],p1[3]);
  #pragma unroll
  for(int r=4;r<16;r+=4){a=max3f(a,p0[r],p0[r+1]);b=max3f(b,p0[r+2],p0[r+3]);a=max3f(a,p1[r],p1[r+1]);b=max3f(b,p1[r+2],p1[r+3]);}
  const float m=max2f(a,b);
  auto rr=__builtin_amdgcn_permlane32_swap(__float_as_uint(m),__float_as_uint(m),false,false);
  return max2f(__uint_as_float(rr[0]),__uint_as_float(rr[1]));
}
__device__ __forceinline__ void pv(f32x16*o,int vb,bf16x8 pa0,bf16x8 pa1,bf16x8 pa2,bf16x8 pa3){
  #pragma unroll
  for(int d0=0;d0<2;++d0){s16x4 lo[4],hi[4];
    #pragma unroll
    for(int ks=0;ks<4;++ks){
      asm volatile("ds_read_b64_tr_b16 %0,%1 offset:%c2":"=&v"(lo[ks]):"v"(vb),"i"(d0*4096+ks*1024):"memory");
      asm volatile("ds_read_b64_tr_b16 %0,%1 offset:%c2":"=&v"(hi[ks]):"v"(vb),"i"(d0*4096+ks*1024+512):"memory");}
    asm volatile("s_waitcnt lgkmcnt(0)":::"memory");SBAR();
    #define PK(k) (bf16x8){lo[k][0],lo[k][1],lo[k][2],lo[k][3],hi[k][0],hi[k][1],hi[k][2],hi[k][3]}
    o[d0]=__builtin_amdgcn_mfma_f32_32x32x16_bf16(pa0,PK(0),o[d0],0,0,0);
    o[d0]=__builtin_amdgcn_mfma_f32_32x32x16_bf16(pa1,PK(1),o[d0],0,0,0);
    o[d0]=__builtin_amdgcn_mfma_f32_32x32x16_bf16(pa2,PK(2),o[d0],0,0,0);
    o[d0]=__builtin_amdgcn_mfma_f32_32x32x16_bf16(pa3,PK(3),o[d0],0,0,0);
    #undef PK
  }
}

#ifndef ATTN_STORE16
#define ATTN_STORE16(p,v) (*(u32x4*)(p)=(v))
#endif
__device__ __forceinline__ void wmask(f32x16&p0,f32x16&p1,int t,int wid,int r32,int hi,int q0){
  const float NEG=-INFINITY; const int ks=q0-128+64*(t-4);
  if(ks<0||ks>=8192){
    #pragma unroll
    for(int r=0;r<16;++r){p0[r]=NEG;p1[r]=NEG;}
    return; }
  const int lo=64*(t-4)-128-(wid*32+31), hi_=64*(t-4)-128+63-wid*32;
  if(lo>=-128&&hi_<=128)return;
  const int base=64*(t-4)-128+4*hi-(wid*32+r32);
  #pragma unroll
  for(int r=0;r<16;++r){const int d0=base+(r&3)+8*(r>>2), d1=d0+32; if(d0>128||d0<-128)p0[r]=NEG; if(d1>128||d1<-128)p1[r]=NEG;}
}
template<int THRL,bool WIN> __device__ __forceinline__ void attn_unit(const bf16*Qb,int PQ,const bf16*__restrict__ Kh,int PK,const bf16*__restrict__ Vh,int PV,bf16*Ob,int PO,const int NT,char*shm,const int tid,const int q0,const float sink2,const float*qg,const int tpos0){
  const int lane=tid&63,r32=lane&31,hi=lane>>5; const int wid=__builtin_amdgcn_readfirstlane(tid>>6);
  const bf16*Qw=Qb+(long)(wid*QBLK)*PQ;
  const unsigned lds0=(unsigned)(uintptr_t)shm;
  float*wsf=(float*)(shm+LDS_WS)+wid*64;
  const bf16*ksrc=Kh+(long)lane*PK+wid*8;
  const bf16*vsrc=Vh+(long)(16*(wid&3)+(lane>>2))*PV+(wid>>2)*32+(lane&3)*8;
  const unsigned kdst=lds0+LDS_K+wid*1024, vdst=lds0+LDS_V+wid*1024;
  #define KOFF(t) ((WIN&&(t)>=4)?min(max(64*(t)+q0-128,0),8448-64):64*(t))
  #define DMA_K(t,slot) glds16(ksrc+(long)KOFF(t)*PK,(unsigned)__builtin_amdgcn_readfirstlane(kdst+(slot)))
  #define DMA_V(t,slot) glds16(vsrc+(long)KOFF(t)*PV,(unsigned)__builtin_amdgcn_readfirstlane(vdst+(slot)))
  const int vb0=(int)(lds0+LDS_V)+((lane>>4)&1)*32+(lane&3)*8+(4*hi+((lane&15)>>2))*64;
  const char*Kbase=shm+LDS_K; bf16x8 kf[8];
  const lds_cptr shm3=(lds_cptr)shm; const lds_cptr kp0=shm3+LDS_K+hi*1024+r32*16; const lds_cptr vp0=shm3+LDS_V+((lane>>4)&1)*32+(lane&3)*8+(4*hi+((lane&15)>>2))*64;
  DMA_K(0,0);DMA_V(0,0);DMA_K(1,SLOTB);
  bf16x8 qr[4];
  #pragma unroll
  for(int d0=0;d0<4;++d0)qr[d0]=*reinterpret_cast<const bf16x8*>(&Qw[(long)r32*PQ+d0*16+hi*8]);
  {
    float x[32];
    #pragma unroll
    for(int d0=0;d0<4;++d0){
      #pragma unroll
      for(int e=0;e<8;++e)x[8*d0+e]=__uint_as_float(((unsigned)(unsigned short)qr[d0][e])<<16);}
    if(qg){float ss=0.f;
      #pragma unroll
      for(int i=0;i<32;++i)ss+=x[i]*x[i];
      ss+=__shfl_xor(ss,32);
      const float rn=rsqrtf(ss*(1.0f/64.0f)+1e-6f);
      #pragma unroll
      for(int d0=0;d0<4;++d0){
        #pragma unroll
        for(int e=0;e<8;++e)x[8*d0+e]*=rn*qg[16*d0+8*hi+e];}}
    if(tpos0>=0){const int tq=tpos0+wid*QBLK+r32; const float pr=(float)(tq>>6),pc=(float)(tq&63);
      #pragma unroll
      for(int e=0;e<8;++e){const float invf=__builtin_amdgcn_exp2f(-(float)(8*hi+e)*0.8304820237218406f)*0.15915494309189535f;
        {const float rev=pr*invf,cs=__builtin_amdgcn_cosf(rev),sn=__builtin_amdgcn_sinf(rev);const float x1=x[e],x2=x[8+e];x[e]=x1*cs-x2*sn;x[8+e]=x2*cs+x1*sn;}
        {const float rev=pc*invf,cs=__builtin_amdgcn_cosf(rev),sn=__builtin_amdgcn_sinf(rev);const float x1=x[16+e],x2=x[24+e];x[16+e]=x1*cs-x2*sn;x[24+e]=x2*cs+x1*sn;}}}
    #pragma unroll
    for(int d0=0;d0<4;++d0){u32x4 w;w.x=cvtpk_s(x[8*d0]*C2,x[8*d0+1]*C2);w.y=cvtpk_s(x[8*d0+2]*C2,x[8*d0+3]*C2);w.z=cvtpk_s(x[8*d0+4]*C2,x[8*d0+5]*C2);w.w=cvtpk_s(x[8*d0+6]*C2,x[8*d0+7]*C2);qr[d0]=__builtin_bit_cast(bf16x8,w);}
  }
  float mhat=0.f,l_reg=0.f;f32x16 o[2];o[0]=f32x16{};o[1]=f32x16{};f32x16 negm=f32x16{}; if constexpr(!WIN){asm volatile("":"+v"(negm));}
  #define CMASK(P0,P1,t) do{ if(WIN&&(t)>=4) wmask(P0,P1,(t),wid,r32,hi,q0); }while(0)
  bool resc=false;
  #define START(P0,P1) do{ const float rm=rowmax(P0,P1); resc=false; \
    { const float dl=rm; mhat=fadd_s(mhat,dl); \
      _Pragma("unroll") for(int r=0;r<16;++r){P0[r]=fsub_s(P0[r],dl);P1[r]=fsub_s(P1[r],dl);} \
      if constexpr(!WIN){ _Pragma("unroll") for(int r=0;r<16;++r)negm[r]=-mhat; asm volatile("":"+v"(negm)); } } \
    _Pragma("unroll") for(int r=0;r<16;++r)P0[r]=__builtin_amdgcn_exp2f(P0[r]); }while(0)
  #define RESC() do{ if(resc){ asm volatile("s_waitcnt lgkmcnt(0)":::"memory"); \
      _Pragma("unroll") for(int d_=0;d_<2;++d_) _Pragma("unroll") for(int r=0;r<16;++r)o[d_][r]*=wsf[crow(r,hi)]; } }while(0)
  f32x16 pA0,pA1,pB0,pB1;
  int sl_prev=0,sl_cur=0,sl_next=SLOTB;
  #define ROT() do{sl_prev=sl_cur;sl_cur=sl_next;sl_next=(sl_next==(NSLOT-1)*SLOTB)?0:sl_next+SLOTB;}while(0)
  DMA_K(2,2*SLOTB);
  WAIT_BAR(3);
  qkt(pA0,pA1,Kbase,qr,(WIN?f32x16{}:negm),r32,hi);asm volatile("s_nop 15\n\ts_nop 7":"+v"(pA0),"+v"(pA1));CMASK(pA0,pA1,0);
  START(pA0,pA1);
  _Pragma("unroll") for(int r=0;r<16;++r)pA1[r]=__builtin_amdgcn_exp2f(pA1[r]);
  WAIT_BAR(0);
  DMA_K(3,0);DMA_V(1,SLOTB);
  ROT();
  kload8(kf,kp0+sl_cur);
  WAIT_BAR(2);
  s16x4 vlo[8],vhi[8]; u32x4 pw0,pw1,pw2,pw3;
  #define PKW(P,B) cvtpk_s(P[B],P[B+1])
  #define PAF(k) __builtin_bit_cast(bf16x8,pw##k)
  #define VFR(i) (bf16x8){vlo[i][0],vlo[i][1],vlo[i][2],vlo[i][3],vhi[i][0],vhi[i][1],vhi[i][2],vhi[i][3]}
  #define PIN(x) asm volatile("":"+v"(x))
  #define MX3(a,b,c) __builtin_fmaxf(__builtin_fmaxf((a),(b)),(c))
  #define GAPA(MF,A0,A1,A2,A3,W0,W1,PW) do{ MF; sacc+=A0; sacc+=A1; sacc+=A2; sacc+=A3; PIN(sacc); W0; W1; PIN(PW); SBAR(); }while(0)
  #define EX(v) __builtin_amdgcn_exp2f(v)
  #define GAPB(MF,X,B) do{ MF; X[B]=EX(X[B]); X[B+1]=EX(X[B+1]); X[B+2]=EX(X[B+2]); X[B+3]=EX(X[B+3]); PIN(X); SBAR(); }while(0)
  #define VRD(i) do{ vlo[i]=vtr(vp_+(((i)>>2)*4096+((i)&3)*1024)); vhi[i]=vtr(vp_+(((i)>>2)*4096+((i)&3)*1024+512)); }while(0)
  #define KRD(G,j) do{ if(G){ kload2(kf,kp0+sl_next,j); SBAR(); } }while(0)
  #define STEP(C0,C1,P0,P1,t,GK,GV,GL) do{ SBAR(); \
    const lds_cptr vp_=vp0+sl_prev; \
    VRD(0); SBAR(); float sacc=(P0[0]+P0[1]); \
    GAPA(C0=__builtin_amdgcn_mfma_f32_32x32x16_bf16(kf[0],qr[0],(WIN?f32x16{}:negm),0,0,0), P0[2],P0[3],P0[4],P0[5],     pw0[0]=PKW(P0,0), pw0[1]=PKW(P0,2), pw0); \
    VRD(4); SBAR(); GAPA(C1=__builtin_amdgcn_mfma_f32_32x32x16_bf16(kf[1],qr[0],(WIN?f32x16{}:negm),0,0,0), P0[6],P0[7],P0[8],P0[9],     pw0[2]=PKW(P0,4), pw0[3]=PKW(P0,6), pw0); \
    VRD(1); SBAR(); GAPA(C0=__builtin_amdgcn_mfma_f32_32x32x16_bf16(kf[2],qr[1],C0,0,0,0),   P0[10],P0[11],P0[12],P0[13], pw1[0]=PKW(P0,8), pw1[1]=PKW(P0,10), pw1); \
    VRD(5); SBAR(); GAPA(C1=__builtin_amdgcn_mfma_f32_32x32x16_bf16(kf[3],qr[1],C1,0,0,0),   P0[14],P0[15],P1[0],P1[1],   pw1[2]=PKW(P0,12),pw1[3]=PKW(P0,14), pw1); \
    VRD(2); SBAR(); GAPA(C0=__builtin_amdgcn_mfma_f32_32x32x16_bf16(kf[4],qr[2],C0,0,0,0),   P1[2],P1[3],P1[4],P1[5],     pw2[0]=PKW(P1,0), pw2[1]=PKW(P1,2), pw2); \
    VRD(6); SBAR(); GAPA(C1=__builtin_amdgcn_mfma_f32_32x32x16_bf16(kf[5],qr[2],C1,0,0,0),   P1[6],P1[7],P1[8],P1[9],     pw2[2]=PKW(P1,4), pw2[3]=PKW(P1,6), pw2); \
    VRD(3); SBAR(); GAPA(C0=__builtin_amdgcn_mfma_f32_32x32x16_bf16(kf[6],qr[3],C0,0,0,0),   P1[10],P1[11],P1[12],P1[13], pw3[0]=PKW(P1,8), pw3[1]=PKW(P1,10), pw3); \
    VRD(7); SBAR(); GAPA(C1=__builtin_amdgcn_mfma_f32_32x32x16_bf16(kf[7],qr[3],C1,0,0,0),   P1[14],P1[15],0.f,0.f,       pw3[2]=PKW(P1,12),pw3[3]=PKW(P1,14), pw3); \
    l_reg+=sacc; \
    if(GK){DMA_K((t)+3,sl_cur);} if(GV){DMA_V((t)+1,sl_next);} \
    if constexpr(WIN){ _Pragma("unroll") for(int r=0;r<16;++r){C0[r]-=mhat;C1[r]-=mhat;} } \
    CMASK(C0,C1,t); \
    { float a=MX3(C0[0],C0[1],C1[0]),b=MX3(C0[2],C0[3],C1[1]); a=MX3(a,C1[2],C1[3]); \
      _Pragma("unroll") for(int r=4;r<16;r+=4){a=MX3(a,C0[r],C0[r+1]);b=MX3(b,C0[r+2],C0[r+3]);a=MX3(a,C1[r],C1[r+1]);b=MX3(b,C1[r+2],C1[r+3]);} \
      float rm=__builtin_fmaxf(a,b); { auto rr=__builtin_amdgcn_permlane32_swap(__float_as_uint(rm),__float_as_uint(rm),false,false); rm=__builtin_fmaxf(__uint_as_float(rr[0]),__uint_as_float(rr[1])); } \
      resc=false; \
      if(__builtin_expect(__any(rm>(float)THRL),0)){ const float dl=__builtin_fmaxf(rm,0.f); mhat+=dl; \
        _Pragma("unroll") for(int r=0;r<16;++r){C0[r]-=dl;C1[r]-=dl;} \
        if constexpr(!WIN){ _Pragma("unroll") for(int r=0;r<16;++r)negm[r]=-mhat; asm volatile("":"+v"(negm)); } \
        const float f=__builtin_amdgcn_exp2f(-dl); l_reg*=f; if(hi==0)wsf[r32]=f; resc=true; } } \
    SBAR(); \
    GAPB(o[0]=__builtin_amdgcn_mfma_f32_32x32x16_bf16(PAF(0),VFR(0),o[0],0,0,0), C0,0); \
    GAPB(o[1]=__builtin_amdgcn_mfma_f32_32x32x16_bf16(PAF(0),VFR(4),o[1],0,0,0), C0,4); \
    KRD(GL,0); GAPB(o[0]=__builtin_amdgcn_mfma_f32_32x32x16_bf16(PAF(1),VFR(1),o[0],0,0,0), C0,8); \
    KRD(GL,1); GAPB(o[1]=__builtin_amdgcn_mfma_f32_32x32x16_bf16(PAF(1),VFR(5),o[1],0,0,0), C0,12); \
    KRD(GL,2); GAPB(o[0]=__builtin_amdgcn_mfma_f32_32x32x16_bf16(PAF(2),VFR(2),o[0],0,0,0), C1,0); \
    KRD(GL,3); GAPB(o[1]=__builtin_amdgcn_mfma_f32_32x32x16_bf16(PAF(2),VFR(6),o[1],0,0,0), C1,4); \
    GAPB(o[0]=__builtin_amdgcn_mfma_f32_32x32x16_bf16(PAF(3),VFR(3),o[0],0,0,0), C1,8); \
    GAPB(o[1]=__builtin_amdgcn_mfma_f32_32x32x16_bf16(PAF(3),VFR(7),o[1],0,0,0), C1,12); \
    }while(0)
  int t=1;
  #undef CMASK
  #define CMASK(P0,P1,t) do{ if(WIN&&(t)>=4) wmask(P0,P1,(t),wid,r32,hi,q0); }while(0)
  for(;t+5<NT;t+=2){
    STEP(pB0,pB1,pA0,pA1,t,true,true,true);     WAIT_BAR(2); RESC(); ROT();
    STEP(pA0,pA1,pB0,pB1,t+1,true,true,true);   WAIT_BAR(2); RESC(); ROT();
  }
  #undef CMASK
  #define CMASK(P0,P1,t) do{ if(WIN&&(t)>=4) wmask(P0,P1,(t),wid,r32,hi,q0); }while(0)
  #define ENDW(tt) do{ if((tt)+3<NT){WAIT_BAR(2);} else if((tt)+2<NT){WAIT_BAR(1);} else {WAIT_BAR(0);} }while(0)
  for(;t+1<NT;t+=2){
    STEP(pB0,pB1,pA0,pA1,t,(t+3<NT),(t+1<NT),(t+1<NT));       ENDW(t);   RESC(); ROT();
    STEP(pA0,pA1,pB0,pB1,t+1,(t+4<NT),(t+2<NT),(t+2<NT));     ENDW(t+1); RESC(); ROT();
  }
  STEP(pB0,pB1,pA0,pA1,NT-1,false,false,false); RESC();
  { float sacc=pB0[0]+pB0[1]; _Pragma("unroll") for(int r=2;r<16;++r)sacc+=pB0[r]; _Pragma("unroll") for(int r=0;r<16;++r)sacc+=pB1[r]; l_reg+=sacc;
    pw0=(u32x4){PKW(pB0,0),PKW(pB0,2),PKW(pB0,4),PKW(pB0,6)};pw1=(u32x4){PKW(pB0,8),PKW(pB0,10),PKW(pB0,12),PKW(pB0,14)};pw2=(u32x4){PKW(pB1,0),PKW(pB1,2),PKW(pB1,4),PKW(pB1,6)};pw3=(u32x4){PKW(pB1,8),PKW(pB1,10),PKW(pB1,12),PKW(pB1,14)};
    SBAR(); pv(o,vb0+sl_cur,PAF(0),PAF(1),PAF(2),PAF(3)); }
  #undef PKW
  #undef PAF
  #undef VFR
  #undef PIN
  #undef MX3
  #undef GAPA
  #undef GAPB
  #undef EX
  #undef VRD
  #undef KRD
  #undef STEP
  #undef ENDW
  {auto rr=__builtin_amdgcn_permlane32_swap(__float_as_uint(l_reg),__float_as_uint(l_reg),false,false);l_reg=__uint_as_float(rr[0])+__uint_as_float(rr[1]);}
  if(WIN)l_reg+=__builtin_amdgcn_exp2f(__uint_as_float(__builtin_amdgcn_readfirstlane(__float_as_uint(sink2)))-mhat);
  if(hi==0)wsf[32+r32]=l_reg;asm volatile("s_waitcnt lgkmcnt(0)":::"memory");
  float rli[16];
  #pragma unroll
  for(int r=0;r<16;++r)rli[r]=__builtin_amdgcn_rcpf(wsf[32+crow(r,hi)]);
  bf16*Ow=Ob+(long)(wid*QBLK)*PO;
  { bf16*stg=(bf16*)(shm+LDS_OST)+wid*2048;
    #pragma unroll
    for(int r=0;r<16;++r){const int orow=crow(r,hi);
      #pragma unroll
      for(int d0=0;d0<2;++d0)stg[orow*64+d0*32+r32]=__float2bfloat16(o[d0][r]*rli[r]);}
    asm volatile("s_waitcnt lgkmcnt(0)":::"memory");
    #pragma unroll
    for(int i=0;i<4;++i){const int row=i*8+(lane>>3),ch=lane&7; const u32x4 v=*(const u32x4*)(stg+row*64+ch*8); ATTN_STORE16(Ow+(long)row*PO+ch*8,v);} }
  asm volatile("s_waitcnt lgkmcnt(0)\n\ts_barrier":::"memory");
  #undef DMA_K
  #undef KOFF
  #undef DMA_V
  #undef CMASK
  #undef START
  #undef RESC
  #undef ROT
}
constexpr int ATTN_LDS_BYTES=LDS_BYTES;
#undef SBAR
#undef WAIT_BAR
}
__device__ __forceinline__ unsigned long long phase_attn(const KArgs& a, const int z, const int tid, int jl, bool with_ctx, char* lds_gen) {
    const int lane = tid & 63, wave = tid >> 6, l15 = lane & 15, lg = lane >> 4;
    const bf16_t* Zq = (const bf16_t*)((a.ws + z) + OFF_Z + ZO_QKV); const bf16_t* KK = (const bf16_t*)((a.ws + z) + OFF_Z + ZO_KK); const bf16_t* VT = (const bf16_t*)((a.ws + z) + OFF_Z + ZO_VT);
    bf16_t* O = (bf16_t*)((a.ws + z) + OFF_Z + ZO_O);
    const float* sinkp = a.in[z + 25] + jl * 8; const float* qn = a.in[z + 23] + jl * 64;
    const int gw = blockIdx.x * NWAVE + wave, NGW = gridDim.x * NWAVE;
    const int nitems = with_ctx ? 16384 + 512 : 16384;
    {
        const bf16_t* VV = (const bf16_t*)((unsigned char*)(a.out + z) + DO_VV);
        const int G = gridDim.x, bx = blockIdx.x, vcu = (G % 8 == 0) ? (bx % 8) * (G / 8) + bx / 8 : bx, per = (2048 + G - 1) / G;
        for (int i = 0; i < per; ++i) { const int u = vcu * per + i; if (u >= 2048) break;
            const int b = (u >> 8) & 7, qb = (u >> 3) & 31, h = u & 7, g = h >> 2;
            attn_body::attn_unit<8, false>((const attn_body::bf16*)(Zq + (size_t)(b * SEQ + qb * 256) * 1536 + h * 64), 1536,
                                    (const attn_body::bf16*)(KK + (size_t)(b * 2 + g) * KVR * 64), 64, (const attn_body::bf16*)(VV + (size_t)(b * 2 + g) * KVR * 64), 64,
                                    (attn_body::bf16*)(O + (size_t)(b * SEQ + qb * 256) * 1024 + h * 64), 1024, KVR / 64, lds_gen, tid, 0, 0.f, qn, qb * 256); }
        for (int i = 0; i < per; ++i) { const int u = vcu * per + i; if (u >= 2048) break;
            const int b = (u >> 8) & 7, qb = (u >> 3) & 31, h = u & 7, g = h >> 2;
            attn_body::attn_unit<8, true>((const attn_body::bf16*)(Zq + (size_t)(b * SEQ + qb * 256) * 1536 + 512 + h * 64), 1536,
                                    (const attn_body::bf16*)(KK + (size_t)((8 + b) * 2 + g) * KVR * 64), 64, (const attn_body::bf16*)(VV + (size_t)((8 + b) * 2 + g) * KVR * 64), 64,
                                    (attn_body::bf16*)(O + (size_t)(b * SEQ + qb * 256) * 1024 + 512 + h * 64), 1024, 12, lds_gen, tid, qb * 256, sinkp[h] * LOG2E, nullptr, qb * 256); }
        if (with_ctx) {
            for (int u = vcu; u < 128; u += G) { const int type = u >> 6, b = (u >> 3) & 7, h = u & 7, g = h >> 2;
                attn_body::attn_unit<8, true>((const attn_body::bf16*)(Zq + (size_t)(ML + b * CTXL) * 1536 + type * 512 + h * 64), 1536,
                                    (const attn_body::bf16*)(KK + (size_t)((type * 8 + b) * 2 + g) * KVR * 64), 64, (const attn_body::bf16*)(VV + (size_t)((type * 8 + b) * 2 + g) * KVR * 64), 64,
                                    (attn_body::bf16*)(O + (size_t)(ML + b * CTXL) * 1024 + type * 512 + h * 64), 1024, 4, lds_gen, tid, 0, type ? sinkp[h] * LOG2E : -1e30f, type ? nullptr : qn, -1); }
        }
    }
    return 0ull;
#if 0
    const unsigned long long t_simple0 = __builtin_amdgcn_s_memrealtime();
    for (int item = 8192 + gw; item < nitems; item += NGW) {
        int mode, bg, qtile;
        if (item < 8192) { mode = 0; bg = item >> 9; qtile = item & 511; }
        else if (item < 16384) { mode = 1; bg = (item - 8192) >> 9; qtile = item & 511; }
        else if (item < 16384 + 256) { mode = 2; bg = (item - 16384) >> 4; qtile = item & 15; }
        else { mode = 3; bg = (item - 16640) >> 4; qtile = item & 15; }
        const int b = bg >> 1, g = bg & 1, type = mode & 1;
        const int rowbase = (mode < 2) ? b * SEQ + 16 * qtile : ML + b * CTXL + 16 * qtile;
        const int qcol = type * 512 + g * 256;
        const bf16_t* Kb = KK + (size_t)((type * 8 + b) * 2 + g) * KVR * 64;
        const bf16_t* Vb = VT + (size_t)((type * 8 + b) * 2 + g) * 64 * KVR;
        const int nA = (mode == 0) ? 264 : 8;
        int lo = 0, nB = 0; const int q0 = 16 * qtile;
        if (mode == 1) { lo = q0 >= 128 ? ((q0 - 128) >> 5) : 0; int hi = ((q0 + 143) >> 5) + 1; if (hi > 256) hi = 256; nB = hi - lo; }
        const int ntot = nA + nB;
        bf16x8 qf[4][2];
        { const bf16_t* qp = Zq + (size_t)(rowbase + l15) * 1536 + qcol + 8 * lg;
#pragma unroll
          for (int qt = 0; qt < 4; ++qt)
#pragma unroll
              for (int ks = 0; ks < 2; ++ks) qf[qt][ks] = *(const bf16x8*)(qp + 64 * qt + 32 * ks); }
        f32x4 oacc[4][4]; float mrun[4], lsum[4];
#pragma unroll
        for (int qt = 0; qt < 4; ++qt) { mrun[qt] = -1e30f; lsum[qt] = 0.f;
#pragma unroll
            for (int dt = 0; dt < 4; ++dt) oacc[qt][dt] = (f32x4){0.f, 0.f, 0.f, 0.f}; }
        bf16x8 kf[2][2]; u32x2 vlo[4], vhi[4];
        const bf16_t* kp = Kb + (size_t)l15 * 64 + 8 * lg; const bf16_t* vp = Vb + (size_t)l15 * KVR + 4 * lg;
#define LOAD_KV(KF, VLO, VHI, kvrow0) do { \
        _Pragma("unroll") for (int kt = 0; kt < 2; ++kt) _Pragma("unroll") for (int ks = 0; ks < 2; ++ks) KF[kt][ks] = *(const bf16x8*)(kp + (size_t)((kvrow0) + 16 * kt) * 64 + 32 * ks); \
        _Pragma("unroll") for (int dt = 0; dt < 4; ++dt) { VLO[dt] = *(const u32x2*)(vp + (size_t)(16 * dt) * KVR + (kvrow0)); VHI[dt] = *(const u32x2*)(vp + (size_t)(16 * dt) * KVR + (kvrow0) + 16); } } while (0)
        LOAD_KV(kf, vlo, vhi, 0);
        for (int blk = 0; blk < ntot; ++blk) {
            const int nb_ = (blk + 1 < ntot) ? blk + 1 : blk;
            const int kvnext = nb_ < nA ? 32 * nb_ : 256 + 32 * (lo + nb_ - nA);
            bf16x8 kfn[2][2]; u32x2 vlon[4], vhin[4];
            LOAD_KV(kfn, vlon, vhin, kvnext);
            const bool masked = blk >= nA; const int kpos0 = 32 * (lo + blk - nA) + 4 * lg;
            bf16x8 vf[4];
#pragma unroll
            for (int dt = 0; dt < 4; ++dt) { u32x4 w; w.x = vlo[dt].x; w.y = vlo[dt].y; w.z = vhi[dt].x; w.w = vhi[dt].y; vf[dt] = __builtin_bit_cast(bf16x8, w); }
#pragma unroll
            for (int qt = 0; qt < 4; ++qt) {
                f32x4 s0 = (f32x4){0.f, 0.f, 0.f, 0.f}, s1 = (f32x4){0.f, 0.f, 0.f, 0.f};
                s0 = __builtin_amdgcn_mfma_f32_16x16x32_bf16(kf[0][0], qf[qt][0], s0, 0, 0, 0); s0 = __builtin_amdgcn_mfma_f32_16x16x32_bf16(kf[0][1], qf[qt][1], s0, 0, 0, 0);
                s1 = __builtin_amdgcn_mfma_f32_16x16x32_bf16(kf[1][0], qf[qt][0], s1, 0, 0, 0); s1 = __builtin_amdgcn_mfma_f32_16x16x32_bf16(kf[1][1], qf[qt][1], s1, 0, 0, 0);
                if (masked) { const int qpos = q0 + l15;
#pragma unroll
                    for (int r = 0; r < 4; ++r) { const int d0 = kpos0 + r - qpos, d1 = d0 + 16;
                        if (d0 > 128 || d0 < -128) s0[r] = -1e30f; if (d1 > 128 || d1 < -128) s1[r] = -1e30f; } }
                float mx = fmaxf(fmaxf(fmaxf(s0[0], s0[1]), fmaxf(s0[2], s0[3])), fmaxf(fmaxf(s1[0], s1[1]), fmaxf(s1[2], s1[3])));
                mx = fmaxf(mx, __shfl_xor(mx, 16)); mx = fmaxf(mx, __shfl_xor(mx, 32));
                if (__any(mx > mrun[qt])) {
                    const float mnew = fmaxf(mrun[qt], mx), al = __builtin_amdgcn_exp2f(mrun[qt] - mnew); mrun[qt] = mnew; lsum[qt] *= al;
#pragma unroll
                    for (int dt = 0; dt < 4; ++dt) oacc[qt][dt] = oacc[qt][dt] * al; }
                const float mnew = mrun[qt];
                float ps = 0.f;
#pragma unroll
                for (int r = 0; r < 4; ++r) { s0[r] = __builtin_amdgcn_exp2f(s0[r] - mnew); s1[r] = __builtin_amdgcn_exp2f(s1[r] - mnew); ps += s0[r] + s1[r]; }
                lsum[qt] += ps;
                u32x4 pw; pw.x = cvt_pk_bf16(s0[0], s0[1]); pw.y = cvt_pk_bf16(s0[2], s0[3]); pw.z = cvt_pk_bf16(s1[0], s1[1]); pw.w = cvt_pk_bf16(s1[2], s1[3]);
                const bf16x8 pf = __builtin_bit_cast(bf16x8, pw);
#pragma unroll
                for (int dt = 0; dt < 4; ++dt) oacc[qt][dt] = __builtin_amdgcn_mfma_f32_16x16x32_bf16(vf[dt], pf, oacc[qt][dt], 0, 0, 0);
            }
#pragma unroll
            for (int kt = 0; kt < 2; ++kt)
#pragma unroll
                for (int ks = 0; ks < 2; ++ks) kf[kt][ks] = kfn[kt][ks];
#pragma unroll
            for (int dt = 0; dt < 4; ++dt) { vlo[dt] = vlon[dt]; vhi[dt] = vhin[dt]; }
        }
#undef LOAD_KV
#pragma unroll
        for (int qt = 0; qt < 4; ++qt) { float lt = lsum[qt]; lt += __shfl_xor(lt, 16); lt += __shfl_xor(lt, 32);
            if (type == 1) lt += __builtin_amdgcn_exp2f(sinkp[4 * g + qt] * LOG2E - mrun[qt]);
            const float inv = 1.0f / lt;
            bf16_t* op = O + (size_t)(rowbase + l15) * 1024 + qcol + 64 * qt + 4 * lg;
#pragma unroll
            for (int dt = 0; dt < 4; ++dt) { u32x2 w; w.x = cvt_pk_bf16(oacc[qt][dt][0] * inv, oacc[qt][dt][1] * inv); w.y = cvt_pk_bf16(oacc[qt][dt][2] * inv, oacc[qt][dt][3] * inv);
                *(u32x2*)(op + 16 * dt) = w; } }
    }
    return __builtin_amdgcn_s_memrealtime() - t_simple0;
#endif
}

#define RLX_AGENT __ATOMIC_RELAXED, __HIP_MEMORY_SCOPE_AGENT
#define XB_TMO      128
#define XB_XCNT(j)  (256  + 64 * (j))
#define XB_XSUB(j)  (1280 + 64 * (j))
#define XB_XGEN(j)  (2304 + 64 * (j))
#define XB_TOP      3328
#define XB_TOPGEN   3392
#define XCD_BAR_WORDS 3456
#define XB_SPIN_CAP (1u << 18)

__device__ __forceinline__ unsigned xb_ld(unsigned* p)              { return __hip_atomic_load(p, __ATOMIC_RELAXED, __HIP_MEMORY_SCOPE_AGENT); }
__device__ __forceinline__ unsigned xb_add(unsigned* p, unsigned v) { return __hip_atomic_fetch_add(p, v, __ATOMIC_RELAXED, __HIP_MEMORY_SCOPE_AGENT); }
__device__ __forceinline__ unsigned xb_xcc_id() { return (unsigned)__builtin_amdgcn_s_getreg((3 << 11) | 20) & 0xFu; }
#define XB_SPIN(cond, bar) do { unsigned _sp = 0; while (cond) { __builtin_amdgcn_s_sleep(1); \
    if ((++_sp & 255u) == 0u) { if (xb_ld(&(bar)[XB_TMO])) break; if (_sp > XB_SPIN_CAP) { atomicAdd(&(bar)[XB_TMO], 1u); break; } } } } while (0)

struct XcdBarrier {
    unsigned* bar; unsigned x;
    volatile LAS unsigned* st;
};

__device__ __forceinline__ XcdBarrier xcd_barrier_post(unsigned* bar, volatile LAS unsigned* st) {
    XcdBarrier b; b.bar = bar; b.x = xb_xcc_id(); b.st = st;
    if (threadIdx.x == 0) (void)xb_add(&bar[XB_XCNT(b.x)], 1u);
    return b;
}
__device__ __forceinline__ void xcd_barrier_complete(unsigned* bar, unsigned x, unsigned& nloc, unsigned& nx) {
    const unsigned G = gridDim.x * gridDim.y * gridDim.z;
    unsigned sum, cnt, mine, sp = 0u;
    for (;;) {
        sum = 0u; cnt = 0u; mine = 0u;
#pragma unroll
        for (unsigned j = 0; j < 16; ++j) { const unsigned c = xb_ld(&bar[XB_XCNT(j)]); sum += c; cnt += (c > 0u) ? 1u : 0u; mine = (j == x) ? c : mine; }
        if (sum == G) break;
        __builtin_amdgcn_s_sleep(1);
        if ((++sp & 255u) == 0u) { if (xb_ld(&bar[XB_TMO])) break; if (sp > XB_SPIN_CAP) { atomicAdd(&bar[XB_TMO], 1u); break; } }
    }
    nloc = mine > 0u ? mine : 1u; nx = cnt > 0u ? cnt : 1u;
}

__device__ __forceinline__ void xcd_barrier(const XcdBarrier& b) {
    asm volatile("s_waitcnt vmcnt(0)" ::: "memory");
    __syncthreads();
    if (threadIdx.x == 0) {
        unsigned* bar = b.bar;
        __builtin_amdgcn_s_waitcnt(0);
        unsigned nloc = b.st[0], nx = b.st[1];
        if (nloc == 0u) { xcd_barrier_complete(bar, b.x, nloc, nx); b.st[0] = nloc; b.st[1] = nx; }
        const unsigned old = xb_add(&bar[XB_XSUB(b.x)], 1u);
        const unsigned gen = old / nloc;
        if (old + 1u == (gen + 1u) * nloc) {
            __builtin_amdgcn_fence(__ATOMIC_RELEASE, "agent");
            asm volatile("s_waitcnt vmcnt(0)" ::: "memory");
            const unsigned og = xb_add(&bar[XB_TOP], 1u);
            const unsigned tg = og / nx;
            if (og + 1u == (tg + 1u) * nx) xb_add(&bar[XB_TOPGEN], 1u);
            else XB_SPIN(xb_ld(&bar[XB_TOPGEN]) == tg, bar);
            __builtin_amdgcn_fence(__ATOMIC_ACQUIRE, "agent");
            xb_add(&bar[XB_XGEN(b.x)], 1u);
            asm volatile("s_waitcnt vmcnt(0)" ::: "memory");
        } else {
            XB_SPIN(xb_ld(&bar[XB_XGEN(b.x)]) == gen, bar);
            __builtin_amdgcn_fence(__ATOMIC_ACQUIRE, "agent");
            asm volatile("s_waitcnt vmcnt(0)" ::: "memory");
        }
    }
    __syncthreads();
}

__global__ void __launch_bounds__(NTHR, 2) trunk_fwd(KArgs a) {
    extern __shared__ __attribute__((aligned(16))) unsigned char lds_raw[];
    LAS unsigned char* lds = (LAS unsigned char*)lds_raw;
    cg::grid_group grid = cg::this_grid();
    if (threadIdx.x < 16) ((LAS unsigned*)(lds + 131072))[threadIdx.x] = 0u;
    __syncthreads();
    const XcdBarrier xbar = xcd_barrier_post((unsigned*)(a.ws + OFF_BAR), (volatile LAS unsigned*)(lds + 131072 + 32));
#ifdef PROBE_KIND
    unsigned long long t_acc = 0;
#endif
    for (int si = a.step_lo; si < a.step_hi; ++si) {
        int tid = threadIdx.x; asm volatile("" : "+v"(tid));
        int z = 0; asm volatile("" : "+s"(z));
        unsigned char* ws = a.ws + z; unsigned char* WB = ws + OFF_W;
        const int st = a.steps[si], kind = st & 0xff, l = (st >> 8) & 0xf, arg = (st >> 12) & 0xf, jl = l >> 1;
        const int Mrows = (l == 3) ? ML : MALL;
#ifdef PROBE_KIND
        const unsigned long long t_0 = __builtin_amdgcn_s_memrealtime();
#endif
#ifdef ONLY
        if (kind != ONLY) continue;
#endif
        switch (kind) {
        case K_PROLOGUE: phase_prologue(a, z, tid, lds); break;
        case K_MOD0: phase_ln(a, z, tid, 0, 0, 0, MALL, blockIdx.x, gridDim.x); break;
        case K_LN: { const int which = arg & 3; const bool ctx_only = (arg >> 2) & 1;
            phase_ln(a, z, tid, l, which, ctx_only ? ML : 0, (l == 3) ? ML : MALL, blockIdx.x, gridDim.x); break; }
        case K_GEMM_EVIN: {
            const bool latonly = (arg >> 2) & 1, tail = (arg >> 3) & 1;
            pg8::Gemm g{(const bf16_t*)(ws + OFF_R2), (const bf16_t*)(WB + W_EV_IN) + (size_t)jl * 3072 * 1024, MALL, 3072, 1024, 1024, 0};
            EpiStore E{(bf16_t*)(ws + OFF_Z), 3072, 8};
            int M_ = MALL, G_ = gridDim.x; bool do_gemm = true;
            if (latonly) M_ = ML;
            if (tail) { g.A += (size_t)ML * 1024; E.O += (size_t)ML * 3072; M_ = MC; G_ = 96; do_gemm = blockIdx.x < 96; }
            g.M = M_;
            if (do_gemm) { pg8::StaticOrder S; S.init(M_, 3072, G_, blockIdx.x); pg8::gemm_phase<EpiStore, true>(tid, lds, g, S, E); }
            else phase_conv(a, z, tid, jl, 0, ML / 16, blockIdx.x - 96, gridDim.x - 96);
            break; }
        case K_GEMM_PLAIN: {
            const int pk = arg & 3; const bool latonly = (arg >> 2) & 1, tail = (arg >> 3) & 1;
            pg8::Gemm g; EpiStore E; int M_, N_;
            if (pk == PL_EVOUT) { g = pg8::Gemm{(const bf16_t*)(ws + OFF_Z), (const bf16_t*)(WB + W_EV_OUT) + (size_t)jl * 1024 * 1536, MALL, 1024, 1536, 3072, 0}; M_ = MALL; N_ = 1024; E = EpiStore{(bf16_t*)(ws + OFF_R2 + SZ_ROWS_BF), 1024, 0}; }
            else if (pk == PL_ODIN) { g = pg8::Gemm{(const bf16_t*)(ws + OFF_R2), (const bf16_t*)(WB + W_OD_IN) + (size_t)jl * 1536 * 1024, MALL, 1536, 1024, 1024, 0}; M_ = MALL; N_ = 1536; E = EpiStore{(bf16_t*)(ws + OFF_Z + ZO_QKV), 1536, 0}; }
            else if (pk == PL_ODOUT) { g = pg8::Gemm{(const bf16_t*)(ws + OFF_Z + ZO_O), (const bf16_t*)(WB + W_OD_OUT) + (size_t)jl * 1024 * 1024, Mrows, 1024, 1024, 1024, 0}; M_ = Mrows; N_ = 1024; E = EpiStore{(bf16_t*)(ws + OFF_R2 + SZ_ROWS_BF), 1024, 0}; }
            else { g = pg8::Gemm{(const bf16_t*)(ws + OFF_Z), (const bf16_t*)(WB + W_FFN_OUT) + (size_t)l * 1024 * 2816, Mrows, 1024, 2816, 2816, 0}; M_ = Mrows; N_ = 1024; E = EpiStore{(bf16_t*)(ws + OFF_R2 + SZ_ROWS_BF), 1024, 0}; }
            int G_ = gridDim.x; bool do_gemm = true;
            if (latonly) M_ = ML;
            const int tg = 8 * (N_ / 256);
            if (tail) { g.A += (size_t)ML * g.lda; E.O += (size_t)ML * E.ldc; M_ = MC; G_ = tg; do_gemm = blockIdx.x < tg; }
            g.M = M_;
            if (do_gemm) { pg8::StaticOrder S; S.init(M_, N_, G_, blockIdx.x); pg8::gemm_phase<EpiStore, true>(tid, lds, g, S, E); }
            else if (pk == PL_ODIN) phase_qkpost(a, z, tid, jl, 0, ML, blockIdx.x - tg, gridDim.x - tg);
            else phase_ln(a, z, tid, l, pk == PL_FFNOUT ? 2 : 1, 0, ML, blockIdx.x - tg, gridDim.x - tg);
            break; }
        case K_GEMM_SWIGLU: {
            pg8::Gemm g{(const bf16_t*)(ws + OFF_R2), (const bf16_t*)(WB + W_FFN_IN) + (size_t)l * 5632 * 1024, Mrows, 5632, 1024, 1024, 0};
            pg8::StaticOrder S; S.init(Mrows, 5632, gridDim.x, blockIdx.x);
            EpiSwiglu E{(bf16_t*)(ws + OFF_Z), 2816};
            pg8::gemm_phase<EpiSwiglu, true>(tid, lds, g, S, E); break; }
        case K_GEMM_GATE: {
            const int d = arg;
            pg8::Gemm g{(const bf16_t*)((unsigned char*)(a.out + z) + DO_XC), (const bf16_t*)(WB + W_GATE) + (size_t)jl * (2 * 8 * 256 * 128) + (size_t)d * 8 * 256 * 128, MALL, 2048, 128, 1024, 256};
            pg8::StaticOrder S; S.init(MALL, 2048, gridDim.x, blockIdx.x);
            EpiGate E{(bf16_t*)(ws + OFF_R2), (bf16_t*)(ws + OFF_R2 + SZ_ROWS_BF), (const bf16_t*)((unsigned char*)(a.out + z) + DO_XC),
                      a.in[z + 17] + (size_t)((jl * 2 + d) * 2 + 0) * 1024, a.in[z + 17] + (size_t)((jl * 2 + d) * 2 + 1) * 1024, (const float*)(ws + OFF_SPL) + (size_t)(jl * 2 + d) * 1024};
            pg8::gemm_phase<EpiGate, true>(tid, lds, g, S, E); break; }
        case K_CONV_GMLP: if (arg & 4) phase_conv(a, z, tid, jl, ML / 16, MC / 16, blockIdx.x, gridDim.x); else phase_conv(a, z, tid, jl, 0, MALL / 16, blockIdx.x, gridDim.x); break;
        case K_SCAN1: phase_scan(a, z, tid, arg, 1); break;
        case K_CARRY:
            phase_carry(a, z, tid, lds);
            if (arg == 0) phase_gmlp(a, z, tid, jl, lds, blockIdx.x, gridDim.x);
            break;
        case K_SCAN2: phase_scan(a, z, tid, arg, 2); break;
        case K_QKPOST: if (arg & 4) phase_qkpost(a, z, tid, jl, ML, MC, blockIdx.x, gridDim.x); else phase_qkpost(a, z, tid, jl, 0, MALL, blockIdx.x, gridDim.x); break;
        case K_ATTN: { const unsigned long long ts_ = phase_attn(a, z, tid, jl, l != 3, (char*)lds_raw);
#ifdef PROBE_ATTN_SIMPLE
            t_acc += ts_;
#else
            (void)ts_;
#endif
            break; }
        case K_DUMP: {
            const float* H = (const float*)(ws + OFF_H); const bf16_t* A_ = (const bf16_t*)(ws + OFF_R2); const bf16_t* Y_ = (const bf16_t*)(ws + OFF_R2 + SZ_ROWS_BF); const bf16_t* Z_ = (const bf16_t*)(ws + OFF_Z);
            for (size_t i = (size_t)blockIdx.x * NTHR + tid; i < (size_t)ML * 1024; i += (size_t)gridDim.x * NTHR) { const size_t row = i >> 10, c = i & 1023;
                (a.out + z)[i] = H[i] + bf_lo(A_[i]) + bf_lo(Y_[i]) + bf_lo(Z_[row * 3072 + c]) + bf_lo(Z_[row * 3072 + 1024 + c]) + bf_lo(Z_[row * 3072 + 2048 + c]); }
            break; }
        default: break;
        }
        if (si + 1 < a.step_hi) { if (si == a.step_lo) grid.sync(); else xcd_barrier(xbar); }
#ifdef PROBE_KIND
        if (kind == PROBE_KIND) t_acc += __builtin_amdgcn_s_memrealtime() - t_0;
#endif
    }
#ifdef PROBE_KIND
    { const unsigned long long t_s = __builtin_amdgcn_s_memrealtime(); while (__builtin_amdgcn_s_memrealtime() - t_s < t_acc) __builtin_amdgcn_s_sleep(8); }
#endif
}

extern "C" void kernel_launch(void* const* d_in, const int* in_sizes, int n_in, void* d_out, int out_size, void* d_ws, size_t ws_size, hipStream_t stream) {
    static int grid = 0;
    if (grid == 0) {
        if (n_in != 26 || out_size != ML * 1024 || ws_size < WS_NEED) { fprintf(stderr, "kernel_launch: unexpected problem (n_in %d out %d ws %zu need %zu)\n", n_in, out_size, ws_size, (size_t)WS_NEED); grid = -1; return; }
        int dev = 0, cus = 0, per_cu = 0;
        (void)hipGetDevice(&dev); (void)hipDeviceGetAttribute(&cus, hipDeviceAttributeMultiprocessorCount, dev);
        if (hipFuncSetAttribute((const void*)trunk_fwd, hipFuncAttributeMaxDynamicSharedMemorySize, LDS_BYTES) != hipSuccess) fprintf(stderr, "kernel_launch: hipFuncSetAttribute failed\n");
        if (hipOccupancyMaxActiveBlocksPerMultiprocessor(&per_cu, (const void*)trunk_fwd, NTHR, LDS_BYTES) != hipSuccess || per_cu < 1) { fprintf(stderr, "kernel_launch: occupancy query says %d\n", per_cu); per_cu = 1; }
        (void)hipGetLastError();
        if (per_cu > 1) per_cu = 1;
        grid = cus * per_cu;
    }
    if (grid < 0) return;
    KArgs a{};
    for (int i = 0; i < 26; ++i) a.in[i] = (const float*)d_in[i];
    a.out = (float*)d_out; a.ws = (unsigned char*)d_ws;
    int n = 0;
#ifndef PROBE_DUP
#define PROBE_DUP 0
#endif
#define STEP(kind, l, arg) do { a.steps[n++] = (kind) | ((l) << 8) | ((arg) << 12); if ((PROBE_DUP >> (kind)) & 1) a.steps[n++] = (kind) | ((l) << 8) | ((arg) << 12); } while (0)
    STEP(K_PROLOGUE, 0, 0); STEP(K_MOD0, 0, 0);
    const bool split = grid >= 192;
    for (int l = 0; l < 4; ++l) {
        const bool sp = split && l != 3;
        if ((l & 1) == 0) {
            if (split) { STEP(K_GEMM_EVIN, l, 4); STEP(K_GEMM_EVIN, l, 8); STEP(K_CONV_GMLP, l, 4); } else { STEP(K_GEMM_EVIN, l, 0); STEP(K_CONV_GMLP, l, 0); }
            for (int d = 0; d < 2; ++d) { STEP(K_GEMM_GATE, l, d); STEP(K_SCAN1, l, d); STEP(K_CARRY, l, d); STEP(K_SCAN2, l, d); }
            if (sp) { STEP(K_GEMM_PLAIN, l, PL_EVOUT | 4); STEP(K_GEMM_PLAIN, l, PL_EVOUT | 8); STEP(K_LN, l, 1 | 4); } else { STEP(K_GEMM_PLAIN, l, PL_EVOUT); STEP(K_LN, l, 1); }
        } else {
            if (split) { STEP(K_GEMM_PLAIN, l, PL_ODIN | 4); STEP(K_GEMM_PLAIN, l, PL_ODIN | 8); STEP(K_QKPOST, l, 4); } else { STEP(K_GEMM_PLAIN, l, PL_ODIN); STEP(K_QKPOST, l, 0); }
            STEP(K_ATTN, l, 0);
            if (sp) { STEP(K_GEMM_PLAIN, l, PL_ODOUT | 4); STEP(K_GEMM_PLAIN, l, PL_ODOUT | 8); STEP(K_LN, l, 1 | 4); } else { STEP(K_GEMM_PLAIN, l, PL_ODOUT); STEP(K_LN, l, 1); }
        }
        STEP(K_GEMM_SWIGLU, l, 0);
        if (sp) { STEP(K_GEMM_PLAIN, l, PL_FFNOUT | 4); STEP(K_GEMM_PLAIN, l, PL_FFNOUT | 8); STEP(K_LN, l, 2 | 4); } else { STEP(K_GEMM_PLAIN, l, PL_FFNOUT); STEP(K_LN, l, 2); }
    }
#undef STEP
#ifdef TRUNC
    n = TRUNC; a.steps[n++] = K_DUMP;
#endif
    a.step_lo = 0; a.step_hi = n;
    (void)hipMemsetAsync((unsigned char*)d_ws + OFF_BAR, 0, 16384, stream);
    void* args[] = {&a};
#ifndef FORCE_MULTI
#define FORCE_MULTI 0
#endif
    hipError_t e = FORCE_MULTI ? hipErrorUnknown : hipLaunchCooperativeKernel((const void*)trunk_fwd, dim3(grid), dim3(NTHR), args, LDS_BYTES, stream);
    if (e != hipSuccess) {
        if (!FORCE_MULTI) fprintf(stderr, "kernel_launch: cooperative launch failed: %s (grid %d); falling back to one launch per step\n", hipGetErrorString(e), grid);
        (void)hipGetLastError();
        for (int s = 0; s < n; ++s) { a.step_lo = s; a.step_hi = s + 1; hipLaunchKernelGGL(trunk_fwd, dim3(grid), dim3(NTHR), LDS_BYTES, stream, a); }
    }
}
```

```cpp
#include <hip/hip_runtime.h>
#include <hip/hip_cooperative_groups.h>
#include <cstdio>
#include <cstdint>
#include <hip/hip_bf16.h>
#include <cmath>
namespace cg = cooperative_groups;

#define LAS __attribute__((address_space(3)))
typedef unsigned short bf16_t;
typedef short bf16x8 __attribute__((ext_vector_type(8)));
typedef float f32x4 __attribute__((ext_vector_type(4)));
typedef float f32x2 __attribute__((ext_vector_type(2)));
typedef unsigned u32x4 __attribute__((ext_vector_type(4)));
typedef unsigned u32x2 __attribute__((ext_vector_type(2)));

constexpr int DM = 1024, NB = 8, SEQ = 8192, CTXL = 256, ML = NB * SEQ, MC = NB * CTXL, MALL = ML + MC, FH = 2816, KVR = SEQ + CTXL;
constexpr int NTHR = 512, NWAVE = 8;
constexpr int LDS_BYTES = 131072 + 2048;
constexpr float ALPHA = 1.681792830507429f, LOG2E = 1.4426950408889634f;
constexpr float QSCALE = 0.125f * 1.4426950408889634f;

constexpr size_t SZ_ROWS_BF = (size_t)MALL * 1024 * 2;
constexpr size_t OFF_H = 0;
constexpr size_t OFF_W = OFF_H + (size_t)MALL * 1024 * 4;
constexpr size_t W_FFN_IN = 0;
constexpr size_t W_FFN_OUT = W_FFN_IN + 4ull * 5632 * 1024 * 2;
constexpr size_t W_EV_IN = W_FFN_OUT + 4ull * 1024 * 2816 * 2;
constexpr size_t W_EV_OUT = W_EV_IN + 2ull * 3072 * 1024 * 2;
constexpr size_t W_GATE = W_EV_OUT + 2ull * 1024 * 1536 * 2;
constexpr size_t W_OD_IN = W_GATE + 2ull * 2 * 8 * 256 * 128 * 2;
constexpr size_t W_OD_OUT = W_OD_IN + 2ull * 1536 * 1024 * 2;
constexpr size_t W_END = W_OD_OUT + 2ull * 1024 * 1024 * 2;
constexpr size_t OFF_MOD = OFF_W + W_END;
constexpr size_t OFF_Z = OFF_MOD + 4ull * 9 * 6144 * 4;
constexpr size_t OFF_R2 = OFF_Z + (size_t)MALL * 3072 * 2;
constexpr size_t OFF_SPL = OFF_R2 + 2 * SZ_ROWS_BF;
constexpr size_t OFF_BAR = OFF_SPL + 16384;
constexpr size_t WS_NEED = OFF_BAR + 16384;
constexpr size_t ZO_QKV = 0;
constexpr size_t ZO_O = (size_t)MALL * 1536 * 2;
constexpr size_t ZO_KK = ZO_O + SZ_ROWS_BF;
constexpr size_t ZO_VT = ZO_KK + 2ull * 8 * 2 * KVR * 64 * 2;
constexpr size_t DO_VV = 0;
constexpr size_t DO_XC = 0;
constexpr size_t DO_SUMM = SZ_ROWS_BF;
constexpr size_t DO_CARRY = DO_SUMM + 8ull * 264 * 1024 * 8;

struct KArgs {
    const float* in[26];
    float* out; unsigned char* ws;
    int step_lo, step_hi;
    int steps[96];
};
enum { K_PROLOGUE = 0, K_MOD0, K_GEMM_EVIN, K_CONV_GMLP, K_GEMM_GATE, K_SCAN1, K_CARRY, K_SCAN2, K_GEMM_PLAIN, K_LN, K_GEMM_SWIGLU, K_QKPOST, K_ATTN, K_DUMP };
enum { PL_EVOUT = 0, PL_ODIN, PL_ODOUT, PL_FFNOUT };

typedef __bf16 bf16x2_t __attribute__((ext_vector_type(2)));
__device__ __forceinline__ unsigned cvt_pk_bf16(float lo, float hi) { f32x2 v = {lo, hi}; bf16x2_t b = __builtin_convertvector(v, bf16x2_t); return __builtin_bit_cast(unsigned, b); }
__device__ __forceinline__ float bf_lo(unsigned w) { return __uint_as_float(w << 16); }
__device__ __forceinline__ float bf_hi(unsigned w) { return __uint_as_float(w & 0xffff0000u); }
__device__ __forceinline__ float fast_sigmoid(float x) { return __builtin_amdgcn_rcpf(1.0f + __builtin_amdgcn_exp2f(-x * LOG2E)); }
__device__ __forceinline__ float silu_f(float x) { return x * fast_sigmoid(x); }
__device__ __forceinline__ float gelu_tanh(float x) { const float u = x + 0.044715f * x * x * x; return x * __builtin_amdgcn_rcpf(1.0f + __builtin_amdgcn_exp2f(-2.0f * 0.7978845608028654f * LOG2E * u)); }
__device__ __forceinline__ void unpack8(const u32x4 w, float (&x)[8]) { x[0] = bf_lo(w.x); x[1] = bf_hi(w.x); x[2] = bf_lo(w.y); x[3] = bf_hi(w.y); x[4] = bf_lo(w.z); x[5] = bf_hi(w.z); x[6] = bf_lo(w.w); x[7] = bf_hi(w.w); }
__device__ __forceinline__ float wave_sum(float v) {
#pragma unroll
    for (int o = 1; o < 64; o <<= 1) v += __shfl_xor(v, o);
    return v;
}

namespace pg8 {
constexpr int BM = 256, BK = 64, HALF = 128, HTB = HALF * BK * 2, STAGE_BYTES = 8 * HTB, NXCD = 8, WGM = 4;
__host__ __device__ __forceinline__ int lds_byte(int r, int c) { const int st = (r >> 4) * 2 + (c >> 5), rr = r & 15, cc = c & 31, ob = rr * 64 + cc * 2; return st * 1024 + (ob ^ (((ob >> 9) & 1) << 5)); }
__host__ __device__ __forceinline__ void stage_rc(int b, int& R, int& C) { const int st = b / 1024, sb = b % 1024, swz = sb ^ (((sb >> 9) & 1) << 5); R = (st >> 1) * 16 + swz / 64; C = (st & 1) * 32 + (swz % 64) / 2; }
__host__ __device__ __forceinline__ int perm32(int rho) { const int n = rho >> 4, i = rho & 15; return 8 * (i >> 2) + 4 * n + (i & 3); }
struct Unit { int pm, pn; };
struct Gemm { const bf16_t* A; const bf16_t* Bt; int M, N, K, lda, a_pn_off; };
struct StaticOrder {
    int nM, nN, nwg, G, c;
    __device__ void init(int M, int N, int G_, int c_) { nM = M / BM; nN = N / BM; nwg = nM * nN; G = G_; c = c_; }
    __device__ bool next(int i, Unit& u) const {
        const long L = (long)i * G + c; if (L >= nwg) return false;
        int wgid = (int)L; { const int q = nwg / NXCD, r = nwg % NXCD, xcd = wgid % NXCD, off = wgid / NXCD; wgid = (xcd < r ? xcd * (q + 1) : r * (q + 1) + (xcd - r) * q) + off; }
        const int nig = WGM * nN, gid = wgid / nig, fm = gid * WGM, gsz = (nM - fm) < WGM ? (nM - fm) : WGM;
        u.pm = fm + ((wgid % nig) % gsz); u.pn = (wgid % nig) / gsz; return true;
    }
};
template <class Epi, bool ALIGN_EPI>
__device__ __forceinline__ void gemm_phase(int tid, LAS unsigned char* lds, const Gemm g, const StaticOrder& S, const Epi& E) {
    const int wid = __builtin_amdgcn_readfirstlane(tid >> 6), lane = tid & 63, wr = wid >> 2, wc = wid & 3, fr = lane & 15, fq = lane >> 4;
    const int K = g.K, nt = K / BK;
    unsigned voffA[2], voffB[2];
#pragma unroll
    for (int i = 0; i < 2; ++i) { int R, C; stage_rc(tid * 16 + i * 8192, R, C); const int Rb = Epi::PERM ? ((R & ~31) + perm32(R & 31)) : R;
        voffA[i] = (unsigned)(R * g.lda + C) * 2u; voffB[i] = (unsigned)(Rb * K + C) * 2u; }
    const size_t kstep = (size_t)(BK * 2);
    const size_t hstepA = (size_t)HALF * g.lda * 2, hstepB = (size_t)HALF * K * 2;
    const size_t tstepA = 2 * hstepA, tstepB = 2 * hstepB;
    const unsigned ldsw = (unsigned)wid * 1024u;
    const int aoff = lds_byte(wr * 64 + fr, fq * 8), boff = lds_byte(wc * 32 + fr, fq * 8);
#define PG8_SA(b, h) (((b) * 2 + (h)) * HTB)
#define PG8_SB(b, h) ((4 + (b) * 2 + (h)) * HTB)
#define PG8_STAGE(bufoff, gbase, voff) do { _Pragma("unroll") for (int _i = 0; _i < 2; ++_i) \
        __builtin_amdgcn_global_load_lds((const unsigned*)((const char*)(gbase) + (voff)[_i]), (LAS unsigned*)(lds + (bufoff) + ldsw + _i * 8192), 16, 0, 0); } while (0)
#define PG8_LDA(dst, b, h) do { _Pragma("unroll") for (int m = 0; m < 4; ++m) _Pragma("unroll") for (int k = 0; k < 2; ++k) dst[m][k] = *(const LAS bf16x8*)(lds + PG8_SA(b, h) + aoff + m * 2048 + k * 1024); } while (0)
#define PG8_LDB(dst, b, h) do { _Pragma("unroll") for (int n = 0; n < 2; ++n) _Pragma("unroll") for (int k = 0; k < 2; ++k) dst[n][k] = *(const LAS bf16x8*)(lds + PG8_SB(b, h) + boff + n * 2048 + k * 1024); } while (0)
#define PG8_MMA(ai, bj, At, Bt) do { __builtin_amdgcn_s_setprio(1); _Pragma("unroll") for (int m = 0; m < 4; ++m) _Pragma("unroll") for (int n = 0; n < 2; ++n) _Pragma("unroll") for (int k = 0; k < 2; ++k) \
        acc[ai][bj][m][n] = __builtin_amdgcn_mfma_f32_16x16x32_bf16(Bt[n][k], At[m][k], acc[ai][bj][m][n], 0, 0, 0); __builtin_amdgcn_s_setprio(0); } while (0)
#define PG8_WAIT_V(n) asm volatile("s_waitcnt vmcnt(" #n ")" ::: "memory")
#define PG8_WAIT_L(n) asm volatile("s_waitcnt lgkmcnt(" #n ")" ::: "memory")
#define PG8_BAR __builtin_amdgcn_s_barrier()
#define PG8_SCHED __builtin_amdgcn_sched_barrier(0)
    Unit cur, nxt; int ui = 0;
    if (!S.next(0, cur)) return;
    f32x4 acc[2][2][4][2];
#pragma unroll
    for (int a = 0; a < 2; ++a)
#pragma unroll
        for (int b = 0; b < 2; ++b)
#pragma unroll
            for (int m = 0; m < 4; ++m)
#pragma unroll
                for (int n = 0; n < 2; ++n) acc[a][b][m][n] = (f32x4){0.f, 0.f, 0.f, 0.f};
    bf16x8 At[4][2], B0[2][2], B1[2][2];
    const char* cA = (const char*)g.A + (size_t)cur.pm * tstepA + (size_t)cur.pn * (size_t)g.a_pn_off; const char* cB = (const char*)g.Bt + (size_t)cur.pn * tstepB;
    PG8_STAGE(PG8_SB(0, 0), cB, voffB); PG8_STAGE(PG8_SB(0, 1), cB + hstepB, voffB); PG8_STAGE(PG8_SA(0, 0), cA, voffA); PG8_STAGE(PG8_SA(0, 1), cA + hstepA, voffA);
    if (wr == 1) PG8_BAR;
    PG8_WAIT_V(2); PG8_BAR;
    PG8_STAGE(PG8_SB(1, 0), cB + kstep, voffB); PG8_STAGE(PG8_SA(1, 0), cA + kstep, voffA); PG8_STAGE(PG8_SB(1, 1), cB + hstepB + kstep, voffB);
    PG8_WAIT_V(6); PG8_BAR;
    for (;;) {
        const bool has_next = S.next(ui + 1, nxt);
        const char* nA = has_next ? (const char*)g.A + (size_t)nxt.pm * tstepA + (size_t)nxt.pn * (size_t)g.a_pn_off : cA; const char* nB = has_next ? (const char*)g.Bt + (size_t)nxt.pn * tstepB : cB;
        for (int t = 0; t < nt; t += 2) {
            const bool last = (t == nt - 2);
            const char* a1 = cA + (size_t)(t + 1) * kstep;
            const char* a2 = last ? nA : cA + (size_t)(t + 2) * kstep; const char* b2 = last ? nB : cB + (size_t)(t + 2) * kstep;
            const char* a3 = a2 + kstep; const char* b3 = b2 + kstep;
            PG8_LDB(B0, 0, 0); PG8_LDB(B1, 0, 1); PG8_SCHED; PG8_LDA(At, 0, 0); PG8_STAGE(PG8_SA(1, 1), a1 + hstepA, voffA);
            PG8_WAIT_V(8); PG8_WAIT_L(0); PG8_BAR; PG8_MMA(0, 0, At, B0); PG8_MMA(0, 1, At, B1); PG8_BAR; PG8_SCHED;
            PG8_LDA(At, 0, 1); PG8_STAGE(PG8_SB(0, 0), b2, voffB); PG8_STAGE(PG8_SB(0, 1), b2 + hstepB, voffB); PG8_STAGE(PG8_SA(0, 0), a2, voffA);
            PG8_WAIT_V(8); PG8_WAIT_L(0); PG8_BAR; PG8_MMA(1, 0, At, B0); PG8_MMA(1, 1, At, B1); PG8_BAR; PG8_SCHED;
            PG8_LDB(B0, 1, 0); PG8_LDB(B1, 1, 1); PG8_SCHED; PG8_LDA(At, 1, 0); PG8_STAGE(PG8_SA(0, 1), a2 + hstepA, voffA);
            PG8_WAIT_V(8); PG8_WAIT_L(0); PG8_BAR; PG8_MMA(0, 0, At, B0); PG8_MMA(0, 1, At, B1); PG8_BAR; PG8_SCHED;
            PG8_LDA(At, 1, 1); PG8_STAGE(PG8_SB(1, 0), b3, voffB); PG8_STAGE(PG8_SB(1, 1), b3 + hstepB, voffB); PG8_STAGE(PG8_SA(1, 0), a3, voffA);
            PG8_WAIT_V(8); PG8_WAIT_L(0); PG8_BAR; PG8_MMA(1, 0, At, B0); PG8_MMA(1, 1, At, B1); PG8_BAR; PG8_SCHED;
        }
        if constexpr (ALIGN_EPI) { if (wr == 0) PG8_BAR; }
        E(acc, cur, wr, wc, fr, fq);
        if (!has_next) break;
#pragma unroll
        for (int a = 0; a < 2; ++a)
#pragma unroll
            for (int b = 0; b < 2; ++b)
#pragma unroll
                for (int m = 0; m < 4; ++m)
#pragma unroll
                    for (int n = 0; n < 2; ++n) acc[a][b][m][n] = (f32x4){0.f, 0.f, 0.f, 0.f};
        cur = nxt; cA = nA; cB = nB; ++ui;
        if constexpr (ALIGN_EPI) { if (wr == 1) PG8_BAR; }
    }
    PG8_WAIT_V(0);
    if constexpr (!ALIGN_EPI) { if (wr == 0) PG8_BAR; }
    PG8_BAR;
#undef PG8_SA
#undef PG8_SB
#undef PG8_STAGE
#undef PG8_LDA
#undef PG8_LDB
#undef PG8_MMA
#undef PG8_WAIT_V
#undef PG8_WAIT_L
#undef PG8_BAR
#undef PG8_SCHED
}
}

struct EpiStore {
    static constexpr bool PERM = true;
    bf16_t* O; int ldc; int gelu_tiles;
    __device__ __forceinline__ void operator()(const f32x4 (&acc)[2][2][4][2], const pg8::Unit& u, int wr, int wc, int fr, int fq) const {
        const int row0 = u.pm * 256 + wr * 64 + fr, col0 = u.pn * 256 + wc * 32 + 8 * fq; const bool act = u.pn < gelu_tiles;
#pragma unroll
        for (int ai = 0; ai < 2; ++ai)
#pragma unroll
            for (int m = 0; m < 4; ++m) { bf16_t* rowp = O + (size_t)(row0 + ai * 128 + m * 16) * ldc + col0;
#pragma unroll
                for (int bj = 0; bj < 2; ++bj) { f32x4 v0 = acc[ai][bj][m][0], v1 = acc[ai][bj][m][1];
                    if (act) {
#pragma unroll
                        for (int e = 0; e < 4; ++e) { v0[e] = gelu_tanh(v0[e]); v1[e] = gelu_tanh(v1[e]); } }
                    u32x4 w; w.x = cvt_pk_bf16(v0[0], v0[1]); w.y = cvt_pk_bf16(v0[2], v0[3]); w.z = cvt_pk_bf16(v1[0], v1[1]); w.w = cvt_pk_bf16(v1[2], v1[3]);
                    *(u32x4*)(rowp + bj * 128) = w; } }
    }
};
struct EpiSwiglu {
    static constexpr bool PERM = true;
    bf16_t* O; int ldc;
    __device__ __forceinline__ void operator()(const f32x4 (&acc)[2][2][4][2], const pg8::Unit& u, int wr, int wc, int fr, int fq) const {
        const int row0 = u.pm * 256 + wr * 64 + fr, col0 = u.pn * 128 + wc * 32 + 8 * fq;
#pragma unroll
        for (int ai = 0; ai < 2; ++ai)
#pragma unroll
            for (int m = 0; m < 4; ++m) { bf16_t* rowp = O + (size_t)(row0 + ai * 128 + m * 16) * ldc + col0;
                f32x4 v0, v1;
#pragma unroll
                for (int n = 0; n < 2; ++n)
#pragma unroll
                    for (int e = 0; e < 4; e += 2) {
                        const f32x2 g = {acc[ai][0][m][n][e], acc[ai][0][m][n][e + 1]}, up = {acc[ai][1][m][n][e], acc[ai][1][m][n][e + 1]};
                        const f32x2 t = g * (-LOG2E); f32x2 ex; ex.x = __builtin_amdgcn_exp2f(t.x); ex.y = __builtin_amdgcn_exp2f(t.y);
                        const f32x2 d = ex + 1.0f; f32x2 r; r.x = __builtin_amdgcn_rcpf(d.x); r.y = __builtin_amdgcn_rcpf(d.y);
                        const f32x2 o = (g * up) * r;
                        if (n == 0) { v0[e] = o.x; v0[e + 1] = o.y; } else { v1[e] = o.x; v1[e + 1] = o.y; } }
                u32x4 w; w.x = cvt_pk_bf16(v0[0], v0[1]); w.y = cvt_pk_bf16(v0[2], v0[3]); w.z = cvt_pk_bf16(v1[0], v1[1]); w.w = cvt_pk_bf16(v1[2], v1[3]);
                __builtin_nontemporal_store(w, (u32x4*)rowp); }
    }
};
struct EpiGate {
    static constexpr bool PERM = true;
    bf16_t* LA; bf16_t* BBo; const bf16_t* XC; const float* gb_r; const float* gb_i; const float* spl;
    __device__ __forceinline__ void operator()(const f32x4 (&acc)[2][2][4][2], const pg8::Unit& u, int wr, int wc, int fr, int fq) const {
        const int row0 = u.pm * 256 + wr * 64 + fr, ch0 = u.pn * 128 + wc * 32 + 8 * fq;
#pragma unroll
        for (int ai = 0; ai < 2; ++ai)
#pragma unroll
            for (int m = 0; m < 4; ++m) { const size_t off = (size_t)(row0 + ai * 128 + m * 16) * 1024 + ch0;
                const u32x4 xw = *(const u32x4*)(XC + off);
                u32x4 w1, w2;
#pragma unroll
                for (int n = 0; n < 2; ++n) {
                    const f32x4 br = *(const f32x4*)(gb_r + ch0 + 4 * n), bi = *(const f32x4*)(gb_i + ch0 + 4 * n), sp = *(const f32x4*)(spl + ch0 + 4 * n);
                    const unsigned xa = n == 0 ? xw.x : xw.z, xb = n == 0 ? xw.y : xw.w;
                    const float xv[4] = {bf_lo(xa), bf_hi(xa), bf_lo(xb), bf_hi(xb)};
                    float la[4], bb[4];
#pragma unroll
                    for (int e = 0; e < 4; ++e) { const float gr = acc[ai][0][m][n][e] + br[e], gi = acc[ai][1][m][n][e] + bi[e];
                        const float l_ = sp[e] * fast_sigmoid(gr); la[e] = l_;
                        const float om = fmaxf(0.0f, 1.0f - __builtin_amdgcn_exp2f(2.0f * LOG2E * l_)); bb[e] = __builtin_amdgcn_sqrtf(om) * fast_sigmoid(gi) * xv[e]; }
                    if (n == 0) { w1.x = cvt_pk_bf16(la[0], la[1]); w1.y = cvt_pk_bf16(la[2], la[3]); w2.x = cvt_pk_bf16(bb[0], bb[1]); w2.y = cvt_pk_bf16(bb[2], bb[3]); }
                    else { w1.z = cvt_pk_bf16(la[0], la[1]); w1.w = cvt_pk_bf16(la[2], la[3]); w2.z = cvt_pk_bf16(bb[0], bb[1]); w2.w = cvt_pk_bf16(bb[2], bb[3]); }
                }
                *(u32x4*)(LA + off) = w1; *(u32x4*)(BBo + off) = w2; }
    }
};

__device__ __forceinline__ int colmap(int id, int n) {
    if (id == 1) { const int t = n >> 8, w = n & 255; return w < 128 ? t * 128 + w : FH + t * 128 + (w - 128); }
    if (id == 2) return n < 1024 ? n : (n < 2048 ? n + 1024 : n - 1024);
    return n;
}
__device__ __forceinline__ void tr_item(const float* W, int ldsrc, int K, bf16_t* WT, int n0, int k0, int mapid, LAS float* scr, int lane) {
    const int sc = colmap(mapid, n0 + (lane & 31));
#pragma unroll 8
    for (int i = 0; i < 32; ++i) { const int kk = 2 * i + (lane >> 5); scr[kk * 33 + (lane & 31)] = W[(size_t)(k0 + kk) * ldsrc + sc]; }
    asm volatile("s_waitcnt lgkmcnt(0)" ::: "memory");
    const int c = lane & 7;
#pragma unroll
    for (int j = 0; j < 4; ++j) { const int n = (lane >> 3) + 8 * j; const LAS float* s = scr + (8 * c) * 33 + n;
        u32x4 o; o.x = cvt_pk_bf16(s[0 * 33], s[1 * 33]); o.y = cvt_pk_bf16(s[2 * 33], s[3 * 33]); o.z = cvt_pk_bf16(s[4 * 33], s[5 * 33]); o.w = cvt_pk_bf16(s[6 * 33], s[7 * 33]);
        *(u32x4*)(WT + (size_t)(n0 + n) * K + k0 + 8 * c) = o; }
    asm volatile("s_waitcnt lgkmcnt(0)" ::: "memory");
}
__device__ __forceinline__ void phase_prologue(const KArgs& a, const int z, const int tid, LAS unsigned char* lds) {
    const int lane = tid & 63, wave = tid >> 6;
    LAS float* sv = (LAS float*)(lds + 73728);
    LAS float* part = (LAS float*)(lds + 110592);
    float* MOD = (float*)((a.ws + z) + OFF_MOD);
    for (int i = tid; i < 9 * 1024; i += NTHR) { const int s = i >> 10, k = i & 1023; const float v = s < 8 ? a.in[z + 1][s * 1024 + k] : a.in[z + 3][k]; sv[i] = v / (1.0f + __expf(-v)); }
    __syncthreads();
    for (int item = blockIdx.x; item < 768; item += gridDim.x) {
        const int l = item / 192, n0 = (item % 192) * 32, ks = tid >> 5, cl = tid & 31;
        const float* w = a.in[z + 4] + (size_t)l * 1024 * 6144 + n0 + cl;
        float acc[9];
#pragma unroll
        for (int s = 0; s < 9; ++s) acc[s] = 0.f;
        const int k0 = ks * 64;
        for (int kb = 0; kb < 64; kb += 16) { float wv[16];
#pragma unroll
            for (int k = 0; k < 16; ++k) wv[k] = w[(size_t)(k0 + kb + k) * 6144];
#pragma unroll
            for (int k = 0; k < 16; ++k)
#pragma unroll
                for (int s = 0; s < 9; ++s) acc[s] += sv[s * 1024 + k0 + kb + k] * wv[k]; }
#pragma unroll
        for (int s = 0; s < 9; ++s) part[(ks * 9 + s) * 32 + cl] = acc[s];
        __syncthreads();
        for (int idx = tid; idx < 288; idx += NTHR) { const int s = idx >> 5, n = idx & 31; float r = a.in[z + 5][l * 6144 + n0 + n];
#pragma unroll
            for (int w16 = 0; w16 < 16; ++w16) r += part[(w16 * 9 + s) * 32 + n];
            MOD[(size_t)(l * 9 + s) * 6144 + n0 + n] = r; }
        __syncthreads();
    }
    for (int i = blockIdx.x * NTHR + tid; i < 4096; i += gridDim.x * NTHR) ((float*)((a.ws + z) + OFF_SPL))[i] = -8.0f * log1pf(__expf(-a.in[z + 18][i]));
    LAS float* scr = (LAS float*)(lds + wave * 8448);
    unsigned char* WB = (a.ws + z) + OFF_W;
    const int gw = blockIdx.x * NWAVE + wave, NGW = gridDim.x * NWAVE;
    for (int it = gw; it < 24576; it += NGW) {
        int r = it;
        if (r < 11264) { const int l = r / 2816, q = r % 2816, kb = q / 176, nb = q % 176;
            tr_item(a.in[z + 10] + (size_t)l * 1024 * 5632, 5632, 1024, (bf16_t*)(WB + W_FFN_IN) + (size_t)l * 5632 * 1024, nb * 32, kb * 64, 1, scr, lane); continue; }
        r -= 11264;
        if (r < 5632) { const int l = r / 1408, q = r % 1408, kb = q / 32, nb = q % 32;
            tr_item(a.in[z + 11] + (size_t)l * 2816 * 1024, 1024, 2816, (bf16_t*)(WB + W_FFN_OUT) + (size_t)l * 1024 * 2816, nb * 32, kb * 64, 0, scr, lane); continue; }
        r -= 5632;
        if (r < 3072) { const int j = r / 1536, q = r % 1536, kb = q / 96, nb = q % 96;
            tr_item(a.in[z + 12] + (size_t)j * 1024 * 3072, 3072, 1024, (bf16_t*)(WB + W_EV_IN) + (size_t)j * 3072 * 1024, nb * 32, kb * 64, 2, scr, lane); continue; }
        r -= 3072;
        if (r < 1536) { const int j = r / 768, q = r % 768, kb = q / 32, nb = q % 32;
            tr_item(a.in[z + 13] + (size_t)j * 1536 * 1024, 1024, 1536, (bf16_t*)(WB + W_EV_OUT) + (size_t)j * 1024 * 1536, nb * 32, kb * 64, 0, scr, lane); continue; }
        r -= 1536;
        if (r < 512) { const int blk = r >> 3, q = r & 7, kb = q >> 2, nb = q & 3; const int h = blk & 7, k = (blk >> 3) & 1, d = (blk >> 4) & 1, j = blk >> 5;
            tr_item(a.in[z + 16] + (size_t)blk * 16384, 128, 128, (bf16_t*)(WB + W_GATE) + (size_t)j * (2 * 8 * 256 * 128) + (size_t)((d * 8 + h) * 256 + k * 128) * 128, nb * 32, kb * 64, 0, scr, lane); continue; }
        r -= 512;
        if (r < 1536) { const int j = r / 768, q = r % 768, kb = q / 48, nb = q % 48;
            tr_item(a.in[z + 21] + (size_t)j * 1024 * 1536, 1536, 1024, (bf16_t*)(WB + W_OD_IN) + (size_t)j * 1536 * 1024, nb * 32, kb * 64, 0, scr, lane); continue; }
        r -= 1536;
        { const int j = r / 512, q = r % 512, kb = q / 32, nb = q % 32;
            tr_item(a.in[z + 22] + (size_t)j * 1024 * 1024, 1024, 1024, (bf16_t*)(WB + W_OD_OUT) + (size_t)j * 1024 * 1024, nb * 32, kb * 64, 0, scr, lane); }
    }
}

struct LnCtx { float* H; const float* MOD; bf16_t* A; const bf16_t* Y; const float* gam; const float* bet; float* outp; int l, which, lm, shi, sci, gi; bool final_, from_in; const float* xin; const float* cin; };
__device__ __forceinline__ const float* ln_src(const LnCtx& c, int row) { return c.from_in ? (row < ML ? c.xin + (size_t)row * 1024 : c.cin + (size_t)(row - ML) * 1024) : c.H + (size_t)row * 1024; }
struct LnPar { f32x4 g[4], gm[4], bt[4], sh[4], sc[4]; };
__device__ __forceinline__ void ln_load_par(const LnCtx& c, int lane, int ms, LnPar& p) {
    const float* gp = c.MOD + (size_t)(c.l * 9 + ms) * 6144 + c.gi * 1024;
    const float* shp = c.MOD + (size_t)(c.lm * 9 + ms) * 6144 + c.shi * 1024; const float* scp = c.MOD + (size_t)(c.lm * 9 + ms) * 6144 + c.sci * 1024;
#pragma unroll
    for (int j = 0; j < 4; ++j) { const int o = 4 * lane + 256 * j;
        if (c.which != 0) p.g[j] = *(const f32x4*)(gp + o);
        if (!c.final_) { p.sh[j] = *(const f32x4*)(shp + o); p.sc[j] = *(const f32x4*)(scp + o) + 1.0f; } }
}
__device__ __forceinline__ void ln_finish(const LnCtx& c, const LnPar& p, int lane, int row, f32x4 (&v)[4], const u32x2 (&yw)[4]) {
    if (c.which != 0) {
        float s = 0.f;
#pragma unroll
        for (int j = 0; j < 4; ++j) { const f32x4 g = p.g[j];
            v[j][0] = ALPHA * v[j][0] + g[0] * bf_lo(yw[j].x); v[j][1] = ALPHA * v[j][1] + g[1] * bf_hi(yw[j].x); v[j][2] = ALPHA * v[j][2] + g[2] * bf_lo(yw[j].y); v[j][3] = ALPHA * v[j][3] + g[3] * bf_hi(yw[j].y);
            s += (v[j][0] + v[j][1]) + (v[j][2] + v[j][3]); }
        const float mean = wave_sum(s) * (1.0f / 1024.0f); float s2 = 0.f;
#pragma unroll
        for (int j = 0; j < 4; ++j) { v[j] = v[j] - mean; s2 += (v[j][0] * v[j][0] + v[j][1] * v[j][1]) + (v[j][2] * v[j][2] + v[j][3] * v[j][3]); }
        const float rstd = rsqrtf(wave_sum(s2) * (1.0f / 1024.0f) + 1e-6f);
        float* dst = c.final_ ? c.outp + (size_t)row * 1024 : c.H + (size_t)row * 1024;
#pragma unroll
        for (int j = 0; j < 4; ++j) { v[j] = v[j] * rstd * p.gm[j] + p.bt[j]; __builtin_nontemporal_store(v[j], (f32x4*)(dst + 4 * lane + 256 * j)); }
    }
    if (!c.final_) {
#pragma unroll
        for (int j = 0; j < 4; ++j) { const f32x4 o = v[j] * p.sc[j] + p.sh[j]; u32x2 w; w.x = cvt_pk_bf16(o[0], o[1]); w.y = cvt_pk_bf16(o[2], o[3]);
            *(u32x2*)(c.A + (size_t)row * 1024 + 4 * lane + 256 * j) = w; }
    }
}
__device__ __forceinline__ void phase_ln(const KArgs& a, const int z, const int tid, int l, int which, const int r_lo, const int r_hi, const int vb, const int nvb) {
    const int lane = tid & 63, wave = tid >> 6;
    const int gw = vb * NWAVE + wave, NGW = nvb * NWAVE;
    LnCtx c;
    c.H = (float*)((a.ws + z) + OFF_H); c.MOD = (const float*)((a.ws + z) + OFF_MOD);
    c.A = (bf16_t*)((a.ws + z) + OFF_R2); c.Y = (const bf16_t*)((a.ws + z) + OFF_R2 + SZ_ROWS_BF);
    c.final_ = (l == 3 && which == 2); c.from_in = (which == 0) || (which == 1 && l == 0);
    c.gam = which == 1 ? a.in[z + 6] + l * 1024 : a.in[z + 8] + l * 1024; c.bet = which == 1 ? a.in[z + 7] + l * 1024 : a.in[z + 9] + l * 1024;
    c.l = l; c.which = which; c.lm = which == 0 ? 0 : (which == 1 ? l : l + 1); c.shi = which == 1 ? 3 : 0; c.sci = which == 1 ? 4 : 1; c.gi = which == 1 ? 2 : 5;
    c.outp = (a.out + z); c.xin = a.in[z + 0]; c.cin = a.in[z + 2];
    const int per = (r_hi - r_lo + NGW - 1) / NGW, w_lo = r_lo + gw * per, w_hi = (w_lo + per < r_hi) ? w_lo + per : r_hi;
    LnPar p; int cur_ms = -1;
    if (which != 0) {
#pragma unroll
        for (int j = 0; j < 4; ++j) { p.gm[j] = *(const f32x4*)(c.gam + 4 * lane + 256 * j); p.bt[j] = *(const f32x4*)(c.bet + 4 * lane + 256 * j); } }
    for (int row0 = w_lo; row0 < w_hi; row0 += 2) {
        const int row1 = row0 + 1; const bool has1 = row1 < w_hi;
        f32x4 v0[4], v1[4]; u32x2 y0[4], y1[4];
        const float* s0 = ln_src(c, row0); const float* s1 = ln_src(c, has1 ? row1 : row0);
#pragma unroll
        for (int j = 0; j < 4; ++j) { v0[j] = __builtin_nontemporal_load((const f32x4*)(s0 + 4 * lane + 256 * j)); v1[j] = __builtin_nontemporal_load((const f32x4*)(s1 + 4 * lane + 256 * j)); }
        if (which != 0) {
#pragma unroll
            for (int j = 0; j < 4; ++j) { y0[j] = __builtin_nontemporal_load((const u32x2*)(c.Y + (size_t)row0 * 1024 + 4 * lane + 256 * j)); y1[j] = __builtin_nontemporal_load((const u32x2*)(c.Y + (size_t)(has1 ? row1 : row0) * 1024 + 4 * lane + 256 * j)); } }
        else {
#pragma unroll
            for (int j = 0; j < 4; ++j) { y0[j] = (u32x2){0u, 0u}; y1[j] = (u32x2){0u, 0u}; } }
        { const int ms = row0 < ML ? (row0 >> 13) : 8; if (ms != cur_ms) { ln_load_par(c, lane, ms, p); cur_ms = ms; } }
        ln_finish(c, p, lane, row0, v0, y0);
        if (has1) { const int ms = row1 < ML ? (row1 >> 13) : 8; if (ms != cur_ms) { ln_load_par(c, lane, ms, p); cur_ms = ms; }
            ln_finish(c, p, lane, row1, v1, y1); }
    }
}

__device__ __forceinline__ void phase_gmlp(const KArgs& a, const int z, const int tid, int jl, LAS unsigned char* lds, const int vb, const int nvb) {
    const int lane = tid & 63, wave = tid >> 6;
    bf16_t* Z = (bf16_t*)((a.ws + z) + OFF_Z);
    LAS bf16_t* VNT = (LAS bf16_t*)lds;
    const float* Wsp = a.in[z + 19] + (size_t)jl * 4 * 128 * 128; const float* Bsp = a.in[z + 20] + (size_t)jl * 4 * 128;
    for (int ci = vb; ci < 528; ci += nvb) {
        const int row0 = ci < 512 ? ci * 128 : ML + (ci - 512) * 128;
        u32x4 wv[16];
#pragma unroll
        for (int rr = 0; rr < 16; ++rr) wv[rr] = *(const u32x4*)(Z + (size_t)(row0 + wave * 16 + rr) * 3072 + 1536 + 8 * lane);
        float s1[16], s2[16];
#pragma unroll
        for (int rr = 0; rr < 16; ++rr) { float x[8]; unpack8(wv[rr], x); float t1 = 0.f, t2 = 0.f;
#pragma unroll
            for (int e = 0; e < 8; ++e) { t1 += x[e]; t2 += x[e] * x[e]; }
            s1[rr] = t1; s2[rr] = t2; }
#pragma unroll
        for (int o = 1; o < 64; o <<= 1) {
#pragma unroll
            for (int rr = 0; rr < 16; ++rr) { s1[rr] += __shfl_xor(s1[rr], o); s2[rr] += __shfl_xor(s2[rr], o); } }
        const int p = wave * 16 + (lane & 15);
        for (int g = 0; g < 4; ++g) {
            if ((lane >> 4) == g) {
#pragma unroll
                for (int rr = 0; rr < 16; ++rr) { const int q = wave * 16 + rr; float x[8]; unpack8(wv[rr], x);
                    const float mean = s1[rr] * (1.0f / 512.0f), var = fmaxf(s2[rr] * (1.0f / 512.0f) - mean * mean, 0.f), rstd = rsqrtf(var + 1e-6f);
#pragma unroll
                    for (int e = 0; e < 8; e += 2) { const unsigned pk = cvt_pk_bf16((x[e] - mean) * rstd, (x[e + 1] - mean) * rstd);
                        VNT[(8 * (lane & 15) + e) * 136 + q] = (bf16_t)(pk & 0xffffu); VNT[(8 * (lane & 15) + e + 1) * 136 + q] = (bf16_t)(pk >> 16); } } }
            bf16x8 bfr[4];
            { const float* wp = Wsp + (size_t)(g * 128 + p) * 128 + 8 * (lane >> 4);
#pragma unroll
              for (int ks = 0; ks < 4; ++ks) { const f32x4 w0 = *(const f32x4*)(wp + 32 * ks), w1 = *(const f32x4*)(wp + 32 * ks + 4);
                  u32x4 pw; pw.x = cvt_pk_bf16(w0[0], w0[1]); pw.y = cvt_pk_bf16(w0[2], w0[3]); pw.z = cvt_pk_bf16(w1[0], w1[1]); pw.w = cvt_pk_bf16(w1[2], w1[3]); bfr[ks] = __builtin_bit_cast(bf16x8, pw); } }
            const float bias = Bsp[g * 128 + p];
            bf16_t* urow = Z + (size_t)(row0 + p) * 3072 + 1024 + g * 128;
            u32x2 uw[8];
#pragma unroll
            for (int dt = 0; dt < 8; ++dt) uw[dt] = *(const u32x2*)(urow + 16 * dt + 4 * (lane >> 4));
            __syncthreads();
#pragma unroll
            for (int dt = 0; dt < 8; ++dt) {
                f32x4 acc = (f32x4){0.f, 0.f, 0.f, 0.f};
#pragma unroll
                for (int ks = 0; ks < 4; ++ks) { const bf16x8 af = *(const LAS bf16x8*)(VNT + (16 * dt + (lane & 15)) * 136 + 32 * ks + 8 * (lane >> 4));
                    acc = __builtin_amdgcn_mfma_f32_16x16x32_bf16(af, bfr[ks], acc, 0, 0, 0); }
                u32x2 o; o.x = cvt_pk_bf16(bf_lo(uw[dt].x) * (acc[0] + bias), bf_hi(uw[dt].x) * (acc[1] + bias)); o.y = cvt_pk_bf16(bf_lo(uw[dt].y) * (acc[2] + bias), bf_hi(uw[dt].y) * (acc[3] + bias));
                *(u32x2*)(urow + 16 * dt + 4 * (lane >> 4)) = o;
            }
            __syncthreads();
        }
    }
}
__device__ __forceinline__ void phase_conv(const KArgs& a, const int z, const int tid, int jl, const int rg_lo, const int nrg, const int vb, const int nvb) {
    bf16_t* Z = (bf16_t*)((a.ws + z) + OFF_Z);
    bf16_t* XC = (bf16_t*)((unsigned char*)(a.out + z) + DO_XC);
    const float* cw = a.in[z + 14] + (size_t)jl * 4 * 1024; const float* cb = a.in[z + 15] + (size_t)jl * 1024;
    for (int idx = vb * NTHR + tid; idx < nrg * 128; idx += nvb * NTHR) {
        const int rg = rg_lo + (idx >> 7), c0 = (idx & 127) * 8, row0 = rg * 16;
        int t0, len; if (row0 < ML) { t0 = row0 & 8191; len = SEQ; } else { t0 = (row0 - ML) & 255; len = CTXL; }
        u32x4 xw[19];
#pragma unroll
        for (int i = 0; i < 19; ++i) { const int tt = t0 - 2 + i; xw[i] = (u32x4){0u, 0u, 0u, 0u};
            if (tt >= 0 && tt < len) xw[i] = *(const u32x4*)(Z + (size_t)(row0 - 2 + i) * 3072 + 2048 + c0); }
        float wk[4][8], bs[8];
#pragma unroll
        for (int k = 0; k < 4; ++k) { const f32x4 w0 = *(const f32x4*)(cw + k * 1024 + c0), w1 = *(const f32x4*)(cw + k * 1024 + c0 + 4);
            wk[k][0] = w0[0]; wk[k][1] = w0[1]; wk[k][2] = w0[2]; wk[k][3] = w0[3]; wk[k][4] = w1[0]; wk[k][5] = w1[1]; wk[k][6] = w1[2]; wk[k][7] = w1[3]; }
        { const f32x4 b0 = *(const f32x4*)(cb + c0), b1 = *(const f32x4*)(cb + c0 + 4); bs[0] = b0[0]; bs[1] = b0[1]; bs[2] = b0[2]; bs[3] = b0[3]; bs[4] = b1[0]; bs[5] = b1[1]; bs[6] = b1[2]; bs[7] = b1[3]; }
#pragma unroll
        for (int r = 0; r < 16; ++r) {
            float o[8];
#pragma unroll
            for (int e = 0; e < 8; ++e) o[e] = bs[e];
#pragma unroll
            for (int k = 0; k < 4; ++k) { const u32x4 w = xw[r + k];
                o[0] += bf_lo(w.x) * wk[k][0]; o[1] += bf_hi(w.x) * wk[k][1]; o[2] += bf_lo(w.y) * wk[k][2]; o[3] += bf_hi(w.y) * wk[k][3];
                o[4] += bf_lo(w.z) * wk[k][4]; o[5] += bf_hi(w.z) * wk[k][5]; o[6] += bf_lo(w.w) * wk[k][6]; o[7] += bf_hi(w.w) * wk[k][7]; }
            u32x4 ow; ow.x = cvt_pk_bf16(o[0], o[1]); ow.y = cvt_pk_bf16(o[2], o[3]); ow.z = cvt_pk_bf16(o[4], o[5]); ow.w = cvt_pk_bf16(o[6], o[7]);
            *(u32x4*)(XC + (size_t)(row0 + r) * 1024 + c0) = ow;
        }
    }
}

__device__ __forceinline__ int scan_row_p(int d, int b, int p) {
    if (p < 256) return ML + b * 256 + (d == 0 ? p : 255 - p);
    const int t = p - 256; return b * SEQ + (d == 0 ? t : 8191 - t);
}
template <int PASS, int DIR, int NB>
__device__ __forceinline__ void scan_body(const KArgs& a, const int z, const int tid) {
    const bf16_t* LA = (const bf16_t*)((a.ws + z) + OFF_R2); const bf16_t* BBp = (const bf16_t*)((a.ws + z) + OFF_R2 + SZ_ROWS_BF);
    bf16_t* Z = (bf16_t*)((a.ws + z) + OFF_Z);
    float* SUMM = (float*)((unsigned char*)(a.out + z) + DO_SUMM); const float* CAR = (const float*)((unsigned char*)(a.out + z) + DO_CARRY);
    const int sub = tid >> 7, ch = (tid & 127) * 8;
    for (int blk = blockIdx.x; blk < 512; blk += gridDim.x) {
        const int item = blk * 4 + sub, b = item >> 8, sc = item & 255, p0 = sc * 33;
        float h[8], P[8];
#pragma unroll
        for (int e = 0; e < 8; ++e) { h[e] = 0.f; P[e] = 0.f; }
        if (PASS == 2) { const f32x4 c0 = *(const f32x4*)(CAR + (size_t)item * 1024 + ch), c1 = *(const f32x4*)(CAR + (size_t)item * 1024 + ch + 4);
            h[0] = c0[0]; h[1] = c0[1]; h[2] = c0[2]; h[3] = c0[3]; h[4] = c1[0]; h[5] = c1[1]; h[6] = c1[2]; h[7] = c1[3]; }
        for (int i0 = 0; i0 < 33; i0 += NB) {
            u32x4 lw[NB], bw[NB], fw[NB], gw[NB]; int rows[NB];
#pragma unroll
            for (int i = 0; i < NB; ++i) { rows[i] = scan_row_p(DIR, b, p0 + i0 + i);
                if (PASS == 2) { lw[i] = __builtin_nontemporal_load((const u32x4*)(LA + (size_t)rows[i] * 1024 + ch)); bw[i] = __builtin_nontemporal_load((const u32x4*)(BBp + (size_t)rows[i] * 1024 + ch)); }
                else { lw[i] = *(const u32x4*)(LA + (size_t)rows[i] * 1024 + ch); bw[i] = *(const u32x4*)(BBp + (size_t)rows[i] * 1024 + ch); }
                if (PASS == 2 && DIR == 1) { fw[i] = *(const u32x4*)(Z + (size_t)rows[i] * 3072 + 2048 + ch); gw[i] = *(const u32x4*)(Z + (size_t)rows[i] * 3072 + ch); } }
#pragma unroll
            for (int i = 0; i < NB; ++i) { float l[8], bb[8]; unpack8(lw[i], l); unpack8(bw[i], bb);
#pragma unroll
                for (int e = 0; e < 8; ++e) { h[e] = __builtin_amdgcn_exp2f(l[e] * LOG2E) * h[e] + bb[e]; if (PASS == 1) P[e] += l[e]; }
                if (PASS == 2 && DIR == 0) { u32x4 o; o.x = cvt_pk_bf16(h[0], h[1]); o.y = cvt_pk_bf16(h[2], h[3]); o.z = cvt_pk_bf16(h[4], h[5]); o.w = cvt_pk_bf16(h[6], h[7]);
                    *(u32x4*)(Z + (size_t)rows[i] * 3072 + 2048 + ch) = o; }
                if (PASS == 2 && DIR == 1) { float f[8], g[8]; unpack8(fw[i], f); unpack8(gw[i], g);
                    u32x4 o; o.x = cvt_pk_bf16(g[0] * (f[0] + h[0]), g[1] * (f[1] + h[1])); o.y = cvt_pk_bf16(g[2] * (f[2] + h[2]), g[3] * (f[3] + h[3]));
                    o.z = cvt_pk_bf16(g[4] * (f[4] + h[4]), g[5] * (f[5] + h[5])); o.w = cvt_pk_bf16(g[6] * (f[6] + h[6]), g[7] * (f[7] + h[7]));
                    *(u32x4*)(Z + (size_t)rows[i] * 3072 + ch) = o; }
            }
        }
        if (PASS == 1) { float* sp = SUMM + ((size_t)item * 1024 + ch) * 2;
#pragma unroll
            for (int e = 0; e < 8; e += 2) *(f32x4*)(sp + 2 * e) = (f32x4){P[e], h[e], P[e + 1], h[e + 1]}; }
    }
}
__device__ __forceinline__ void phase_scan(const KArgs& a, const int z, const int tid, int d, int pass) {
    if (pass == 1) { if (d == 0) scan_body<1, 0, 11>(a, z, tid); else scan_body<1, 1, 11>(a, z, tid); }
    else { if (d == 0) scan_body<2, 0, 11>(a, z, tid); else scan_body<2, 1, 3>(a, z, tid); }
}
__device__ __forceinline__ void phase_carry(const KArgs& a, const int z, const int tid, LAS unsigned char* lds) {
    const float* SUMM = (const float*)((unsigned char*)(a.out + z) + DO_SUMM); float* CAR = (float*)((unsigned char*)(a.out + z) + DO_CARRY);
    LAS float* segP = (LAS float*)lds; LAS float* segS = (LAS float*)(lds + 2048);
    const int seg = tid >> 6, cl = tid & 63;
    for (int blk = blockIdx.x; blk < 128; blk += gridDim.x) {
        const int b = blk >> 4, ch = (blk & 15) * 64 + cl; const size_t o0 = (size_t)(b * 256 + seg * 32) * 1024 + ch;
        f32x2 s[32];
#pragma unroll
        for (int k = 0; k < 32; ++k) s[k] = *(const f32x2*)(SUMM + (o0 + (size_t)k * 1024) * 2);
        float ps = 0.f, sa = 0.f;
#pragma unroll
        for (int k = 0; k < 32; ++k) { sa = __builtin_amdgcn_exp2f(s[k].x * LOG2E) * sa + s[k].y; ps += s[k].x; }
        segP[seg * 64 + cl] = ps; segS[seg * 64 + cl] = sa;
        __syncthreads();
        float c = 0.f;
        for (int j = 0; j < seg; ++j) c = __builtin_amdgcn_exp2f(segP[j * 64 + cl] * LOG2E) * c + segS[j * 64 + cl];
#pragma unroll
        for (int k = 0; k < 32; ++k) { CAR[o0 + (size_t)k * 1024] = c; c = __builtin_amdgcn_exp2f(s[k].x * LOG2E) * c + s[k].y; }
        __syncthreads();
    }
}

__device__ __forceinline__ void phase_qkpost(const KArgs& a, const int z, const int tid, int jl, const int r_lo, const int nrows, const int vb, const int nvb) {
    const bf16_t* Zq = (const bf16_t*)((a.ws + z) + OFF_Z + ZO_QKV); bf16_t* KK = (bf16_t*)((a.ws + z) + OFF_Z + ZO_KK); bf16_t* VV = (bf16_t*)((unsigned char*)(a.out + z) + DO_VV);
    const float* kn = a.in[z + 24] + jl * 64;
    for (int idx = vb * NTHR + tid; idx < 8 * nrows; idx += nvb * NTHR) {
        const int s8 = idx / nrows, row = r_lo + (idx - s8 * nrows), slot = 16 + s8;
        const bool lat = row < ML; const int t = lat ? (row & 8191) : ((row - ML) & 255), b = lat ? (row >> 13) : ((row - ML) >> 8);
        const int kvrow = lat ? 256 + t : t, type = slot >= 20, hh = slot & 1;
        const bf16_t* src = Zq + (size_t)row * 1536 + slot * 64;
        const size_t dsto = ((size_t)((type * 8 + b) * 2 + hh) * KVR + kvrow) * 64;
        u32x4 w[8];
#pragma unroll
        for (int c = 0; c < 8; ++c) w[c] = *(const u32x4*)(src + 8 * c);
        if (slot & 2) {
#pragma unroll
            for (int c = 0; c < 8; ++c) *(u32x4*)(VV + dsto + 8 * c) = w[c];
            continue; }
        float v[64];
#pragma unroll
        for (int c = 0; c < 8; ++c) { v[8 * c] = bf_lo(w[c].x); v[8 * c + 1] = bf_hi(w[c].x); v[8 * c + 2] = bf_lo(w[c].y); v[8 * c + 3] = bf_hi(w[c].y); v[8 * c + 4] = bf_lo(w[c].z); v[8 * c + 5] = bf_hi(w[c].z); v[8 * c + 6] = bf_lo(w[c].w); v[8 * c + 7] = bf_hi(w[c].w); }
        if (type == 0) { float ss = 0.f;
#pragma unroll
            for (int dd = 0; dd < 64; ++dd) ss += v[dd] * v[dd];
            const float r = rsqrtf(ss * (1.0f / 64.0f) + 1e-6f);
#pragma unroll
            for (int dd = 0; dd < 64; ++dd) v[dd] = v[dd] * r * kn[dd]; }
        if (lat) { const float pr = (float)(t >> 6), pc = (float)(t & 63);
#pragma unroll
            for (int f = 0; f < 16; ++f) { const float invf = exp2f(-(float)f * 0.8304820237218406f) * 0.15915494309189535f;
                { const float rev = pr * invf, cs = __builtin_amdgcn_cosf(rev), sn = __builtin_amdgcn_sinf(rev); const float x1 = v[f], x2 = v[16 + f]; v[f] = x1 * cs - x2 * sn; v[16 + f] = x2 * cs + x1 * sn; }
                { const float rev = pc * invf, cs = __builtin_amdgcn_cosf(rev), sn = __builtin_amdgcn_sinf(rev); const float x1 = v[32 + f], x2 = v[48 + f]; v[32 + f] = x1 * cs - x2 * sn; v[48 + f] = x2 * cs + x1 * sn; } } }
#pragma unroll
        for (int c = 0; c < 8; ++c) { u32x4 o; o.x = cvt_pk_bf16(v[8 * c], v[8 * c + 1]); o.y = cvt_pk_bf16(v[8 * c + 2], v[8 * c + 3]); o.z = cvt_pk_bf16(v[8 * c + 4], v[8 * c + 5]); o.w = cvt_pk_bf16(v[8 * c + 6], v[8 * c + 7]);
            *(u32x4*)(KK + dsto + 8 * c) = o; }
    }
}

namespace attn_body {
using bf16=__hip_bfloat16;
using bf16x8=__attribute__((ext_vector_type(8)))short;
using s16x4=__attribute__((ext_vector_type(4)))short;
using f32x16=__attribute__((ext_vector_type(16)))float;
using u32x4=__attribute__((ext_vector_type(4)))unsigned;
constexpr int D=64;
constexpr int NW=8,QBLK=32,QB=QBLK*NW,KVBLK=64;
constexpr int ATTN_UNIT_ROWS=QB;
__device__ __forceinline__ int crow(int r,int hi){return (r&3)+8*(r>>2)+4*hi;}
#define SBAR() __builtin_amdgcn_sched_barrier(0)
constexpr int NSLOT=3, SLOTB=8192;
constexpr int LDS_K=0, LDS_V=NSLOT*SLOTB, LDS_WS=2*NSLOT*SLOTB, LDS_OST=LDS_WS+NW*64*4, LDS_BYTES=LDS_OST+NW*4096;
constexpr float C2=0.125f*1.4426950408889634f;
__device__ __forceinline__ void glds16(const void*gsrc,unsigned lds_dst){unsigned keep;
  asm volatile("s_mov_b32 %0, m0\n\ts_mov_b32 m0, %2\n\ts_nop 0\n\tglobal_load_lds_dwordx4 %1, off\n\ts_mov_b32 m0, %0":"=&s"(keep):"v"(gsrc),"s"(lds_dst):"memory");}
__device__ __forceinline__ float max3f(float a,float b,float c){float r;asm("v_max3_f32 %0, %1, %2, %3":"=v"(r):"v"(a),"v"(b),"v"(c));return r;}
__device__ __forceinline__ float max2f(float a,float b){float r;asm("v_max_f32_e32 %0, %1, %2":"=v"(r):"v"(a),"v"(b));return r;}
__device__ __forceinline__ float fadd_s(float a,float b){float r;asm("v_add_f32_e32 %0, %1, %2":"=v"(r):"v"(a),"v"(b));return r;}
__device__ __forceinline__ float fsub_s(float a,float b){float r;asm("v_sub_f32_e32 %0, %1, %2":"=v"(r):"v"(a),"v"(b));return r;}
typedef float f32x2_t __attribute__((ext_vector_type(2))); typedef __bf16 bf16x2_t __attribute__((ext_vector_type(2)));
__device__ __forceinline__ unsigned cvtpk_s(float lo,float hi){f32x2_t v={lo,hi};bf16x2_t b=__builtin_convertvector(v,bf16x2_t);return __builtin_bit_cast(unsigned,b);}
#define WAIT_BAR(N) asm volatile("s_waitcnt vmcnt(" #N ") lgkmcnt(0)\n\ts_barrier":::"memory")

__device__ __forceinline__ void qkt(f32x16&p0,f32x16&p1,const char*Kslot,const bf16x8*qr,const f32x16&negm,int r32,int hi){
  const char*kb=Kslot+hi*1024+r32*16;
  #pragma unroll
  for(int d0=0;d0<4;++d0){
    const bf16x8 b0=*reinterpret_cast<const bf16x8*>(kb+d0*2048);
    const bf16x8 b1=*reinterpret_cast<const bf16x8*>(kb+d0*2048+512);
    if(d0==0){p0=__builtin_amdgcn_mfma_f32_32x32x16_bf16(b0,qr[0],negm,0,0,0);p1=__builtin_amdgcn_mfma_f32_32x32x16_bf16(b1,qr[0],negm,0,0,0);}
    else{p0=__builtin_amdgcn_mfma_f32_32x32x16_bf16(b0,qr[d0],p0,0,0,0);p1=__builtin_amdgcn_mfma_f32_32x32x16_bf16(b1,qr[d0],p1,0,0,0);}}
}
typedef __attribute__((address_space(3))) const char* lds_cptr;
typedef short v4i16_t __attribute__((ext_vector_type(4)));
__device__ __forceinline__ void kload8(bf16x8*kf,lds_cptr kp){
  kf[0]=*(const __attribute__((address_space(3))) bf16x8*)(kp);      kf[1]=*(const __attribute__((address_space(3))) bf16x8*)(kp+512);
  kf[2]=*(const __attribute__((address_space(3))) bf16x8*)(kp+2048); kf[3]=*(const __attribute__((address_space(3))) bf16x8*)(kp+2560);
  kf[4]=*(const __attribute__((address_space(3))) bf16x8*)(kp+4096); kf[5]=*(const __attribute__((address_space(3))) bf16x8*)(kp+4608);
  kf[6]=*(const __attribute__((address_space(3))) bf16x8*)(kp+6144); kf[7]=*(const __attribute__((address_space(3))) bf16x8*)(kp+6656);
}
__device__ __forceinline__ void kload2(bf16x8*kf,lds_cptr kp,int j){ kf[2*j]=*(const __attribute__((address_space(3))) bf16x8*)(kp+j*2048); kf[2*j+1]=*(const __attribute__((address_space(3))) bf16x8*)(kp+j*2048+512); }
__device__ __forceinline__ s16x4 vtr(lds_cptr p){ return __builtin_bit_cast(s16x4,__builtin_amdgcn_ds_read_tr16_b64_v4i16((__attribute__((address_space(3))) v4i16_t*)p)); }
__device__ __forceinline__ float rowmax(const f32x16&p0,const f32x16&p1){
  float a=max3f(p0[0],p0[1],p1[0]),b=max3f(p0[2],p0[3],p1[1]);a=max3f(a,p1[2],p1[3]);
  #pragma unroll
  for(int r=4;r<16;r+=4){a=max3f(a,p0[r],p0[r+1]);b=max3f(b,p0[r+2],p0[r+3]);a=max3f(a,p1[r],p1[r+1]);b=max3f(b,p1[r+2],p1[r+3]);}
  const float m=max2f(a,b);
  auto rr=__builtin_amdgcn_permlane32_swap(__float_as_uint(m),__float_as_uint(m),false,false);
  return max2f(__uint_as_float(rr[0]),__uint_as_float(rr[1]));
}
__device__ __forceinline__ void pv(f32x16*o,int vb,bf16x8 pa0,bf16x8 pa1,bf16x8 pa2,bf16x8 pa3){
  #pragma unroll
  for(int d0=0;d0<2;++d0){s16x4 lo[4],hi[4];
    #pragma unroll
    for(int ks=0;ks<4;++ks){
      asm volatile("ds_read_b64_tr_b16 %0,%1 offset:%c2":"=&v"(lo[ks]):"v"(vb),"i"(d0*4096+ks*1024):"memory");
      asm volatile("ds_read_b64_tr_b16 %0,%1 offset:%c2":"=&v"(hi[ks]):"v"(vb),"i"(d0*4096+ks*1024+512):"memory");}
    asm volatile("s_waitcnt lgkmcnt(0)":::"memory");SBAR();
    #define PK(k) (bf16x8){lo[k][0],lo[k][1],lo[k][2],lo[k][3],hi[k][0],hi[k][1],hi[k][2],hi[k][3]}
    o[d0]=__builtin_amdgcn_mfma_f32_32x32x16_bf16(pa0,PK(0),o[d0],0,0,0);
    o[d0]=__builtin_amdgcn_mfma_f32_32x32x16_bf16(pa1,PK(1),o[d0],0,0,0);
    o[d0]=__builtin_amdgcn_mfma_f32_32x32x16_bf16(pa2,PK(2),o[d0],0,0,0);
    o[d0]=__builtin_amdgcn_mfma_f32_32x32x16_bf16(pa3,PK(3),o[d0],0,0,0);
    #undef PK
  }
}

#ifndef ATTN_STORE16
#define ATTN_STORE16(p,v) (*(u32x4*)(p)=(v))
#endif
__device__ __forceinline__ void wmask(f32x16&p0,f32x16&p1,int t,int wid,int r32,int hi,int q0){
  const float NEG=-INFINITY; const int ks=q0-128+64*(t-4);
  if(ks<0||ks>=8192){
    #pragma unroll
    for(int r=0;r<16;++r){p0[r]=NEG;p1[r]=NEG;}
    return; }
  const int lo=64*(t-4)-128-(wid*32+31), hi_=64*(t-4)-128+63-wid*32;
  if(lo>=-128&&hi_<=128)return;
  const int base=64*(t-4)-128+4*hi-(wid*32+r32);
  #pragma unroll
  for(int r=0;r<16;++r){const int d0=base+(r&3)+8*(r>>2), d1=d0+32; if(d0>128||d0<-128)p0[r]=NEG; if(d1>128||d1<-128)p1[r]=NEG;}
}
template<int THRL,bool WIN> __device__ __forceinline__ void attn_unit(const bf16*Qb,int PQ,const bf16*__restrict__ Kh,int PK,const bf16*__restrict__ Vh,int PV,bf16*Ob,int PO,const int NT,char*shm,const int tid,const int q0,const float sink2,const float*qg,const int tpos0){
  const int lane=tid&63,r32=lane&31,hi=lane>>5; const int wid=__builtin_amdgcn_readfirstlane(tid>>6);
  const bf16*Qw=Qb+(long)(wid*QBLK)*PQ;
  const unsigned lds0=(unsigned)(uintptr_t)shm;
  float*wsf=(float*)(shm+LDS_WS)+wid*64;
  const bf16*ksrc=Kh+(long)lane*PK+wid*8;
  const bf16*vsrc=Vh+(long)(16*(wid&3)+(lane>>2))*PV+(wid>>2)*32+(lane&3)*8;
  const unsigned kdst=lds0+LDS_K+wid*1024, vdst=lds0+LDS_V+wid*1024;
  #define KOFF(t) ((WIN&&(t)>=4)?min(max(64*(t)+q0-128,0),8448-64):64*(t))
  #define DMA_K(t,slot) glds16(ksrc+(long)KOFF(t)*PK,(unsigned)__builtin_amdgcn_readfirstlane(kdst+(slot)))
  #define DMA_V(t,slot) glds16(vsrc+(long)KOFF(t)*PV,(unsigned)__builtin_amdgcn_readfirstlane(vdst+(slot)))
  const int vb0=(int)(lds0+LDS_V)+((lane>>4)&1)*32+(lane&3)*8+(4*hi+((lane&15)>>2))*64;
  const char*Kbase=shm+LDS_K; bf16x8 kf[8];
  const lds_cptr shm3=(lds_cptr)shm; const lds_cptr kp0=shm3+LDS_K+hi*1024+r32*16; const lds_cptr vp0=shm3+LDS_V+((lane>>4)&1)*32+(lane&3)*8+(4*hi+((lane&15)>>2))*64;
  DMA_K(0,0);DMA_V(0,0);DMA_K(1,SLOTB);
  bf16x8 qr[4];
  #pragma unroll
  for(int d0=0;d0<4;++d0)qr[d0]=*reinterpret_cast<const bf16x8*>(&Qw[(long)r32*PQ+d0*16+hi*8]);
  {
    float x[32];
    #pragma unroll
    for(int d0=0;d0<4;++d0){
      #pragma unroll
      for(int e=0;e<8;++e)x[8*d0+e]=__uint_as_float(((unsigned)(unsigned short)qr[d0][e])<<16);}
    if(qg){float ss=0.f;
      #pragma unroll
      for(int i=0;i<32;++i)ss+=x[i]*x[i];
      ss+=__shfl_xor(ss,32);
      const float rn=rsqrtf(ss*(1.0f/64.0f)+1e-6f);
      #pragma unroll
      for(int d0=0;d0<4;++d0){
        #pragma unroll
        for(int e=0;e<8;++e)x[8*d0+e]*=rn*qg[16*d0+8*hi+e];}}
    if(tpos0>=0){const int tq=tpos0+wid*QBLK+r32; const float pr=(float)(tq>>6),pc=(float)(tq&63);
      #pragma unroll
      for(int e=0;e<8;++e){const float invf=__builtin_amdgcn_exp2f(-(float)(8*hi+e)*0.8304820237218406f)*0.15915494309189535f;
        {const float rev=pr*invf,cs=__builtin_amdgcn_cosf(rev),sn=__builtin_amdgcn_sinf(rev);const float x1=x[e],x2=x[8+e];x[e]=x1*cs-x2*sn;x[8+e]=x2*cs+x1*sn;}
        {const float rev=pc*invf,cs=__builtin_amdgcn_cosf(rev),sn=__builtin_amdgcn_sinf(rev);const float x1=x[16+e],x2=x[24+e];x[16+e]=x1*cs-x2*sn;x[24+e]=x2*cs+x1*sn;}}}
    #pragma unroll
    for(int d0=0;d0<4;++d0){u32x4 w;w.x=cvtpk_s(x[8*d0]*C2,x[8*d0+1]*C2);w.y=cvtpk_s(x[8*d0+2]*C2,x[8*d0+3]*C2);w.z=cvtpk_s(x[8*d0+4]*C2,x[8*d0+5]*C2);w.w=cvtpk_s(x[8*d0+6]*C2,x[8*d0+7]*C2);qr[d0]=__builtin_bit_cast(bf16x8,w);}
  }
  float mhat=0.f,l_reg=0.f;f32x16 o[2];o[0]=f32x16{};o[1]=f32x16{};f32x16 negm=f32x16{}; if constexpr(!WIN){asm volatile("":"+v"(negm));}
  #define CMASK(P0,P1,t) do{ if(WIN&&(t)>=4) wmask(P0,P1,(t),wid,r32,hi,q0); }while(0)
  bool resc=false;
  #define START(P0,P1) do{ const float rm=rowmax(P0,P1); resc=false; \
    { const float dl=rm; mhat=fadd_s(mhat,dl); \
      _Pragma("unroll") for(int r=0;r<16;++r){P0[r]=fsub_s(P0[r],dl);P1[r]=fsub_s(P1[r],dl);} \
      if constexpr(!WIN){ _Pragma("unroll") for(int r=0;r<16;++r)negm[r]=-mhat; asm volatile("":"+v"(negm)); } } \
    _Pragma("unroll") for(int r=0;r<16;++r)P0[r]=__builtin_amdgcn_exp2f(P0[r]); }while(0)
  #define RESC() do{ if(resc){ asm volatile("s_waitcnt lgkmcnt(0)":::"memory"); \
      _Pragma("unroll") for(int d_=0;d_<2;++d_) _Pragma("unroll") for(int r=0;r<16;++r)o[d_][r]*=wsf[crow(r,hi)]; } }while(0)
  f32x16 pA0,pA1,pB0,pB1;
  int sl_prev=0,sl_cur=0,sl_next=SLOTB;
  #define ROT() do{sl_prev=sl_cur;sl_cur=sl_next;sl_next=(sl_next==(NSLOT-1)*SLOTB)?0:sl_next+SLOTB;}while(0)
  DMA_K(2,2*SLOTB);
  WAIT_BAR(3);
  qkt(pA0,pA1,Kbase,qr,(WIN?f32x16{}:negm),r32,hi);asm volatile("s_nop 15\n\ts_nop 7":"+v"(pA0),"+v"(pA1));CMASK(pA0,pA1,0);
  START(pA0,pA1);
  _Pragma("unroll") for(int r=0;r<16;++r)pA1[r]=__builtin_amdgcn_exp2f(pA1[r]);
  WAIT_BAR(0);
  DMA_K(3,0);DMA_V(1,SLOTB);
  ROT();
  kload8(kf,kp0+sl_cur);
  WAIT_BAR(2);
  s16x4 vlo[8],vhi[8]; u32x4 pw0,pw1,pw2,pw3;
  #define PKW(P,B) cvtpk_s(P[B],P[B+1])
  #define PAF(k) __builtin_bit_cast(bf16x8,pw##k)
  #define VFR(i) (bf16x8){vlo[i][0],vlo[i][1],vlo[i][2],vlo[i][3],vhi[i][0],vhi[i][1],vhi[i][2],vhi[i][3]}
  #define PIN(x) asm volatile("":"+v"(x))
  #define MX3(a,b,c) __builtin_fmaxf(__builtin_fmaxf((a),(b)),(c))
  #define GAPA(MF,A0,A1,A2,A3,W0,W1,PW) do{ MF; sacc+=A0; sacc+=A1; sacc+=A2; sacc+=A3; PIN(sacc); W0; W1; PIN(PW); SBAR(); }while(0)
  #define EX(v) __builtin_amdgcn_exp2f(v)
  #define GAPB(MF,X,B) do{ MF; X[B]=EX(X[B]); X[B+1]=EX(X[B+1]); X[B+2]=EX(X[B+2]); X[B+3]=EX(X[B+3]); PIN(X); SBAR(); }while(0)
  #define VRD(i) do{ vlo[i]=vtr(vp_+(((i)>>2)*4096+((i)&3)*1024)); vhi[i]=vtr(vp_+(((i)>>2)*4096+((i)&3)*1024+512)); }while(0)
  #define KRD(G,j) do{ if(G){ kload2(kf,kp0+sl_next,j); SBAR(); } }while(0)
  #define STEP(C0,C1,P0,P1,t,GK,GV,GL) do{ SBAR(); \
    const lds_cptr vp_=vp0+sl_prev; \
    VRD(0); SBAR(); float sacc=(P0[0]+P0[1]); \
    GAPA(C0=__builtin_amdgcn_mfma_f32_32x32x16_bf16(kf[0],qr[0],(WIN?f32x16{}:negm),0,0,0), P0[2],P0[3],P0[4],P0[5],     pw0[0]=PKW(P0,0), pw0[1]=PKW(P0,2), pw0); \
    VRD(4); SBAR(); GAPA(C1=__builtin_amdgcn_mfma_f32_32x32x16_bf16(kf[1],qr[0],(WIN?f32x16{}:negm),0,0,0), P0[6],P0[7],P0[8],P0[9],     pw0[2]=PKW(P0,4), pw0[3]=PKW(P0,6), pw0); \
    VRD(1); SBAR(); GAPA(C0=__builtin_amdgcn_mfma_f32_32x32x16_bf16(kf[2],qr[1],C0,0,0,0),   P0[10],P0[11],P0[12],P0[13], pw1[0]=PKW(P0,8), pw1[1]=PKW(P0,10), pw1); \
    VRD(5); SBAR(); GAPA(C1=__builtin_amdgcn_mfma_f32_32x32x16_bf16(kf[3],qr[1],C1,0,0,0),   P0[14],P0[15],P1[0],P1[1],   pw1[2]=PKW(P0,12),pw1[3]=PKW(P0,14), pw1); \
    VRD(2); SBAR(); GAPA(C0=__builtin_amdgcn_mfma_f32_32x32x16_bf16(kf[4],qr[2],C0,0,0,0),   P1[2],P1[3],P1[4],P1[5],     pw2[0]=PKW(P1,0), pw2[1]=PKW(P1,2), pw2); \
    VRD(6); SBAR(); GAPA(C1=__builtin_amdgcn_mfma_f32_32x32x16_bf16(kf[5],qr[2],C1,0,0,0),   P1[6],P1[7],P1[8],P1[9],     pw2[2]=PKW(P1,4), pw2[3]=PKW(P1,6), pw2); \
    VRD(3); SBAR(); GAPA(C0=__builtin_amdgcn_mfma_f32_32x32x16_bf16(kf[6],qr[3],C0,0,0,0),   P1[10],P1[11],P1[12],P1[13], pw3[0]=PKW(P1,8), pw3[1]=PKW(P1,10), pw3); \
    VRD(7); SBAR(); GAPA(C1=__builtin_amdgcn_mfma_f32_32x32x16_bf16(kf[7],qr[3],C1,0,0,0),   P1[14],P1[15],0.f,0.f,       pw3[2]=PKW(P1,12),pw3[3]=PKW(P1,14), pw3); \
    l_reg+=sacc; \
    if(GK){DMA_K((t)+3,sl_cur);} if(GV){DMA_V((t)+1,sl_next);} \
    if constexpr(WIN){ _Pragma("unroll") for(int r=0;r<16;++r){C0[r]-=mhat;C1[r]-=mhat;} } \
    CMASK(C0,C1,t); \
    { float a=MX3(C0[0],C0[1],C1[0]),b=MX3(C0[2],C0[3],C1[1]); a=MX3(a,C1[2],C1[3]); \
      _Pragma("unroll") for(int r=4;r<16;r+=4){a=MX3(a,C0[r],C0[r+1]);b=MX3(b,C0[r+2],C0[r+3]);a=MX3(a,C1[r],C1[r+1]);b=MX3(b,C1[r+2],C1[r+3]);} \
      float rm=__builtin_fmaxf(a,b); { auto rr=__builtin_amdgcn_permlane32_swap(__float_as_uint(rm),__float_as_uint(rm),false,false); rm=__builtin_fmaxf(__uint_as_float(rr[0]),__uint_as_float(rr[1])); } \
      resc=false; \
      if(__builtin_expect(__any(rm>(float)THRL),0)){ const float dl=__builtin_fmaxf(rm,0.f); mhat+=dl; \
        _Pragma("unroll") for(int r=0;r<16;++r){C0[r]-=dl;C1[r]-=dl;} \
        if constexpr(!WIN){ _Pragma("unroll") for(int r=0;r<16;++r)negm[r]=-mhat; asm volatile("":"+v"(negm)); } \
        const float f=__builtin_amdgcn_exp2f(-dl); l_reg*=f; if(hi==0)wsf[r32]=f; resc=true; } } \
    SBAR(); \
    GAPB(o[0]=__builtin_amdgcn_mfma_f32_32x32x16_bf16(PAF(0),VFR(0),o[0],0,0,0), C0,0); \
    GAPB(o[1]=__builtin_amdgcn_mfma_f32_32x32x16_bf16(PAF(0),VFR(4),o[1],0,0,0), C0,4); \
    KRD(GL,0); GAPB(o[0]=__builtin_amdgcn_mfma_f32_32x32x16_bf16(PAF(1),VFR(1),o[0],0,0,0), C0,8); \
    KRD(GL,1); GAPB(o[1]=__builtin_amdgcn_mfma_f32_32x32x16_bf16(PAF(1),VFR(5),o[1],0,0,0), C0,12); \
    KRD(GL,2); GAPB(o[0]=__builtin_amdgcn_mfma_f32_32x32x16_bf16(PAF(2),VFR(2),o[0],0,0,0), C1,0); \
    KRD(GL,3); GAPB(o[1]=__builtin_amdgcn_mfma_f32_32x32x16_bf16(PAF(2),VFR(6),o[1],0,0,0), C1,4); \
    GAPB(o[0]=__builtin_amdgcn_mfma_f32_32x32x16_bf16(PAF(3),VFR(3),o[0],0,0,0), C1,8); \
    GAPB(o[1]=__builtin_amdgcn_mfma_f32_32x32x16_bf16(PAF(3),VFR(7),o[1],0,0,0), C1,12); \
    }while(0)
  int t=1;
  #undef CMASK
  #define CMASK(P0,P1,t) do{ if(WIN&&(t)>=4) wmask(P0,P1,(t),wid,r32,hi,q0); }while(0)
  for(;t+5<NT;t+=2){
    STEP(pB0,pB1,pA0,pA1,t,true,true,true);     WAIT_BAR(2); RESC(); ROT();
    STEP(pA0,pA1,pB0,pB1,t+1,true,true,true);   WAIT_BAR(2); RESC(); ROT();
  }
  #undef CMASK
  #define CMASK(P0,P1,t) do{ if(WIN&&(t)>=4) wmask(P0,P1,(t),wid,r32,hi,q0); }while(0)
  #define ENDW(tt) do{ if((tt)+3<NT){WAIT_BAR(2);} else if((tt)+2<NT){WAIT_BAR(1);} else {WAIT_BAR(0);} }while(0)
  for(;t+1<NT;t+=2){
    STEP(pB0,pB1,pA0,pA1,t,(t+3<NT),(t+1<NT),(t+1<NT));       ENDW(t);   RESC(); ROT();
    STEP(pA0,pA1,pB0,pB1,t+1,(t+4<NT),(t+2<NT),(t+2<NT));     ENDW(t+1); RESC(); ROT();
  }
  STEP(pB0,pB1,pA0,pA1,NT-1,false,false,false); RESC();
  { float sacc=pB0[0]+pB0[1]; _Pragma("unroll") for(int r=2;r<16;++r)sacc+=pB0[r]; _Pragma("unroll") for(int r=0;r<16;++r)sacc+=pB1[r]; l_reg+=sacc;
    pw0=(u32x4){PKW(pB0,0),PKW(pB0,2),PKW(pB0,4),PKW(pB0,6)};pw1=(u32x4){PKW(pB0,8),PKW(pB0,10),PKW(pB0,12),PKW(pB0,14)};pw2=(u32x4){PKW(pB1,0),PKW(pB1,2),PKW(pB1,4),PKW(pB1,6)};pw3=(u32x4){PKW(pB1,8),PKW(pB1,10),PKW(pB1,12),PKW(pB1,14)};
    SBAR(); pv(o,vb0+sl_cur,PAF(0),PAF(1),PAF(2),PAF(3)); }
  #undef PKW
  #undef PAF
  #undef VFR
  #undef PIN
  #undef MX3
  #undef GAPA
  #undef GAPB
  #undef EX
  #undef VRD
  #undef KRD
  #undef STEP
  #undef ENDW
  {auto rr=__builtin_amdgcn_permlane32_swap(__float_as_uint(l_reg),__float_as_uint(l_reg),false,false);l_reg=__uint_as_float(rr[0])+__uint_as_float(rr[1]);}
  if(WIN)l_reg+=__builtin_amdgcn_exp2f(__uint_as_float(__builtin_amdgcn_readfirstlane(__float_as_uint(sink2)))-mhat);
  if(hi==0)wsf[32+r32]=l_reg;asm volatile("s_waitcnt lgkmcnt(0)":::"memory");
  float rli[16];
  #pragma unroll
  for(int r=0;r<16;++r)rli[r]=__builtin_amdgcn_rcpf(wsf[32+crow(r,hi)]);
  bf16*Ow=Ob+(long)(wid*QBLK)*PO;
  { bf16*stg=(bf16*)(shm+LDS_OST)+wid*2048;
    #pragma unroll
    for(int r=0;r<16;++r){const int orow=crow(r,hi);
      #pragma unroll
      for(int d0=0;d0<2;++d0)stg[orow*64+d0*32+r32]=__float2bfloat16(o[d0][r]*rli[r]);}
    asm volatile("s_waitcnt lgkmcnt(0)":::"memory");
    #pragma unroll
    for(int i=0;i<4;++i){const int row=i*8+(lane>>3),ch=lane&7; const u32x4 v=*(const u32x4*)(stg+row*64+ch*8); ATTN_STORE16(Ow+(long)row*PO+ch*8,v);} }
  asm volatile("s_waitcnt lgkmcnt(0)\n\ts_barrier":::"memory");
  #undef DMA_K
  #undef KOFF
  #undef DMA_V
  #undef CMASK
  #undef START
  #undef RESC
  #undef ROT
}
constexpr int ATTN_LDS_BYTES=LDS_BYTES;
#undef SBAR
#undef WAIT_BAR
}
__device__ __forceinline__ unsigned long long phase_attn(const KArgs& a, const int z, const int tid, int jl, bool with_ctx, char* lds_gen) {
    const int lane = tid & 63, wave = tid >> 6, l15 = lane & 15, lg = lane >> 4;
    const bf16_t* Zq = (const bf16_t*)((a.ws + z) + OFF_Z + ZO_QKV); const bf16_t* KK = (const bf16_t*)((a.ws + z) + OFF_Z + ZO_KK); const bf16_t* VT = (const bf16_t*)((a.ws + z) + OFF_Z + ZO_VT);
    bf16_t* O = (bf16_t*)((a.ws + z) + OFF_Z + ZO_O);
    const float* sinkp = a.in[z + 25] + jl * 8; const float* qn = a.in[z + 23] + jl * 64;
    const int gw = blockIdx.x * NWAVE + wave, NGW = gridDim.x * NWAVE;
    const int nitems = with_ctx ? 16384 + 512 : 16384;
    {
        const bf16_t* VV = (const bf16_t*)((unsigned char*)(a.out + z) + DO_VV);
        const int G = gridDim.x, bx = blockIdx.x, vcu = (G % 8 == 0) ? (bx % 8) * (G / 8) + bx / 8 : bx, per = (2048 + G - 1) / G;
        for (int i = 0; i < per; ++i) { const int u = vcu * per + i; if (u >= 2048) break;
            const int b = (u >> 8) & 7, qb = (u >> 3) & 31, h = u & 7, g = h >> 2;
            attn_body::attn_unit<8, false>((const attn_body::bf16*)(Zq + (size_t)(b * SEQ + qb * 256) * 1536 + h * 64), 1536,
                                    (const attn_body::bf16*)(KK + (size_t)(b * 2 + g) * KVR * 64), 64, (const attn_body::bf16*)(VV + (size_t)(b * 2 + g) * KVR * 64), 64,
                                    (attn_body::bf16*)(O + (size_t)(b * SEQ + qb * 256) * 1024 + h * 64), 1024, KVR / 64, lds_gen, tid, 0, 0.f, qn, qb * 256); }
        for (int i = 0; i < per; ++i) { const int u = vcu * per + i; if (u >= 2048) break;
            const int b = (u >> 8) & 7, qb = (u >> 3) & 31, h = u & 7, g = h >> 2;
            attn_body::attn_unit<8, true>((const attn_body::bf16*)(Zq + (size_t)(b * SEQ + qb * 256) * 1536 + 512 + h * 64), 1536,
                                    (const attn_body::bf16*)(KK + (size_t)((8 + b) * 2 + g) * KVR * 64), 64, (const attn_body::bf16*)(VV + (size_t)((8 + b) * 2 + g) * KVR * 64), 64,
                                    (attn_body::bf16*)(O + (size_t)(b * SEQ + qb * 256) * 1024 + 512 + h * 64), 1024, 12, lds_gen, tid, qb * 256, sinkp[h] * LOG2E, nullptr, qb * 256); }
        if (with_ctx) {
            for (int u = vcu; u < 128; u += G) { const int type = u >> 6, b = (u >> 3) & 7, h = u & 7, g = h >> 2;
                attn_body::attn_unit<8, true>((const attn_body::bf16*)(Zq + (size_t)(ML + b * CTXL) * 1536 + type * 512 + h * 64), 1536,
                                    (const attn_body::bf16*)(KK + (size_t)((type * 8 + b) * 2 + g) * KVR * 64), 64, (const attn_body::bf16*)(VV + (size_t)((type * 8 + b) * 2 + g) * KVR * 64), 64,
                                    (attn_body::bf16*)(O + (size_t)(ML + b * CTXL) * 1024 + type * 512 + h * 64), 1024, 4, lds_gen, tid, 0, type ? sinkp[h] * LOG2E : -1e30f, type ? nullptr : qn, -1); }
        }
    }
    return 0ull;
#if 0
    const unsigned long long t_simple0 = __builtin_amdgcn_s_memrealtime();
    for (int item = 8192 + gw; item < nitems; item += NGW) {
        int mode, bg, qtile;
        if (item < 8192) { mode = 0; bg = item >> 9; qtile = item & 511; }
        else if (item < 16384) { mode = 1; bg = (item - 8192) >> 9; qtile = item & 511; }
        else if (item < 16384 + 256) { mode = 2; bg = (item - 16384) >> 4; qtile = item & 15; }
        else { mode = 3; bg = (item - 16640) >> 4; qtile = item & 15; }
        const int b = bg >> 1, g = bg & 1, type = mode & 1;
        const int rowbase = (mode < 2) ? b * SEQ + 16 * qtile : ML + b * CTXL + 16 * qtile;
        const int qcol = type * 512 + g * 256;
        const bf16_t* Kb = KK + (size_t)((type * 8 + b) * 2 + g) * KVR * 64;
        const bf16_t* Vb = VT + (size_t)((type * 8 + b) * 2 + g) * 64 * KVR;
        const int nA = (mode == 0) ? 264 : 8;
        int lo = 0, nB = 0; const int q0 = 16 * qtile;
        if (mode == 1) { lo = q0 >= 128 ? ((q0 - 128) >> 5) : 0; int hi = ((q0 + 143) >> 5) + 1; if (hi > 256) hi = 256; nB = hi - lo; }
        const int ntot = nA + nB;
        bf16x8 qf[4][2];
        { const bf16_t* qp = Zq + (size_t)(rowbase + l15) * 1536 + qcol + 8 * lg;
#pragma unroll
          for (int qt = 0; qt < 4; ++qt)
#pragma unroll
              for (int ks = 0; ks < 2; ++ks) qf[qt][ks] = *(const bf16x8*)(qp + 64 * qt + 32 * ks); }
        f32x4 oacc[4][4]; float mrun[4], lsum[4];
#pragma unroll
        for (int qt = 0; qt < 4; ++qt) { mrun[qt] = -1e30f; lsum[qt] = 0.f;
#pragma unroll
            for (int dt = 0; dt < 4; ++dt) oacc[qt][dt] = (f32x4){0.f, 0.f, 0.f, 0.f}; }
        bf16x8 kf[2][2]; u32x2 vlo[4], vhi[4];
        const bf16_t* kp = Kb + (size_t)l15 * 64 + 8 * lg; const bf16_t* vp = Vb + (size_t)l15 * KVR + 4 * lg;
#define LOAD_KV(KF, VLO, VHI, kvrow0) do { \
        _Pragma("unroll") for (int kt = 0; kt < 2; ++kt) _Pragma("unroll") for (int ks = 0; ks < 2; ++ks) KF[kt][ks] = *(const bf16x8*)(kp + (size_t)((kvrow0) + 16 * kt) * 64 + 32 * ks); \
        _Pragma("unroll") for (int dt = 0; dt < 4; ++dt) { VLO[dt] = *(const u32x2*)(vp + (size_t)(16 * dt) * KVR + (kvrow0)); VHI[dt] = *(const u32x2*)(vp + (size_t)(16 * dt) * KVR + (kvrow0) + 16); } } while (0)
        LOAD_KV(kf, vlo, vhi, 0);
        for (int blk = 0; blk < ntot; ++blk) {
            const int nb_ = (blk + 1 < ntot) ? blk + 1 : blk;
            const int kvnext = nb_ < nA ? 32 * nb_ : 256 + 32 * (lo + nb_ - nA);
            bf16x8 kfn[2][2]; u32x2 vlon[4], vhin[4];
            LOAD_KV(kfn, vlon, vhin, kvnext);
            const bool masked = blk >= nA; const int kpos0 = 32 * (lo + blk - nA) + 4 * lg;
            bf16x8 vf[4];
#pragma unroll
            for (int dt = 0; dt < 4; ++dt) { u32x4 w; w.x = vlo[dt].x; w.y = vlo[dt].y; w.z = vhi[dt].x; w.w = vhi[dt].y; vf[dt] = __builtin_bit_cast(bf16x8, w); }
#pragma unroll
            for (int qt = 0; qt < 4; ++qt) {
                f32x4 s0 = (f32x4){0.f, 0.f, 0.f, 0.f}, s1 = (f32x4){0.f, 0.f, 0.f, 0.f};
                s0 = __builtin_amdgcn_mfma_f32_16x16x32_bf16(kf[0][0], qf[qt][0], s0, 0, 0, 0); s0 = __builtin_amdgcn_mfma_f32_16x16x32_bf16(kf[0][1], qf[qt][1], s0, 0, 0, 0);
                s1 = __builtin_amdgcn_mfma_f32_16x16x32_bf16(kf[1][0], qf[qt][0], s1, 0, 0, 0); s1 = __builtin_amdgcn_mfma_f32_16x16x32_bf16(kf[1][1], qf[qt][1], s1, 0, 0, 0);
                if (masked) { const int qpos = q0 + l15;
#pragma unroll
                    for (int r = 0; r < 4; ++r) { const int d0 = kpos0 + r - qpos, d1 = d0 + 16;
                        if (d0 > 128 || d0 < -128) s0[r] = -1e30f; if (d1 > 128 || d1 < -128) s1[r] = -1e30f; } }
                float mx = fmaxf(fmaxf(fmaxf(s0[0], s0[1]), fmaxf(s0[2], s0[3])), fmaxf(fmaxf(s1[0], s1[1]), fmaxf(s1[2], s1[3])));
                mx = fmaxf(mx, __shfl_xor(mx, 16)); mx = fmaxf(mx, __shfl_xor(mx, 32));
                if (__any(mx > mrun[qt])) {
                    const float mnew = fmaxf(mrun[qt], mx), al = __builtin_amdgcn_exp2f(mrun[qt] - mnew); mrun[qt] = mnew; lsum[qt] *= al;
#pragma unroll
                    for (int dt = 0; dt < 4; ++dt) oacc[qt][dt] = oacc[qt][dt] * al; }
                const float mnew = mrun[qt];
                float ps = 0.f;
#pragma unroll
                for (int r = 0; r < 4; ++r) { s0[r] = __builtin_amdgcn_exp2f(s0[r] - mnew); s1[r] = __builtin_amdgcn_exp2f(s1[r] - mnew); ps += s0[r] + s1[r]; }
                lsum[qt] += ps;
                u32x4 pw; pw.x = cvt_pk_bf16(s0[0], s0[1]); pw.y = cvt_pk_bf16(s0[2], s0[3]); pw.z = cvt_pk_bf16(s1[0], s1[1]); pw.w = cvt_pk_bf16(s1[2], s1[3]);
                const bf16x8 pf = __builtin_bit_cast(bf16x8, pw);
#pragma unroll
                for (int dt = 0; dt < 4; ++dt) oacc[qt][dt] = __builtin_amdgcn_mfma_f32_16x16x32_bf16(vf[dt], pf, oacc[qt][dt], 0, 0, 0);
            }
#pragma unroll
            for (int kt = 0; kt < 2; ++kt)
#pragma unroll
                for (int ks = 0; ks < 2; ++ks) kf[kt][ks] = kfn[kt][ks];
#pragma unroll
            for (int dt = 0; dt < 4; ++dt) { vlo[dt] = vlon[dt]; vhi[dt] = vhin[dt]; }
        }
#undef LOAD_KV
#pragma unroll
        for (int qt = 0; qt < 4; ++qt) { float lt = lsum[qt]; lt += __shfl_xor(lt, 16); lt += __shfl_xor(lt, 32);
            if (type == 1) lt += __builtin_amdgcn_exp2f(sinkp[4 * g + qt] * LOG2E - mrun[qt]);
            const float inv = 1.0f / lt;
            bf16_t* op = O + (size_t)(rowbase + l15) * 1024 + qcol + 64 * qt + 4 * lg;
#pragma unroll
            for (int dt = 0; dt < 4; ++dt) { u32x2 w; w.x = cvt_pk_bf16(oacc[qt][dt][0] * inv, oacc[qt][dt][1] * inv); w.y = cvt_pk_bf16(oacc[qt][dt][2] * inv, oacc[qt][dt][3] * inv);
                *(u32x2*)(op + 16 * dt) = w; } }
    }
    return __builtin_amdgcn_s_memrealtime() - t_simple0;
#endif
}

#define RLX_AGENT __ATOMIC_RELAXED, __HIP_MEMORY_SCOPE_AGENT
#define XB_TMO      128
#define XB_XCNT(j)  (256  + 64 * (j))
#define XB_XSUB(j)  (1280 + 64 * (j))
#define XB_XGEN(j)  (2304 + 64 * (j))
#define XB_TOP      3328
#define XB_TOPGEN   3392
#define XCD_BAR_WORDS 3456
#define XB_SPIN_CAP (1u << 18)

__device__ __forceinline__ unsigned xb_ld(unsigned* p)              { return __hip_atomic_load(p, __ATOMIC_RELAXED, __HIP_MEMORY_SCOPE_AGENT); }
__device__ __forceinline__ unsigned xb_add(unsigned* p, unsigned v) { return __hip_atomic_fetch_add(p, v, __ATOMIC_RELAXED, __HIP_MEMORY_SCOPE_AGENT); }
__device__ __forceinline__ unsigned xb_xcc_id() { return (unsigned)__builtin_amdgcn_s_getreg((3 << 11) | 20) & 0xFu; }
#define XB_SPIN(cond, bar) do { unsigned _sp = 0; while (cond) { __builtin_amdgcn_s_sleep(1); \
    if ((++_sp & 255u) == 0u) { if (xb_ld(&(bar)[XB_TMO])) break; if (_sp > XB_SPIN_CAP) { atomicAdd(&(bar)[XB_TMO], 1u); break; } } } } while (0)

struct XcdBarrier {
    unsigned* bar; unsigned x;
    volatile LAS unsigned* st;
};

__device__ __forceinline__ XcdBarrier xcd_barrier_post(unsigned* bar, volatile LAS unsigned* st) {
    XcdBarrier b; b.bar = bar; b.x = xb_xcc_id(); b.st = st;
    if (threadIdx.x == 0) (void)xb_add(&bar[XB_XCNT(b.x)], 1u);
    return b;
}
__device__ __forceinline__ void xcd_barrier_complete(unsigned* bar, unsigned x, unsigned& nloc, unsigned& nx) {
    const unsigned G = gridDim.x * gridDim.y * gridDim.z;
    unsigned sum, cnt, mine, sp = 0u;
    for (;;) {
        sum = 0u; cnt = 0u; mine = 0u;
#pragma unroll
        for (unsigned j = 0; j < 16; ++j) { const unsigned c = xb_ld(&bar[XB_XCNT(j)]); sum += c; cnt += (c > 0u) ? 1u : 0u; mine = (j == x) ? c : mine; }
        if (sum == G) break;
        __builtin_amdgcn_s_sleep(1);
        if ((++sp & 255u) == 0u) { if (xb_ld(&bar[XB_TMO])) break; if (sp > XB_SPIN_CAP) { atomicAdd(&bar[XB_TMO], 1u); break; } }
    }
    nloc = mine > 0u ? mine : 1u; nx = cnt > 0u ? cnt : 1u;
}

__device__ __forceinline__ void xcd_barrier(const XcdBarrier& b) {
    asm volatile("s_waitcnt vmcnt(0)" ::: "memory");
    __syncthreads();
    if (threadIdx.x == 0) {
        unsigned* bar = b.bar;
        __builtin_amdgcn_s_waitcnt(0);
        unsigned nloc = b.st[0], nx = b.st[1];
        if (nloc == 0u) { xcd_barrier_complete(bar, b.x, nloc, nx); b.st[0] = nloc; b.st[1] = nx; }
        const unsigned old = xb_add(&bar[XB_XSUB(b.x)], 1u);
        const unsigned gen = old / nloc;
        if (old + 1u == (gen + 1u) * nloc) {
            __builtin_amdgcn_fence(__ATOMIC_RELEASE, "agent");
            asm volatile("s_waitcnt vmcnt(0)" ::: "memory");
            const unsigned og = xb_add(&bar[XB_TOP], 1u);
            const unsigned tg = og / nx;
            if (og + 1u == (tg + 1u) * nx) xb_add(&bar[XB_TOPGEN], 1u);
            else XB_SPIN(xb_ld(&bar[XB_TOPGEN]) == tg, bar);
            __builtin_amdgcn_fence(__ATOMIC_ACQUIRE, "agent");
            xb_add(&bar[XB_XGEN(b.x)], 1u);
            asm volatile("s_waitcnt vmcnt(0)" ::: "memory");
        } else {
            XB_SPIN(xb_ld(&bar[XB_XGEN(b.x)]) == gen, bar);
            __builtin_amdgcn_fence(__ATOMIC_ACQUIRE, "agent");
            asm volatile("s_waitcnt vmcnt(0)" ::: "memory");
        }
    }
    __syncthreads();
}

__global__ void __launch_bounds__(NTHR, 2) trunk_fwd(KArgs a) {
    extern __shared__ __attribute__((aligned(16))) unsigned char lds_raw[];
    LAS unsigned char* lds = (LAS unsigned char*)lds_raw;
    cg::grid_group grid = cg::this_grid();
    if (threadIdx.x < 16) ((LAS unsigned*)(lds + 131072))[threadIdx.x] = 0u;
    __syncthreads();
    const XcdBarrier xbar = xcd_barrier_post((unsigned*)(a.ws + OFF_BAR), (volatile LAS unsigned*)(lds + 131072 + 32));
#ifdef PROBE_KIND
    unsigned long long t_acc = 0;
#endif
    for (int si = a.step_lo; si < a.step_hi; ++si) {
        int tid = threadIdx.x; asm volatile("" : "+v"(tid));
        int z = 0; asm volatile("" : "+s"(z));
        unsigned char* ws = a.ws + z; unsigned char* WB = ws + OFF_W;
        const int st = a.steps[si], kind = st & 0xff, l = (st >> 8) & 0xf, arg = (st >> 12) & 0xf, jl = l >> 1;
        const int Mrows = (l == 3) ? ML : MALL;
#ifdef PROBE_KIND
        const unsigned long long t_0 = __builtin_amdgcn_s_memrealtime();
#endif
#ifdef ONLY
        if (kind != ONLY) continue;
#endif
        switch (kind) {
        case K_PROLOGUE: phase_prologue(a, z, tid, lds); break;
        case K_MOD0: phase_ln(a, z, tid, 0, 0, 0, MALL, blockIdx.x, gridDim.x); break;
        case K_LN: { const int which = arg & 3; const bool ctx_only = (arg >> 2) & 1;
            phase_ln(a, z, tid, l, which, ctx_only ? ML : 0, (l == 3) ? ML : MALL, blockIdx.x, gridDim.x); break; }
        case K_GEMM_EVIN: {
            const bool latonly = (arg >> 2) & 1, tail = (arg >> 3) & 1;
            pg8::Gemm g{(const bf16_t*)(ws + OFF_R2), (const bf16_t*)(WB + W_EV_IN) + (size_t)jl * 3072 * 1024, MALL, 3072, 1024, 1024, 0};
            EpiStore E{(bf16_t*)(ws + OFF_Z), 3072, 8};
            int M_ = MALL, G_ = gridDim.x; bool do_gemm = true;
            if (latonly) M_ = ML;
            if (tail) { g.A += (size_t)ML * 1024; E.O += (size_t)ML * 3072; M_ = MC; G_ = 96; do_gemm = blockIdx.x < 96; }
            g.M = M_;
            if (do_gemm) { pg8::StaticOrder S; S.init(M_, 3072, G_, blockIdx.x); pg8::gemm_phase<EpiStore, true>(tid, lds, g, S, E); }
            else phase_conv(a, z, tid, jl, 0, ML / 16, blockIdx.x - 96, gridDim.x - 96);
            break; }
        case K_GEMM_PLAIN: {
            const int pk = arg & 3; const bool latonly = (arg >> 2) & 1, tail = (arg >> 3) & 1;
            pg8::Gemm g; EpiStore E; int M_, N_;
            if (pk == PL_EVOUT) { g = pg8::Gemm{(const bf16_t*)(ws + OFF_Z), (const bf16_t*)(WB + W_EV_OUT) + (size_t)jl * 1024 * 1536, MALL, 1024, 1536, 3072, 0}; M_ = MALL; N_ = 1024; E = EpiStore{(bf16_t*)(ws + OFF_R2 + SZ_ROWS_BF), 1024, 0}; }
            else if (pk == PL_ODIN) { g = pg8::Gemm{(const bf16_t*)(ws + OFF_R2), (const bf16_t*)(WB + W_OD_IN) + (size_t)jl * 1536 * 1024, MALL, 1536, 1024, 1024, 0}; M_ = MALL; N_ = 1536; E = EpiStore{(bf16_t*)(ws + OFF_Z + ZO_QKV), 1536, 0}; }
            else if (pk == PL_ODOUT) { g = pg8::Gemm{(const bf16_t*)(ws + OFF_Z + ZO_O), (const bf16_t*)(WB + W_OD_OUT) + (size_t)jl * 1024 * 1024, Mrows, 1024, 1024, 1024, 0}; M_ = Mrows; N_ = 1024; E = EpiStore{(bf16_t*)(ws + OFF_R2 + SZ_ROWS_BF), 1024, 0}; }
            else { g = pg8::Gemm{(const bf16_t*)(ws + OFF_Z), (const bf16_t*)(WB + W_FFN_OUT) + (size_t)l * 1024 * 2816, Mrows, 1024, 2816, 2816, 0}; M_ = Mrows; N_ = 1024; E = EpiStore{(bf16_t*)(ws + OFF_R2 + SZ_ROWS_BF), 1024, 0}; }
            int G_ = gridDim.x; bool do_gemm = true;
            if (latonly) M_ = ML;
            const int tg = 8 * (N_ / 256);
            if (tail) { g.A += (size_t)ML * g.lda; E.O += (size_t)ML * E.ldc; M_ = MC; G_ = tg; do_gemm = blockIdx.x < tg; }
            g.M = M_;
            if (do_gemm) { pg8::StaticOrder S; S.init(M_, N_, G_, blockIdx.x); pg8::gemm_phase<EpiStore, true>(tid, lds, g, S, E); }
            else if (pk == PL_ODIN) phase_qkpost(a, z, tid, jl, 0, ML, blockIdx.x - tg, gridDim.x - tg);
            else phase_ln(a, z, tid, l, pk == PL_FFNOUT ? 2 : 1, 0, ML, blockIdx.x - tg, gridDim.x - tg);
            break; }
        case K_GEMM_SWIGLU: {
            pg8::Gemm g{(const bf16_t*)(ws + OFF_R2), (const bf16_t*)(WB + W_FFN_IN) + (size_t)l * 5632 * 1024, Mrows, 5632, 1024, 1024, 0};
            pg8::StaticOrder S; S.init(Mrows, 5632, gridDim.x, blockIdx.x);
            EpiSwiglu E{(bf16_t*)(ws + OFF_Z), 2816};
            pg8::gemm_phase<EpiSwiglu, true>(tid, lds, g, S, E); break; }
        case K_GEMM_GATE: {
            const int d = arg;
            pg8::Gemm g{(const bf16_t*)((unsigned char*)(a.out + z) + DO_XC), (const bf16_t*)(WB + W_GATE) + (size_t)jl * (2 * 8 * 256 * 128) + (size_t)d * 8 * 256 * 128, MALL, 2048, 128, 1024, 256};
            pg8::StaticOrder S; S.init(MALL, 2048, gridDim.x, blockIdx.x);
            EpiGate E{(bf16_t*)(ws + OFF_R2), (bf16_t*)(ws + OFF_R2 + SZ_ROWS_BF), (const bf16_t*)((unsigned char*)(a.out + z) + DO_XC),
                      a.in[z + 17] + (size_t)((jl * 2 + d) * 2 + 0) * 1024, a.in[z + 17] + (size_t)((jl * 2 + d) * 2 + 1) * 1024, (const float*)(ws + OFF_SPL) + (size_t)(jl * 2 + d) * 1024};
            pg8::gemm_phase<EpiGate, true>(tid, lds, g, S, E); break; }
        case K_CONV_GMLP: if (arg & 4) phase_conv(a, z, tid, jl, ML / 16, MC / 16, blockIdx.x, gridDim.x); else phase_conv(a, z, tid, jl, 0, MALL / 16, blockIdx.x, gridDim.x); break;
        case K_SCAN1: phase_scan(a, z, tid, arg, 1); break;
        case K_CARRY:
            phase_carry(a, z, tid, lds);
            if (arg == 0) phase_gmlp(a, z, tid, jl, lds, blockIdx.x, gridDim.x);
            break;
        case K_SCAN2: phase_scan(a, z, tid, arg, 2); break;
        case K_QKPOST: if (arg & 4) phase_qkpost(a, z, tid, jl, ML, MC, blockIdx.x, gridDim.x); else phase_qkpost(a, z, tid, jl, 0, MALL, blockIdx.x, gridDim.x); break;
        case K_ATTN: { const unsigned long long ts_ = phase_attn(a, z, tid, jl, l != 3, (char*)lds_raw);
#ifdef PROBE_ATTN_SIMPLE
            t_acc += ts_;
#else
            (void)ts_;
#endif
            break; }
        case K_DUMP: {
            const float* H = (const float*)(ws + OFF_H); const bf16_t* A_ = (const bf16_t*)(ws + OFF_R2); const bf16_t* Y_ = (const bf16_t*)(ws + OFF_R2 + SZ_ROWS_BF); const bf16_t* Z_ = (const bf16_t*)(ws + OFF_Z);
            for (size_t i = (size_t)blockIdx.x * NTHR + tid; i < (size_t)ML * 1024; i += (size_t)gridDim.x * NTHR) { const size_t row = i >> 10, c = i & 1023;
                (a.out + z)[i] = H[i] + bf_lo(A_[i]) + bf_lo(Y_[i]) + bf_lo(Z_[row * 3072 + c]) + bf_lo(Z_[row * 3072 + 1024 + c]) + bf_lo(Z_[row * 3072 + 2048 + c]); }
            break; }
        default: break;
        }
        if (si + 1 < a.step_hi) { if (si == a.step_lo) grid.sync(); else xcd_barrier(xbar); }
#ifdef PROBE_KIND
        if (kind == PROBE_KIND) t_acc += __builtin_amdgcn_s_memrealtime() - t_0;
#endif
    }
#ifdef PROBE_KIND
    { const unsigned long long t_s = __builtin_amdgcn_s_memrealtime(); while (__builtin_amdgcn_s_memrealtime() - t_s < t_acc) __builtin_amdgcn_s_sleep(8); }
#endif
}

extern "C" void kernel_launch(void* const* d_in, const int* in_sizes, int n_in, void* d_out, int out_size, void* d_ws, size_t ws_size, hipStream_t stream) {
    static int grid = 0;
    if (grid == 0) {
        if (n_in != 26 || out_size != ML * 1024 || ws_size < WS_NEED) { fprintf(stderr, "kernel_launch: unexpected problem (n_in %d out %d ws %zu need %zu)\n", n_in, out_size, ws_size, (size_t)WS_NEED); grid = -1; return; }
        int dev = 0, cus = 0, per_cu = 0;
        (void)hipGetDevice(&dev); (void)hipDeviceGetAttribute(&cus, hipDeviceAttributeMultiprocessorCount, dev);
        if (hipFuncSetAttribute((const void*)trunk_fwd, hipFuncAttributeMaxDynamicSharedMemorySize, LDS_BYTES) != hipSuccess) fprintf(stderr, "kernel_launch: hipFuncSetAttribute failed\n");
        if (hipOccupancyMaxActiveBlocksPerMultiprocessor(&per_cu, (const void*)trunk_fwd, NTHR, LDS_BYTES) != hipSuccess || per_cu < 1) { fprintf(stderr, "kernel_launch: occupancy query says %d\n", per_cu); per_cu = 1; }
        (void)hipGetLastError();
        if (per_cu > 1) per_cu = 1;
        grid = cus * per_cu;
    }
    if (grid < 0) return;
    KArgs a{};
    for (int i = 0; i < 26; ++i) a.in[i] = (const float*)d_in[i];
    a.out = (float*)d_out; a.ws = (unsigned char*)d_ws;
    int n = 0;
#ifndef PROBE_DUP
#define PROBE_DUP 0
#endif
#define STEP(kind, l, arg) do { a.steps[n++] = (kind) | ((l) << 8) | ((arg) << 12); if ((PROBE_DUP >> (kind)) & 1) a.steps[n++] = (kind) | ((l) << 8) | ((arg) << 12); } while (0)
    STEP(K_PROLOGUE, 0, 0); STEP(K_MOD0, 0, 0);
    const bool split = grid >= 192;
    for (int l = 0; l < 4; ++l) {
        const bool sp = split && l != 3;
        if ((l & 1) == 0) {
            if (split) { STEP(K_GEMM_EVIN, l, 4); STEP(K_GEMM_EVIN, l, 8); STEP(K_CONV_GMLP, l, 4); } else { STEP(K_GEMM_EVIN, l, 0); STEP(K_CONV_GMLP, l, 0); }
            for (int d = 0; d < 2; ++d) { STEP(K_GEMM_GATE, l, d); STEP(K_SCAN1, l, d); STEP(K_CARRY, l, d); STEP(K_SCAN2, l, d); }
            if (sp) { STEP(K_GEMM_PLAIN, l, PL_EVOUT | 4); STEP(K_GEMM_PLAIN, l, PL_EVOUT | 8); STEP(K_LN, l, 1 | 4); } else { STEP(K_GEMM_PLAIN, l, PL_EVOUT); STEP(K_LN, l, 1); }
        } else {
            if (split) { STEP(K_GEMM_PLAIN, l, PL_ODIN | 4); STEP(K_GEMM_PLAIN, l, PL_ODIN | 8); STEP(K_QKPOST, l, 4); } else { STEP(K_GEMM_PLAIN, l, PL_ODIN); STEP(K_QKPOST, l, 0); }
            STEP(K_ATTN, l, 0);
            if (sp) { STEP(K_GEMM_PLAIN, l, PL_ODOUT | 4); STEP(K_GEMM_PLAIN, l, PL_ODOUT | 8); STEP(K_LN, l, 1 | 4); } else { STEP(K_GEMM_PLAIN, l, PL_ODOUT); STEP(K_LN, l, 1); }
        }
        STEP(K_GEMM_SWIGLU, l, 0);
        if (sp) { STEP(K_GEMM_PLAIN, l, PL_FFNOUT | 4); STEP(K_GEMM_PLAIN, l, PL_FFNOUT | 8); STEP(K_LN, l, 2 | 4); } else { STEP(K_GEMM_PLAIN, l, PL_FFNOUT); STEP(K_LN, l, 2); }
    }
#undef STEP
#ifdef TRUNC
    n = TRUNC; a.steps[n++] = K_DUMP;
#endif
    a.step_lo = 0; a.step_hi = n;
    (void)hipMemsetAsync((unsigned char*)d_ws + OFF_BAR, 0, 16384, stream);
    void* args[] = {&a};
#ifndef FORCE_MULTI
#define FORCE_MULTI 0
#endif
    hipError_t e = FORCE_MULTI ? hipErrorUnknown : hipLaunchCooperativeKernel((const void*)trunk_fwd, dim3(grid), dim3(NTHR), args, LDS_BYTES, stream);
    if (e != hipSuccess) {
        if (!FORCE_MULTI) fprintf(stderr, "kernel_launch: cooperative launch failed: %s (grid %d); falling back to one launch per step\n", hipGetErrorString(e), grid);
        (void)hipGetLastError();
        for (int s = 0; s < n; ++s) { a.step_lo = s; a.step_hi = s + 1; hipLaunchKernelGGL(trunk_fwd, dim3(grid), dim3(NTHR), LDS_BYTES, stream, a); }
    }
}
```
